# Optimizing an MI355X kernel written in HIP

```python
import math
import jax, jax.numpy as jnp
from jax import lax
import numpy as np

D_MODEL = 1024
BATCH = 8
SEQ = 4096
DEPTH = 2

CONV_WIDTH = 512
CONV_A_K = 3
N_HEADS = 8
HEAD_DIM = 64
ATTN_WIDTH = N_HEADS * HEAD_DIM
ROT_DIM = HEAD_DIM // 4
ROPE_THETA = 500000.0
MOBA_BLOCK = 256
MOBA_TOPK = 3
Q_CHUNK = 64
LRU_WIDTH = 512
LRU_BLOCKS = 8
LRU_BLOCK_DIM = LRU_WIDTH // LRU_BLOCKS
CONV_C_K = 4
LRU_C = 8.0
N_BRANCHES = 3
IN_COLS = 3 * CONV_WIDTH + 3 * ATTN_WIDTH + 2 * LRU_WIDTH + N_BRANCHES * D_MODEL
D_FF = 2816
N_EXPERTS = 8
TOP_K = 2
EXPERT_FF = 3584
EPS = 1e-6
NEG = -1e30

kernel_name = "hybrid_gated_conv_moba_rglru_moe"


def rms_norm(x, g):
    xf = x.astype(jnp.float32)
    y = xf * lax.rsqrt(jnp.mean(xf * xf, axis=-1, keepdims=True) + EPS)
    return (y * g.astype(jnp.float32)).astype(x.dtype)


def causal_depthwise_conv(u, w):
    k_w, c = w.shape
    return lax.conv_general_dilated(
        u, w[:, None, :].astype(u.dtype), window_strides=(1,), padding=[(k_w - 1, 0)],
        dimension_numbers=("NWC", "WIO", "NWC"), feature_group_count=c)


def partial_rotary(t, pos):
    half = ROT_DIM // 2
    inv_freq = ROPE_THETA ** (-jnp.arange(0, ROT_DIM, 2, dtype=jnp.float32) / ROT_DIM)
    ang = pos.astype(jnp.float32)[:, None] * inv_freq[None, :]
    cos = jnp.cos(ang)[None, :, None, :]
    sin = jnp.sin(ang)[None, :, None, :]
    r1 = t[..., :half].astype(jnp.float32)
    r2 = t[..., half:ROT_DIM].astype(jnp.float32)
    rot = jnp.concatenate([r1 * cos - r2 * sin, r2 * cos + r1 * sin], axis=-1).astype(t.dtype)
    return jnp.concatenate([rot, t[..., ROT_DIM:]], axis=-1)


def moba_attention(q, k, v):
    b, s, h, dh = q.shape
    s_pad = -(-s // MOBA_BLOCK) * MOBA_BLOCK
    pad = ((0, 0), (0, s_pad - s), (0, 0), (0, 0))
    q, k, v = [jnp.pad(t, pad).transpose(0, 2, 1, 3) for t in (q, k, v)]
    nb = s_pad // MOBA_BLOCK
    n_sel = min(MOBA_TOPK, nb)
    kb = k.reshape(b, h, nb, MOBA_BLOCK, dh)
    vb = v.reshape(b, h, nb, MOBA_BLOCK, dh)
    k_mean = jnp.mean(kb.astype(jnp.float32), axis=3)
    n_chunks = s_pad // Q_CHUNK
    chunks_per_block = MOBA_BLOCK // Q_CHUNK
    q_chunks = q.reshape(b, h, n_chunks, Q_CHUNK, dh).transpose(2, 0, 1, 3, 4)
    b_idx = jnp.arange(b)[:, None, None, None]
    h_idx = jnp.arange(h)[None, :, None, None]
    scale = dh ** -0.5

    def chunk(args):
        q_c, c = args
        blk = c // chunks_per_block
        q_pos = c * Q_CHUNK + jnp.arange(Q_CHUNK)
        gate = jnp.einsum("bhqd,bhnd->bhqn", q_c.astype(jnp.float32), k_mean)
        gate = jnp.where(jnp.arange(nb) < blk, gate, NEG)
        _, sel = lax.top_k(gate, n_sel)
        k_sel = kb[b_idx, h_idx, sel]
        v_sel = vb[b_idx, h_idx, sel]
        s_sel = jnp.einsum("bhqd,bhqkjd->bhqkj", q_c, k_sel).astype(jnp.float32) * scale
        s_sel = jnp.where((jnp.arange(n_sel) < blk)[:, None], s_sel, NEG)
        k_own = lax.dynamic_index_in_dim(kb, blk, axis=2, keepdims=False)
        v_own = lax.dynamic_index_in_dim(vb, blk, axis=2, keepdims=False)
        k_pos = blk * MOBA_BLOCK + jnp.arange(MOBA_BLOCK)
        s_own = jnp.einsum("bhqd,bhjd->bhqj", q_c, k_own).astype(jnp.float32) * scale
        s_own = jnp.where(k_pos[None, :] <= q_pos[:, None], s_own, NEG)
        scores = jnp.concatenate([s_sel.reshape(b, h, Q_CHUNK, n_sel * MOBA_BLOCK), s_own], axis=-1)
        p = jax.nn.softmax(scores, axis=-1).astype(v.dtype)
        p_sel = p[..., :n_sel * MOBA_BLOCK].reshape(b, h, Q_CHUNK, n_sel, MOBA_BLOCK)
        p_own = p[..., n_sel * MOBA_BLOCK:]
        return (jnp.einsum("bhqkj,bhqkjd->bhqd", p_sel, v_sel)
                + jnp.einsum("bhqj,bhjd->bhqd", p_own, v_own))

    out = lax.map(chunk, (q_chunks, jnp.arange(n_chunks)))
    out = out.transpose(1, 0, 3, 2, 4).reshape(b, s_pad, h * dh)
    return out[:, :s]


def rg_lru(xc, w_r, b_r, w_i, b_i, lam):
    bsz, s, _ = xc.shape
    xb = xc.reshape(bsz, s, LRU_BLOCKS, LRU_BLOCK_DIM)
    r = jax.nn.sigmoid((jnp.einsum("bshi,hij->bshj", xb, w_r).reshape(bsz, s, LRU_WIDTH) + b_r).astype(jnp.float32))
    i = jax.nn.sigmoid((jnp.einsum("bshi,hij->bshj", xb, w_i).reshape(bsz, s, LRU_WIDTH) + b_i).astype(jnp.float32))
    log_a = -LRU_C * r * jax.nn.softplus(-lam.astype(jnp.float32))
    a = jnp.exp(log_a)
    u = jnp.sqrt(-jnp.expm1(2.0 * log_a)) * (i * xc.astype(jnp.float32))

    def combine(c1, c2):
        a1, b1 = c1
        a2, b2 = c2
        return a1 * a2, a2 * b1 + b2

    _, hs = lax.associative_scan(combine, (a, u), axis=1)
    return hs.astype(xc.dtype)


def swiglu(h, w_gate, w_up, w_down):
    return (jax.nn.silu(h @ w_gate) * (h @ w_up)) @ w_down


def moe_swiglu(h, router, w_gate, w_up, w_down):
    bsz, s, d = h.shape
    t = h.reshape(-1, d)
    logits = (t @ router).astype(jnp.float32)
    top_v, top_i = lax.top_k(logits, TOP_K)
    w = jax.nn.softmax(top_v, axis=-1)
    comb = jnp.sum(jax.nn.one_hot(top_i, N_EXPERTS, dtype=jnp.float32) * w[..., None], axis=1)

    def expert_step(acc, params):
        wg, wu, wd, c_e = params
        return acc + c_e[:, None].astype(t.dtype) * swiglu(t, wg, wu, wd), None

    out, _ = lax.scan(expert_step, jnp.zeros_like(t), (w_gate, w_up, w_down, comb.T))
    return out.reshape(bsz, s, d)


def setup_inputs(seed: int = 0) -> dict:
    key = jax.random.key(seed)
    ks = iter(jax.random.split(key, 32))
    L = DEPTH
    n_dense = (DEPTH + 1) // 2
    n_moe = DEPTH // 2

    def nrm(shape, fan_in):
        return jax.random.normal(next(ks), shape, jnp.float32) * (fan_in ** -0.5)

    def gain(shape):
        return 1.0 + 0.02 * jax.random.normal(next(ks), shape, jnp.float32)

    def bias(shape):
        return 0.02 * jax.random.normal(next(ks), shape, jnp.float32)

    a0 = jax.random.uniform(next(ks), (L, LRU_WIDTH), jnp.float32, 0.9, 0.999)
    return {
        "x": jax.random.normal(next(ks), (BATCH, SEQ, D_MODEL), jnp.float32),
        "norm_mix": gain((L, D_MODEL)),
        "w_in": nrm((L, D_MODEL, IN_COLS), D_MODEL),
        "conv_a_w": nrm((L, CONV_A_K, CONV_WIDTH), CONV_A_K),
        "wo_a": nrm((L, CONV_WIDTH, D_MODEL), CONV_WIDTH),
        "q_norm": gain((L, HEAD_DIM)),
        "k_norm": gain((L, HEAD_DIM)),
        "wo_b": nrm((L, ATTN_WIDTH, D_MODEL), ATTN_WIDTH),
        "conv_c_w": nrm((L, CONV_C_K, LRU_WIDTH), CONV_C_K),
        "conv_c_b": bias((L, LRU_WIDTH)),
        "rg_w_r": nrm((L, LRU_BLOCKS, LRU_BLOCK_DIM, LRU_BLOCK_DIM), LRU_BLOCK_DIM),
        "rg_b_r": bias((L, LRU_WIDTH)),
        "rg_w_i": nrm((L, LRU_BLOCKS, LRU_BLOCK_DIM, LRU_BLOCK_DIM), LRU_BLOCK_DIM),
        "rg_b_i": bias((L, LRU_WIDTH)),
        "rg_lambda": jnp.log(a0 / (1.0 - a0)),
        "wo_c": nrm((L, LRU_WIDTH, D_MODEL), LRU_WIDTH),
        "w_o": nrm((L, D_MODEL, D_MODEL), D_MODEL),
        "norm_ffn": gain((L, D_MODEL)),
        "ffn_w_gate": nrm((n_dense, D_MODEL, D_FF), D_MODEL),
        "ffn_w_up": nrm((n_dense, D_MODEL, D_FF), D_MODEL),
        "ffn_w_down": nrm((n_dense, D_FF, D_MODEL), D_FF),
        "moe_router": nrm((n_moe, D_MODEL, N_EXPERTS), D_MODEL),
        "moe_w_gate": nrm((n_moe, N_EXPERTS, D_MODEL, EXPERT_FF), D_MODEL),
        "moe_w_up": nrm((n_moe, N_EXPERTS, D_MODEL, EXPERT_FF), D_MODEL),
        "moe_w_down": nrm((n_moe, N_EXPERTS, EXPERT_FF, D_MODEL), EXPERT_FF),
    }


def reference(x, norm_mix, w_in, conv_a_w, wo_a, q_norm, k_norm, wo_b, conv_c_w, conv_c_b,
              rg_w_r, rg_b_r, rg_w_i, rg_b_i, rg_lambda, wo_c, w_o, norm_ffn,
              ffn_w_gate, ffn_w_up, ffn_w_down, moe_router, moe_w_gate, moe_w_up, moe_w_down):
    bsz, s, d = x.shape
    pos = jnp.arange(s, dtype=jnp.int32)
    sizes = [CONV_WIDTH] * 3 + [ATTN_WIDTH] * 3 + [LRU_WIDTH] * 2 + [N_BRANCHES * D_MODEL]
    cuts = list(np.cumsum(sizes)[:-1])
    for l in range(DEPTH):
        h = rms_norm(x, norm_mix[l])
        p = h @ w_in[l]
        xa, ba, ca, q, k, v, xc, gc, gates = jnp.split(p, cuts, axis=-1)
        y_a = (ba * causal_depthwise_conv(ca * xa, conv_a_w[l])) @ wo_a[l]
        q = partial_rotary(rms_norm(q.reshape(bsz, s, N_HEADS, HEAD_DIM), q_norm[l]), pos)
        k = partial_rotary(rms_norm(k.reshape(bsz, s, N_HEADS, HEAD_DIM), k_norm[l]), pos)
        v = v.reshape(bsz, s, N_HEADS, HEAD_DIM)
        y_b = moba_attention(q, k, v) @ wo_b[l]
        xc = causal_depthwise_conv(xc, conv_c_w[l]) + conv_c_b[l]
        hc = rg_lru(xc, rg_w_r[l], rg_b_r[l], rg_w_i[l], rg_b_i[l], rg_lambda[l])
        y_c = (jax.nn.gelu(gc, approximate=True) * hc) @ wo_c[l]
        g = jax.nn.sigmoid(gates.reshape(bsz, s, N_BRANCHES, d))
        merged = g[:, :, 0] * y_a + g[:, :, 1] * y_b + g[:, :, 2] * y_c
        x = x + merged @ w_o[l]
        h = rms_norm(x, norm_ffn[l])
        if l % 2 == 0:
            x = x + swiglu(h, ffn_w_gate[l // 2], ffn_w_up[l // 2], ffn_w_down[l // 2])
        else:
            x = x + moe_swiglu(h, moe_router[l // 2], moe_w_gate[l // 2], moe_w_up[l // 2], moe_w_down[l // 2])
    return x
```

```cpp
#include <hip/hip_runtime.h>
#include <cstdio>
#include <cstdint>

namespace pg8 {
#define PG8_LAS __attribute__((address_space(3)))
typedef unsigned short bf16_t;
typedef short bf16x8 __attribute__((ext_vector_type(8)));
typedef float f32x4 __attribute__((ext_vector_type(4)));
typedef unsigned u32x4 __attribute__((ext_vector_type(4)));
constexpr int BM = 256, BK = 64, HALF = 128, HTB = HALF * BK * 2  , STAGE_BYTES = 8 * HTB, NXCD = 8, WGM = 8;

__host__ __device__ __forceinline__ int lds_byte(int r, int c) { const int st = (r >> 4) * 2 + (c >> 5), rr = r & 15, cc = c & 31, ob = rr * 64 + cc * 2; return st * 1024 + (ob ^ (((ob >> 9) & 1) << 5)); }
__host__ __device__ __forceinline__ void stage_rc(int b, int& R, int& C) { const int st = b / 1024, sb = b % 1024, swz = sb ^ (((sb >> 9) & 1) << 5); R = (st >> 1) * 16 + swz / 64; C = (st & 1) * 32 + (swz % 64) / 2; }
__host__ __device__ __forceinline__ int perm32(int rho) { const int n = rho >> 4, i = rho & 15; return 8 * (i >> 2) + 4 * n + (i & 3); }

struct Unit { int pm, pn; const char* a; const char* b; int x; };
struct Gemm { int K, lda, ldb; };

struct TileOrder {
    int nM, nN, nwg, G, c;
    __device__ __forceinline__ void init(int nM_, int nN_, int G_, int c_) { nM = nM_; nN = nN_; nwg = nM * nN; G = G_; c = c_; }
    __device__ __forceinline__ bool map(long L, int& pm, int& pn) const {
        if (L >= nwg) return false;
        int wgid = (int)L; { const int q = nwg / NXCD, r = nwg % NXCD, xcd = wgid % NXCD, off = wgid / NXCD; wgid = (xcd < r ? xcd * (q + 1) : r * (q + 1) + (xcd - r) * q) + off; }
        const int nig = WGM * nN, gid = wgid / nig, fm = gid * WGM, gsz = (nM - fm) < WGM ? (nM - fm) : WGM;
        pm = fm + ((wgid % nig) % gsz); pn = (wgid % nig) / gsz; return true;
    }
};

typedef float f32x2_cv __attribute__((ext_vector_type(2))); typedef __bf16 bf16x2_cv __attribute__((ext_vector_type(2)));
__device__ __forceinline__ unsigned cvt_pk_bf16(float lo, float hi) { const f32x2_cv v = {lo, hi}; const bf16x2_cv b = __builtin_convertvector(v, bf16x2_cv); return __builtin_bit_cast(unsigned, b); }

struct EpiBf16 {
    static constexpr bool PERM = true, AFTER_DRAIN = false, CHAIN = false;
    bf16_t* O; int ldc; int sig_from; float ds;
    __device__ __forceinline__ void operator()(const f32x4 (&acc)[2][2][4][2], const Unit& u, int wr, int wc, int fr, int fq) const {
        const int row0 = u.pm * BM + wr * 64 + fr; const int col0 = u.pn * BM + wc * 32 + 8 * fq;
#pragma unroll
        for (int ai = 0; ai < 2; ++ai)
#pragma unroll
            for (int m = 0; m < 4; ++m) { bf16_t* rowp = O + (size_t)(row0 + ai * HALF + m * 16) * ldc + col0;
#pragma unroll
                for (int bj = 0; bj < 2; ++bj) { f32x4 v0 = acc[ai][bj][m][0] * ds, v1 = acc[ai][bj][m][1] * ds;
                    if (u.pn >= sig_from) {
#pragma unroll
                        for (int k = 0; k < 4; ++k) { v0[k] = __builtin_amdgcn_rcpf(1.0f + __expf(-v0[k])); v1[k] = __builtin_amdgcn_rcpf(1.0f + __expf(-v1[k])); } }
                    u32x4 w; w.x = cvt_pk_bf16(v0[0], v0[1]); w.y = cvt_pk_bf16(v0[2], v0[3]); w.z = cvt_pk_bf16(v1[0], v1[1]); w.w = cvt_pk_bf16(v1[2], v1[3]);
                    *(u32x4*)(rowp + bj * HALF) = w; } }
    }
};

typedef int pg8_v4i __attribute__((ext_vector_type(4))); typedef int pg8_v8i __attribute__((ext_vector_type(8)));
__device__ __forceinline__ pg8_v8i f8cat(bf16x8 lo, bf16x8 hi) { const pg8_v4i a = __builtin_bit_cast(pg8_v4i, lo), b = __builtin_bit_cast(pg8_v4i, hi); return __builtin_shufflevector(a, b, 0, 1, 2, 3, 4, 5, 6, 7); }
template <class Epi, class Sched, bool ALIGN_EPI = false, bool SP2 = false, bool F8 = false>
__device__ __forceinline__ void gemm_phase(int tid_, PG8_LAS unsigned char* lds, const Gemm g, const Sched& S, const Epi& E) {
    const int tid = tid_, wid = __builtin_amdgcn_readfirstlane(tid >> 6), lane = tid & 63, wr = wid >> 2, wc = wid & 3, fr = lane & 15, fq = lane >> 4;
    const int K = g.K, nt = F8 ? K / 128 : K / BK; constexpr int ESZ = F8 ? 1 : 2;
    unsigned voffA[2], voffB[2];
#pragma unroll
    for (int i = 0; i < 2; ++i) { int R, C; stage_rc(tid * 16 + i * 8192, R, C); const int Rb = Epi::PERM ? ((R & ~31) + perm32(R & 31)) : R;
        voffA[i] = (unsigned)(R * g.lda * ESZ + C * 2); voffB[i] = (unsigned)(Rb * g.ldb * ESZ + C * 2); }
    const size_t kstep = (size_t)(BK * 2);
    const size_t hstepA = (size_t)HALF * g.lda * ESZ, hstepB = (size_t)HALF * g.ldb * ESZ;
    const unsigned ldsw = (unsigned)wid * 1024u;
    const int aoff = lds_byte(wr * 64 + fr, fq * 8), boff = lds_byte(wc * 32 + fr, fq * 8);
#define PG8_SA(b, h) (((b) * 2 + (h)) * HTB)
#define PG8_SB(b, h) ((4 + (b) * 2 + (h)) * HTB)
#define PG8_STAGE(bufoff, gbase, voff) do { _Pragma("unroll") for (int _i = 0; _i < 2; ++_i) \
        __builtin_amdgcn_global_load_lds((const unsigned*)((const char*)(gbase) + (voff)[_i]), (PG8_LAS unsigned*)(lds + (bufoff) + ldsw + _i * 8192), 16, 0, 0); } while (0)
#define PG8_LDA(dst, b, h) do { _Pragma("unroll") for (int m = 0; m < 4; ++m) { const bf16x8 lo_ = *(const PG8_LAS bf16x8*)(lds + PG8_SA(b, h) + aoff + m * 2048), hi_ = *(const PG8_LAS bf16x8*)(lds + PG8_SA(b, h) + aoff + m * 2048 + 1024); \
        if constexpr (F8) dst##8[m] = f8cat(lo_, hi_); else { dst[m][0] = lo_; dst[m][1] = hi_; } } } while (0)
#define PG8_LDB(dst, b, h) do { _Pragma("unroll") for (int n = 0; n < 2; ++n) { const bf16x8 lo_ = *(const PG8_LAS bf16x8*)(lds + PG8_SB(b, h) + boff + n * 2048), hi_ = *(const PG8_LAS bf16x8*)(lds + PG8_SB(b, h) + boff + n * 2048 + 1024); \
        if constexpr (F8) dst##8[n] = f8cat(lo_, hi_); else { dst[n][0] = lo_; dst[n][1] = hi_; } } } while (0)
#define PG8_MMA(ai, bj, At, Bt) do { __builtin_amdgcn_s_setprio(1); _Pragma("unroll") for (int m = 0; m < 4; ++m) _Pragma("unroll") for (int n = 0; n < 2; ++n) { \
        if constexpr (F8) asm volatile("v_mfma_scale_f32_16x16x128_f8f6f4 %0, %1, %2, %0, %3, %3 op_sel_hi:[0,0,0]" : "+v"(acc[ai][bj][m][n]) : "v"(Bt##8[n]), "v"(At##8[m]), "v"(f8scale));   \
        else { _Pragma("unroll") for (int k = 0; k < 2; ++k) acc[ai][bj][m][n] = __builtin_amdgcn_mfma_f32_16x16x32_bf16(Bt[n][k], At[m][k], acc[ai][bj][m][n], 0, 0, 0); } } __builtin_amdgcn_s_setprio(0); } while (0)
#define PG8_WAIT_V(n) asm volatile("s_waitcnt vmcnt(" #n ")" ::: "memory")
#define PG8_WAIT_L(n) asm volatile("s_waitcnt lgkmcnt(" #n ")" ::: "memory")
#define PG8_BAR __builtin_amdgcn_s_barrier()
#define PG8_SCHED __builtin_amdgcn_sched_barrier(0)
    Unit cur, nxt; int ui = 0;
    if (!S.next(0, cur)) return;
    f32x4 acc[2][2][4][2];
#pragma unroll
    for (int a = 0; a < 2; ++a)
#pragma unroll
        for (int b = 0; b < 2; ++b)
#pragma unroll
            for (int m = 0; m < 4; ++m)
#pragma unroll
                for (int n = 0; n < 2; ++n) acc[a][b][m][n] = (f32x4){0.f, 0.f, 0.f, 0.f};
    bf16x8 At[4][2], B0[2][2], B1[2][2]; pg8_v8i At8[4], B08[2], B18[2]; const int f8scale = 0x7f7f7f7f;
    const char* cA = cur.a; const char* cB = cur.b;
    S.a_ready(cur);
    if constexpr (SP2) {
        PG8_STAGE(PG8_SB(0, 0), cB, voffB); PG8_STAGE(PG8_SB(0, 1), cB + hstepB, voffB); PG8_STAGE(PG8_SA(0, 0), cA, voffA); PG8_STAGE(PG8_SA(0, 1), cA + hstepA, voffA);
        if (wr == 1) PG8_BAR;
        PG8_WAIT_V(2); PG8_BAR;
        PG8_STAGE(PG8_SB(1, 0), cB + kstep, voffB); PG8_STAGE(PG8_SA(1, 0), cA + kstep, voffA); PG8_STAGE(PG8_SB(1, 1), cB + hstepB + kstep, voffB);
        PG8_WAIT_V(6); PG8_BAR;
    } else {
        PG8_STAGE(PG8_SB(0, 0), cB, voffB); PG8_STAGE(PG8_SA(0, 0), cA, voffA); PG8_STAGE(PG8_SB(0, 1), cB + hstepB, voffB); PG8_STAGE(PG8_SA(0, 1), cA + hstepA, voffA);
        if (wr == 1) PG8_BAR;
        PG8_WAIT_V(4); PG8_BAR;
        PG8_STAGE(PG8_SB(1, 0), cB + kstep, voffB); PG8_STAGE(PG8_SA(1, 0), cA + kstep, voffA); PG8_STAGE(PG8_SB(1, 1), cB + hstepB + kstep, voffB);
        PG8_WAIT_V(6); PG8_BAR;
    }
    for (;;) {
        const bool has_next = S.next(ui + 1, nxt);
        const char* nA = has_next ? nxt.a : cA; const char* nB = has_next ? nxt.b : cB;
#pragma unroll 1
        for (int t = 0; t < nt; t += 2) {
            const bool last = (t == nt - 2);
            const char* a1 = cA + (size_t)(t + 1) * kstep;
            const char* a2 = last ? nA : cA + (size_t)(t + 2) * kstep; const char* b2 = last ? nB : cB + (size_t)(t + 2) * kstep;
            const char* a3 = a2 + kstep; const char* b3 = b2 + kstep;
            if (last && has_next) S.a_ready(nxt);
            if constexpr (SP2) {
            PG8_LDB(B0, 0, 0); PG8_LDB(B1, 0, 1); PG8_SCHED; PG8_LDA(At, 0, 0); PG8_STAGE(PG8_SA(1, 1), a1 + hstepA, voffA);
            PG8_WAIT_V(8); PG8_WAIT_L(0); PG8_BAR; PG8_MMA(0, 0, At, B0); PG8_MMA(0, 1, At, B1); PG8_BAR; PG8_SCHED;
            PG8_LDA(At, 0, 1); PG8_STAGE(PG8_SB(0, 0), b2, voffB); PG8_STAGE(PG8_SB(0, 1), b2 + hstepB, voffB); PG8_STAGE(PG8_SA(0, 0), a2, voffA);
            PG8_WAIT_V(8); PG8_WAIT_L(0); PG8_BAR; PG8_MMA(1, 0, At, B0); PG8_MMA(1, 1, At, B1); PG8_BAR; PG8_SCHED;
            PG8_LDB(B0, 1, 0); PG8_LDB(B1, 1, 1); PG8_SCHED; PG8_LDA(At, 1, 0); PG8_STAGE(PG8_SA(0, 1), a2 + hstepA, voffA);
            PG8_WAIT_V(8); PG8_WAIT_L(0); PG8_BAR; PG8_MMA(0, 0, At, B0); PG8_MMA(0, 1, At, B1); PG8_BAR; PG8_SCHED;
            PG8_LDA(At, 1, 1); PG8_STAGE(PG8_SB(1, 0), b3, voffB); PG8_STAGE(PG8_SB(1, 1), b3 + hstepB, voffB); PG8_STAGE(PG8_SA(1, 0), a3, voffA);
            PG8_WAIT_V(8); PG8_WAIT_L(0); PG8_BAR; PG8_MMA(1, 0, At, B0); PG8_MMA(1, 1, At, B1); PG8_BAR; PG8_SCHED;
            } else {
            PG8_LDB(B0, 0, 0); PG8_SCHED; PG8_LDA(At, 0, 0); PG8_STAGE(PG8_SA(1, 1), a1 + hstepA, voffA);
            PG8_WAIT_L(8); PG8_BAR; PG8_WAIT_L(0); PG8_MMA(0, 0, At, B0); PG8_BAR; PG8_SCHED;
            PG8_LDB(B1, 0, 1); PG8_STAGE(PG8_SB(0, 0), b2, voffB);
            PG8_BAR; PG8_WAIT_L(0); PG8_MMA(0, 1, At, B1); PG8_BAR;
            PG8_LDA(At, 0, 1); PG8_STAGE(PG8_SA(0, 0), a2, voffA);
            PG8_BAR; PG8_WAIT_L(0); PG8_MMA(1, 0, At, B0); PG8_BAR; PG8_SCHED;
            PG8_STAGE(PG8_SB(0, 1), b2 + hstepB, voffB);
            PG8_WAIT_V(6); PG8_BAR; PG8_MMA(1, 1, At, B1); PG8_BAR;
            PG8_LDB(B0, 1, 0); PG8_SCHED; PG8_LDA(At, 1, 0); PG8_STAGE(PG8_SA(0, 1), a2 + hstepA, voffA);
            PG8_WAIT_L(8); PG8_BAR; PG8_WAIT_L(0); PG8_MMA(0, 0, At, B0); PG8_BAR; PG8_SCHED;
            PG8_LDB(B1, 1, 1); PG8_STAGE(PG8_SB(1, 0), b3, voffB);
            PG8_BAR; PG8_WAIT_L(0); PG8_MMA(0, 1, At, B1); PG8_BAR;
            PG8_LDA(At, 1, 1); PG8_STAGE(PG8_SA(1, 0), a3, voffA);
            PG8_BAR; PG8_WAIT_L(0); PG8_MMA(1, 0, At, B0); PG8_BAR; PG8_SCHED;
            PG8_STAGE(PG8_SB(1, 1), b3 + hstepB, voffB);
            PG8_WAIT_V(6); PG8_BAR; PG8_MMA(1, 1, At, B1); PG8_BAR;
            }
        }
        if constexpr (ALIGN_EPI) { if (wr == 0) PG8_BAR; }
        if constexpr (F8) asm volatile("s_nop 15\n\ts_nop 7" ::: "memory");
        bool keep = false;
        if constexpr (!Epi::AFTER_DRAIN) { if constexpr (Epi::CHAIN) keep = E.chain(acc, cur, wr, wc, fr, fq); else E(acc, cur, wr, wc, fr, fq); S.done(cur); }
        if (!has_next) break;
        if (!keep) {
#pragma unroll
        for (int a = 0; a < 2; ++a)
#pragma unroll
            for (int b = 0; b < 2; ++b)
#pragma unroll
                for (int m = 0; m < 4; ++m)
#pragma unroll
                    for (int n = 0; n < 2; ++n) acc[a][b][m][n] = (f32x4){0.f, 0.f, 0.f, 0.f};
        }
        cur = nxt; cA = nA; cB = nB; ++ui;
        if constexpr (ALIGN_EPI) { if (wr == 1) PG8_BAR; }
    }
    PG8_WAIT_V(0);
    if constexpr (!ALIGN_EPI) { if (wr == 0) PG8_BAR; }
    PG8_BAR;
    if constexpr (Epi::AFTER_DRAIN) { E.fused(acc, cur, wr, wc, fr, fq, lds, wid, lane); S.done(cur); }
#undef PG8_SA
#undef PG8_SB
#undef PG8_STAGE
#undef PG8_LDA
#undef PG8_LDB
#undef PG8_MMA
#undef PG8_WAIT_V
#undef PG8_WAIT_L
#undef PG8_BAR
#undef PG8_SCHED
}
}

#define GAS __attribute__((address_space(1)))
#define LAS __attribute__((address_space(3)))
typedef unsigned short bf16;
typedef unsigned v4u __attribute__((ext_vector_type(4)));
typedef unsigned v2u __attribute__((ext_vector_type(2)));
typedef float f32x4 __attribute__((ext_vector_type(4)));
typedef float f32x2 __attribute__((ext_vector_type(2)));
typedef GAS unsigned gu32;
#define RLX_AGENT __ATOMIC_RELAXED, __HIP_MEMORY_SCOPE_AGENT
#define LDS_WAIT() asm volatile("s_waitcnt lgkmcnt(0)" ::: "memory")
#define VM_WAIT() asm volatile("s_waitcnt vmcnt(0)" ::: "memory")
__device__ __forceinline__ unsigned pk2(float lo, float hi) { return pg8::cvt_pk_bf16(lo, hi); }
__device__ __forceinline__ float bflo(unsigned w) { return __uint_as_float(w << 16); }
__device__ __forceinline__ float bfhi(unsigned w) { return __uint_as_float(w & 0xffff0000u); }
__device__ __forceinline__ float bf2f(bf16 b) { return __uint_as_float((unsigned)b << 16); }
__device__ __forceinline__ bf16 f2bf(float f) { return (bf16)(pk2(f, 0.f) & 0xffffu); }
__device__ __forceinline__ float bfround(float f) { return bflo(pk2(f, 0.f)); }
__device__ __forceinline__ unsigned pk4_fp8(float a, float b, float c, float d) {
    a = fminf(fmaxf(a, -448.f), 448.f); b = fminf(fmaxf(b, -448.f), 448.f); c = fminf(fmaxf(c, -448.f), 448.f); d = fminf(fmaxf(d, -448.f), 448.f);
    int p = 0; p = __builtin_amdgcn_cvt_pk_fp8_f32(a, b, p, false); p = __builtin_amdgcn_cvt_pk_fp8_f32(c, d, p, true); return (unsigned)p; }
__device__ __forceinline__ float rcp_(float x) { return __builtin_amdgcn_rcpf(x); }
__device__ __forceinline__ float sigmoidf_(float x) { return rcp_(1.0f + __expf(-x)); }

#define XB_TMO      128
#define XB_XCNT(j)  (256  + 64 * (j))
#define XB_XSUB(j)  (1280 + 64 * (j))
#define XB_XGEN(j)  (2304 + 64 * (j))
#define XB_TOP      3328
#define XB_TOPGEN   3392
#define XCD_BAR_WORDS 3456
#define XB_SPIN_CAP (1u << 18)

__device__ __forceinline__ unsigned xb_ld(unsigned* p)              { return __hip_atomic_load(p, __ATOMIC_RELAXED, __HIP_MEMORY_SCOPE_AGENT); }
__device__ __forceinline__ unsigned xb_add(unsigned* p, unsigned v) { return __hip_atomic_fetch_add(p, v, __ATOMIC_RELAXED, __HIP_MEMORY_SCOPE_AGENT); }
__device__ __forceinline__ unsigned xb_xcc_id() { return (unsigned)__builtin_amdgcn_s_getreg((3 << 11) | 20) & 0xFu; }
#define XB_SPIN(cond, bar) do { unsigned _sp = 0; while (cond) { __builtin_amdgcn_s_sleep(1); \
    if ((++_sp & 255u) == 0u) { if (xb_ld(&(bar)[XB_TMO])) break; if (_sp > XB_SPIN_CAP) { atomicAdd(&(bar)[XB_TMO], 1u); break; } } } } while (0)

struct XcdBarrier {
    unsigned* bar; unsigned x;
    volatile LAS unsigned* st;
};

__device__ __forceinline__ XcdBarrier xcd_barrier_post(unsigned* bar, volatile LAS unsigned* st, bool leader) {
    XcdBarrier b; b.bar = bar; b.x = xb_xcc_id(); b.st = st;
    if (leader) (void)xb_add(&bar[XB_XCNT(b.x)], 1u);
    return b;
}
__device__ __forceinline__ void xcd_barrier_complete(unsigned* bar, unsigned x, unsigned& nloc, unsigned& nx) {
    const unsigned G = gridDim.x * gridDim.y * gridDim.z;
    unsigned sum, cnt, mine, sp = 0u;
    for (;;) {
        sum = 0u; cnt = 0u; mine = 0u;
#pragma unroll
        for (unsigned j = 0; j < 16; ++j) { const unsigned c = xb_ld(&bar[XB_XCNT(j)]); sum += c; cnt += (c > 0u) ? 1u : 0u; mine = (j == x) ? c : mine; }
        if (sum == G) break;
        __builtin_amdgcn_s_sleep(1);
        if ((++sp & 255u) == 0u) { if (xb_ld(&bar[XB_TMO])) break; if (sp > XB_SPIN_CAP) { atomicAdd(&bar[XB_TMO], 1u); break; } }
    }
    nloc = mine > 0u ? mine : 1u; nx = cnt > 0u ? cnt : 1u;
}

__device__ __forceinline__ void xcd_barrier(const XcdBarrier& b_, bool leader) {
    XcdBarrier b = b_; asm volatile("" : "+s"(b.x));
    asm volatile("s_waitcnt vmcnt(0)" ::: "memory");
    __syncthreads();
    if (leader) {
        unsigned* bar = b.bar;
        __builtin_amdgcn_s_waitcnt(0);
        unsigned nloc = b.st[0], nx = b.st[1];
        if (nloc == 0u) { xcd_barrier_complete(bar, b.x, nloc, nx); b.st[0] = nloc; b.st[1] = nx; }
        const unsigned old = xb_add(&bar[XB_XSUB(b.x)], 1u);
        const unsigned gen = old / nloc;
        if (old + 1u == (gen + 1u) * nloc) {
            __builtin_amdgcn_fence(__ATOMIC_RELEASE, "agent");
            asm volatile("s_waitcnt vmcnt(0)" ::: "memory");
            const unsigned og = xb_add(&bar[XB_TOP], 1u);
            const unsigned tg = og / nx;
            if (og + 1u == (tg + 1u) * nx) xb_add(&bar[XB_TOPGEN], 1u);
            else XB_SPIN(xb_ld(&bar[XB_TOPGEN]) == tg, bar);
            __builtin_amdgcn_fence(__ATOMIC_ACQUIRE, "agent");
            xb_add(&bar[XB_XGEN(b.x)], 1u);
            asm volatile("s_waitcnt vmcnt(0)" ::: "memory");
        } else {
            XB_SPIN(xb_ld(&bar[XB_XGEN(b.x)]) == gen, bar);
            __builtin_amdgcn_fence(__ATOMIC_ACQUIRE, "agent");
            asm volatile("s_waitcnt vmcnt(0)" ::: "memory");
        }
    }
    __syncthreads();
}

namespace moba {
using bf16x8=__attribute__((ext_vector_type(8)))short;
using s16x4=__attribute__((ext_vector_type(4)))short;
using f32x16=__attribute__((ext_vector_type(16)))float;
using u32x4=__attribute__((ext_vector_type(4)))unsigned;
typedef unsigned short bf16raw;
constexpr int SEQL=4096,NHEAD=8,HDIM=64,DM=7168;
constexpr int COLQ=1536,COLK=2048,COLV=2560;
constexpr int NW=8,QBLK=32,QB=QBLK*NW,KVBLK=64;
__device__ __forceinline__ int crow(int r,int hi){return (r&3)+8*(r>>2)+4*hi;}
#define SBAR() __builtin_amdgcn_sched_barrier(0)
__device__ __forceinline__ void cmask(f32x16&p0,f32x16&p1,int jb,int qrel,int hi){
  const float NEG=-INFINITY; int kb=64*jb+4*hi;
  #pragma unroll
  for(int r=0;r<16;++r){int kv=kb+(r&3)+8*(r>>2); if(kv>qrel)p0[r]=NEG; if(kv+32>qrel)p1[r]=NEG;}
}
constexpr int NSLOT=3, SLOTB=8192;
constexpr int LDS_K=0, LDS_V=NSLOT*SLOTB, LDS_WS=2*NSLOT*SLOTB, LDS_OST=LDS_WS+NW*64*4, LDS_KM=LDS_OST+NW*4096, LDS_BYTES=LDS_KM+4096;
__device__ __forceinline__ void glds16(const void*gsrc,unsigned lds_dst){unsigned keep;
  asm volatile("s_mov_b32 %0, m0\n\ts_mov_b32 m0, %2\n\ts_nop 0\n\tglobal_load_lds_dwordx4 %1, off\n\ts_mov_b32 m0, %0":"=&s"(keep):"v"(gsrc),"s"(lds_dst):"memory");}
typedef float f32x2_t __attribute__((ext_vector_type(2))); typedef __bf16 bf16x2_t __attribute__((ext_vector_type(2)));
__device__ __forceinline__ unsigned cvtpk_s(float lo,float hi){f32x2_t v={lo,hi};bf16x2_t b=__builtin_convertvector(v,bf16x2_t);return __builtin_bit_cast(unsigned,b);}
#define WAIT_BAR(N) asm volatile("s_waitcnt vmcnt(" #N ") lgkmcnt(0)\n\ts_barrier":::"memory")

__device__ __forceinline__ void qkt(f32x16&p0,f32x16&p1,const char*Kslot,const bf16x8*qr,int r32,int hi){
  const char*kb=Kslot+hi*1024+r32*16; const f32x16 zf=f32x16{};
  #pragma unroll
  for(int d0=0;d0<4;++d0){
    const bf16x8 b0=*reinterpret_cast<const bf16x8*>(kb+d0*2048);
    const bf16x8 b1=*reinterpret_cast<const bf16x8*>(kb+d0*2048+512);
    if(d0==0){p0=__builtin_amdgcn_mfma_f32_32x32x16_bf16(b0,qr[0],zf,0,0,0);p1=__builtin_amdgcn_mfma_f32_32x32x16_bf16(b1,qr[0],zf,0,0,0);}
    else{p0=__builtin_amdgcn_mfma_f32_32x32x16_bf16(b0,qr[d0],p0,0,0,0);p1=__builtin_amdgcn_mfma_f32_32x32x16_bf16(b1,qr[d0],p1,0,0,0);}}
}
typedef __attribute__((address_space(3))) const char* lds_cptr;
typedef short v4i16_t __attribute__((ext_vector_type(4)));
__device__ __forceinline__ void kload8(bf16x8*kf,lds_cptr kp){
  kf[0]=*(const __attribute__((address_space(3))) bf16x8*)(kp);      kf[1]=*(const __attribute__((address_space(3))) bf16x8*)(kp+512);
  kf[2]=*(const __attribute__((address_space(3))) bf16x8*)(kp+2048); kf[3]=*(const __attribute__((address_space(3))) bf16x8*)(kp+2560);
  kf[4]=*(const __attribute__((address_space(3))) bf16x8*)(kp+4096); kf[5]=*(const __attribute__((address_space(3))) bf16x8*)(kp+4608);
  kf[6]=*(const __attribute__((address_space(3))) bf16x8*)(kp+6144); kf[7]=*(const __attribute__((address_space(3))) bf16x8*)(kp+6656);
}
__device__ __forceinline__ void kload2(bf16x8*kf,lds_cptr kp,int j){ kf[2*j]=*(const __attribute__((address_space(3))) bf16x8*)(kp+j*2048); kf[2*j+1]=*(const __attribute__((address_space(3))) bf16x8*)(kp+j*2048+512); }
__device__ __forceinline__ s16x4 vtr(lds_cptr p){ return __builtin_bit_cast(s16x4,__builtin_amdgcn_ds_read_tr16_b64_v4i16((__attribute__((address_space(3))) v4i16_t*)p)); }
__device__ __forceinline__ void pv(f32x16*o,int vb,bf16x8 pa0,bf16x8 pa1,bf16x8 pa2,bf16x8 pa3){
  #pragma unroll
  for(int d0=0;d0<2;++d0){s16x4 lo[4],hi[4];
    #pragma unroll
    for(int ks=0;ks<4;++ks){
      asm volatile("ds_read_b64_tr_b16 %0,%1 offset:%c2":"=&v"(lo[ks]):"v"(vb),"i"(d0*4096+ks*1024):"memory");
      asm volatile("ds_read_b64_tr_b16 %0,%1 offset:%c2":"=&v"(hi[ks]):"v"(vb),"i"(d0*4096+ks*1024+512):"memory");}
    asm volatile("s_waitcnt lgkmcnt(0)":::"memory");SBAR();
    #define PK(k) (bf16x8){lo[k][0],lo[k][1],lo[k][2],lo[k][3],hi[k][0],hi[k][1],hi[k][2],hi[k][3]}
    o[d0]=__builtin_amdgcn_mfma_f32_32x32x16_bf16(pa0,PK(0),o[d0],0,0,0);
    o[d0]=__builtin_amdgcn_mfma_f32_32x32x16_bf16(pa1,PK(1),o[d0],0,0,0);
    o[d0]=__builtin_amdgcn_mfma_f32_32x32x16_bf16(pa2,PK(2),o[d0],0,0,0);
    o[d0]=__builtin_amdgcn_mfma_f32_32x32x16_bf16(pa3,PK(3),o[d0],0,0,0);
    #undef PK
  }
}
__device__ __forceinline__ float bfl(short s){return __uint_as_float(((unsigned)(unsigned short)s)<<16);}

__device__ __forceinline__ void moba_unit(int tid_in,int b,int h,int qb,bf16raw*P,const float*KM,char*shm,int ocol=COLQ){
  int tid=tid_in; asm volatile("":"+v"(tid));
  const int lane=tid&63,r32=lane&31,hi=lane>>5; const int wid=__builtin_amdgcn_readfirstlane(tid>>6);
  const long rowbase=(long)b*SEQL; const int q0=qb*QB;
  bf16raw*Qw=P+(rowbase+q0+wid*QBLK)*DM+COLQ+h*HDIM;
  const bf16raw*Kh=P+rowbase*DM+COLK+h*HDIM,*Vh=P+rowbase*DM+COLV+h*HDIM;
  const unsigned lds0=(unsigned)(uintptr_t)shm;
  float*wsf=(float*)(shm+LDS_WS)+wid*64;
  bf16x8 qr[4];
  #pragma unroll
  for(int d0=0;d0<4;++d0)qr[d0]=*reinterpret_cast<const bf16x8*>(&Qw[(long)r32*DM+d0*16+hi*8]);
  unsigned selbits=(1u<<qb)-1u;
  if(qb>3){
    float*kml=(float*)(shm+LDS_KM);
    { const float*src=KM+(long)((b*NHEAD+h)*16)*HDIM; const f32x2_t v=*(const f32x2_t*)(src+2*tid); *(f32x2_t*)(kml+2*tid)=v; }
    asm volatile("s_waitcnt vmcnt(0) lgkmcnt(0)\n\ts_barrier":::"memory");
    float qf[32];
    #pragma unroll
    for(int d0=0;d0<4;++d0)
      #pragma unroll
      for(int e=0;e<8;++e)qf[d0*8+e]=bfl(qr[d0][e]);
    float g0=-INFINITY,g1=-INFINITY,g2=-INFINITY; int s0=0,s1=0,s2=0;
    for(int jb=0;jb<qb;++jb){
      const float*kr=kml+jb*64+hi*8; float g=0.f;
      #pragma unroll
      for(int d0=0;d0<4;++d0){ const f32x2_t*k2=(const f32x2_t*)(kr+d0*16);
        #pragma unroll
        for(int e=0;e<4;++e){ const f32x2_t kv=k2[e]; g+=qf[d0*8+2*e]*kv.x; g+=qf[d0*8+2*e+1]*kv.y; } }
      {auto rr=__builtin_amdgcn_permlane32_swap(__float_as_uint(g),__float_as_uint(g),false,false);g=__uint_as_float(rr[0])+__uint_as_float(rr[1]);}
      if(g>g0){g2=g1;s2=s1;g1=g0;s1=s0;g0=g;s0=jb;} else if(g>g1){g2=g1;s2=s1;g1=g;s1=jb;} else if(g>g2){g2=g;s2=jb;}
    }
    selbits=(1u<<s0)|(1u<<s1)|(1u<<s2);
  }
  #define TMASK(t) (((t)<4)?0xffffffffu:(0u-((selbits>>(((t)-4)>>2))&1u)))
  const bf16raw*ksrc=Kh+(long)lane*DM+wid*8;
  const bf16raw*vsrc=Vh+(long)(16*(wid&3)+(lane>>2))*DM+(wid>>2)*32+(lane&3)*8;
  const unsigned kdst=lds0+LDS_K+wid*1024, vdst=lds0+LDS_V+wid*1024;
  #define KT(t) (((t)<4)?(4*qb+(t)):((t)-4))
  #define DMA_K(t,slot) glds16(ksrc+(long)KT(t)*KVBLK*DM,(unsigned)__builtin_amdgcn_readfirstlane(kdst+(slot)))
  #define DMA_V(t,slot) glds16(vsrc+(long)KT(t)*KVBLK*DM,(unsigned)__builtin_amdgcn_readfirstlane(vdst+(slot)))
  const char*Kbase=shm+LDS_K; bf16x8 kf[8];
  const lds_cptr shm3=(lds_cptr)shm; const lds_cptr kp0=shm3+LDS_K+hi*1024+r32*16; const lds_cptr vp0=shm3+LDS_V+((lane>>4)&1)*32+(lane&3)*8+(4*hi+((lane&15)>>2))*64;
  const int vb0=(int)(lds0+LDS_V)+((lane>>4)&1)*32+(lane&3)*8+(4*hi+((lane&15)>>2))*64;
  const int NT=4*qb+4;
  DMA_K(0,0);DMA_V(0,0);DMA_K(1,SLOTB);
  float l_reg=0.f;f32x16 o[2];o[0]=f32x16{};o[1]=f32x16{};
  const int qrel=wid*QBLK+r32;
  f32x16 pA0,pA1,pB0,pB1;
  int sl_prev=0,sl_cur=0,sl_next=SLOTB;
  #define ROT() do{sl_prev=sl_cur;sl_cur=sl_next;sl_next=(sl_next==(NSLOT-1)*SLOTB)?0:sl_next+SLOTB;}while(0)
  DMA_K(2,2*SLOTB);
  WAIT_BAR(3);
  qkt(pA0,pA1,Kbase,qr,r32,hi);asm volatile("s_nop 15\n\ts_nop 7":"+v"(pA0),"+v"(pA1));cmask(pA0,pA1,0,qrel,hi);
  _Pragma("unroll") for(int r=0;r<16;++r){pA0[r]=__builtin_amdgcn_exp2f(pA0[r]);pA1[r]=__builtin_amdgcn_exp2f(pA1[r]);}
  WAIT_BAR(0);
  DMA_K(3,0);DMA_V(1,SLOTB);
  ROT();
  kload8(kf,kp0+sl_cur);
  WAIT_BAR(2);
  s16x4 vlo[8],vhi[8]; u32x4 pw0,pw1,pw2,pw3;
  const f32x16 zf=f32x16{};
  #define PKW(P,B) (cvtpk_s(P[B],P[B+1])&mprev_)
  #define PAF(k) __builtin_bit_cast(bf16x8,pw##k)
  #define VFR(i) (bf16x8){vlo[i][0],vlo[i][1],vlo[i][2],vlo[i][3],vhi[i][0],vhi[i][1],vhi[i][2],vhi[i][3]}
  #define PIN(x) asm volatile("":"+v"(x))
  #define GAPA(MF,A0,A1,A2,A3,W0,W1,PW) do{ MF; sacc+=A0; sacc+=A1; sacc+=A2; sacc+=A3; PIN(sacc); W0; W1; PIN(PW); SBAR(); }while(0)
  #define EX(v) __builtin_amdgcn_exp2f(v)
  #define GAPB(MF,X,B) do{ MF; X[B]=EX(X[B]); X[B+1]=EX(X[B+1]); X[B+2]=EX(X[B+2]); X[B+3]=EX(X[B+3]); PIN(X); SBAR(); }while(0)
  #define VRD(i) do{ vlo[i]=vtr(vp_+(((i)>>2)*4096+((i)&3)*1024)); vhi[i]=vtr(vp_+(((i)>>2)*4096+((i)&3)*1024+512)); }while(0)
  #define KRD(G,j) do{ if(G){ kload2(kf,kp0+sl_next,j); SBAR(); } }while(0)
  #define STEP(C0,C1,P0,P1,t,GK,GV,GL,CM) do{ SBAR(); \
    const unsigned mprev_=TMASK((t)-1); \
    const lds_cptr vp_=vp0+sl_prev; \
    VRD(0); SBAR(); float sacc=(P0[0]+P0[1]); \
    GAPA(C0=__builtin_amdgcn_mfma_f32_32x32x16_bf16(kf[0],qr[0],zf,0,0,0), P0[2],P0[3],P0[4],P0[5],     pw0[0]=PKW(P0,0), pw0[1]=PKW(P0,2), pw0); \
    VRD(4); SBAR(); GAPA(C1=__builtin_amdgcn_mfma_f32_32x32x16_bf16(kf[1],qr[0],zf,0,0,0), P0[6],P0[7],P0[8],P0[9],     pw0[2]=PKW(P0,4), pw0[3]=PKW(P0,6), pw0); \
    VRD(1); SBAR(); GAPA(C0=__builtin_amdgcn_mfma_f32_32x32x16_bf16(kf[2],qr[1],C0,0,0,0),   P0[10],P0[11],P0[12],P0[13], pw1[0]=PKW(P0,8), pw1[1]=PKW(P0,10), pw1); \
    VRD(5); SBAR(); GAPA(C1=__builtin_amdgcn_mfma_f32_32x32x16_bf16(kf[3],qr[1],C1,0,0,0),   P0[14],P0[15],P1[0],P1[1],   pw1[2]=PKW(P0,12),pw1[3]=PKW(P0,14), pw1); \
    VRD(2); SBAR(); GAPA(C0=__builtin_amdgcn_mfma_f32_32x32x16_bf16(kf[4],qr[2],C0,0,0,0),   P1[2],P1[3],P1[4],P1[5],     pw2[0]=PKW(P1,0), pw2[1]=PKW(P1,2), pw2); \
    VRD(6); SBAR(); GAPA(C1=__builtin_amdgcn_mfma_f32_32x32x16_bf16(kf[5],qr[2],C1,0,0,0),   P1[6],P1[7],P1[8],P1[9],     pw2[2]=PKW(P1,4), pw2[3]=PKW(P1,6), pw2); \
    VRD(3); SBAR(); GAPA(C0=__builtin_amdgcn_mfma_f32_32x32x16_bf16(kf[6],qr[3],C0,0,0,0),   P1[10],P1[11],P1[12],P1[13], pw3[0]=PKW(P1,8), pw3[1]=PKW(P1,10), pw3); \
    VRD(7); SBAR(); GAPA(C1=__builtin_amdgcn_mfma_f32_32x32x16_bf16(kf[7],qr[3],C1,0,0,0),   P1[14],P1[15],0.f,0.f,       pw3[2]=PKW(P1,12),pw3[3]=PKW(P1,14), pw3); \
    l_reg+=__uint_as_float(__float_as_uint(sacc)&mprev_); \
    if(GK){DMA_K((t)+3,sl_cur);} if(GV){DMA_V((t)+1,sl_next);} \
    if(CM){cmask(C0,C1,(t),qrel,hi);} \
    SBAR(); \
    GAPB(o[0]=__builtin_amdgcn_mfma_f32_32x32x16_bf16(PAF(0),VFR(0),o[0],0,0,0), C0,0); \
    GAPB(o[1]=__builtin_amdgcn_mfma_f32_32x32x16_bf16(PAF(0),VFR(4),o[1],0,0,0), C0,4); \
    KRD(GL,0); GAPB(o[0]=__builtin_amdgcn_mfma_f32_32x32x16_bf16(PAF(1),VFR(1),o[0],0,0,0), C0,8); \
    KRD(GL,1); GAPB(o[1]=__builtin_amdgcn_mfma_f32_32x32x16_bf16(PAF(1),VFR(5),o[1],0,0,0), C0,12); \
    KRD(GL,2); GAPB(o[0]=__builtin_amdgcn_mfma_f32_32x32x16_bf16(PAF(2),VFR(2),o[0],0,0,0), C1,0); \
    KRD(GL,3); GAPB(o[1]=__builtin_amdgcn_mfma_f32_32x32x16_bf16(PAF(2),VFR(6),o[1],0,0,0), C1,4); \
    GAPB(o[0]=__builtin_amdgcn_mfma_f32_32x32x16_bf16(PAF(3),VFR(3),o[0],0,0,0), C1,8); \
    GAPB(o[1]=__builtin_amdgcn_mfma_f32_32x32x16_bf16(PAF(3),VFR(7),o[1],0,0,0), C1,12); \
    }while(0)
  #define ENDW(tt) do{ if((tt)+3<NT){WAIT_BAR(2);} else if((tt)+2<NT){WAIT_BAR(1);} else {WAIT_BAR(0);} }while(0)
  STEP(pB0,pB1,pA0,pA1,1,(4<NT),true,true,true);          ENDW(1); ROT();
  STEP(pA0,pA1,pB0,pB1,2,(5<NT),true,true,true);          ENDW(2); ROT();
  STEP(pB0,pB1,pA0,pA1,3,(6<NT),(4<NT),(4<NT),true);
  if(NT>4){
    ENDW(3); ROT();
    int t=4;
    for(;t+5<NT;t+=2){
      STEP(pA0,pA1,pB0,pB1,t,true,true,true,false);     WAIT_BAR(2); ROT();
      STEP(pB0,pB1,pA0,pA1,t+1,true,true,true,false);   WAIT_BAR(2); ROT();
    }
    for(;t+2<NT;t+=2){
      STEP(pA0,pA1,pB0,pB1,t,(t+3<NT),(t+1<NT),(t+1<NT),false);       ENDW(t);   ROT();
      STEP(pB0,pB1,pA0,pA1,t+1,(t+4<NT),(t+2<NT),(t+2<NT),false);     ENDW(t+1); ROT();
    }
    STEP(pA0,pA1,pB0,pB1,t,false,true,true,false);      ENDW(t); ROT();
    STEP(pB0,pB1,pA0,pA1,t+1,false,false,false,false);
  }
  { const unsigned mprev_=TMASK(NT-1);
    float sacc=pB0[0]+pB0[1]; _Pragma("unroll") for(int r=2;r<16;++r)sacc+=pB0[r]; _Pragma("unroll") for(int r=0;r<16;++r)sacc+=pB1[r]; l_reg+=__uint_as_float(__float_as_uint(sacc)&mprev_);
    pw0=(u32x4){PKW(pB0,0),PKW(pB0,2),PKW(pB0,4),PKW(pB0,6)};pw1=(u32x4){PKW(pB0,8),PKW(pB0,10),PKW(pB0,12),PKW(pB0,14)};pw2=(u32x4){PKW(pB1,0),PKW(pB1,2),PKW(pB1,4),PKW(pB1,6)};pw3=(u32x4){PKW(pB1,8),PKW(pB1,10),PKW(pB1,12),PKW(pB1,14)};
    SBAR(); pv(o,vb0+sl_cur,PAF(0),PAF(1),PAF(2),PAF(3)); }
  #undef PKW
  #undef PAF
  #undef VFR
  #undef PIN
  #undef GAPA
  #undef GAPB
  #undef EX
  #undef VRD
  #undef KRD
  #undef STEP
  #undef ENDW
  {auto rr=__builtin_amdgcn_permlane32_swap(__float_as_uint(l_reg),__float_as_uint(l_reg),false,false);l_reg=__uint_as_float(rr[0])+__uint_as_float(rr[1]);}
  if(hi==0)wsf[32+r32]=l_reg;asm volatile("s_waitcnt lgkmcnt(0)":::"memory");
  float rli[16];
  #pragma unroll
  for(int r=0;r<16;++r)rli[r]=__builtin_amdgcn_rcpf(wsf[32+crow(r,hi)]);
  { bf16raw*stg=(bf16raw*)(shm+LDS_OST)+wid*2048;
    #pragma unroll
    for(int r=0;r<16;++r){const int orow=crow(r,hi);
      #pragma unroll
      for(int d0=0;d0<2;++d0)stg[orow*64+d0*32+r32]=(bf16raw)(cvtpk_s(o[d0][r]*rli[r],0.f)&0xffffu);}
    asm volatile("s_waitcnt lgkmcnt(0)":::"memory");
    #pragma unroll
    for(int i=0;i<4;++i){const int row=i*8+(lane>>3),ch=lane&7; const u32x4 v=*(const u32x4*)(stg+row*64+ch*8); *(u32x4*)(Qw+(ocol-COLQ)+(long)row*DM+ch*8)=v;} }
  asm volatile("s_waitcnt lgkmcnt(0)\n\ts_barrier":::"memory");
  #undef DMA_K
  #undef DMA_V
  #undef KT
  #undef TMASK
  #undef ROT
}
#undef SBAR
#undef WAIT_BAR
}

constexpr int NWAVES = 8, NTHR = NWAVES * 64;
#ifndef MK_ONE_LAUNCH
#define MK_ONE_LAUNCH 1
#endif
constexpr int BATCH = 8, SEQ = 4096, D = 1024, M = BATCH * SEQ;
constexpr int NCOL = 7168;
constexpr int C_XA = 0, C_BA = 512, C_CA = 1024, C_Q = 1536, C_K = 2048, C_V = 2560, C_XC = 3072, C_GC = 3584, C_G = 4096;
constexpr int NH = 8, HD = 64, BLK = 256, NBLK = SEQ / BLK;
constexpr int DFF = 2816, EFF = 3584, NEXP = 8;
constexpr int LCH = 64, NCH = SEQ / LCH;
constexpr float EPS = 1e-6f;
constexpr float QSCALE = 0.18033688011112042f;
constexpr int MOE_TILES = 136, MOE_ROWS = MOE_TILES * 256;
constexpr int N_PHASES = 22;

constexpr size_t MiB = 1u << 20;
constexpr size_t WS_CTL = 0, CTL_ZERO_BYTES = 1 * MiB;
constexpr size_t WS_ROPE = 1 * MiB;
constexpr size_t WS_KMEAN = 1 * MiB + 256 * 1024;
constexpr size_t WS_SUM = 2 * MiB;
constexpr size_t WS_TOK = 4 * MiB;
constexpr size_t WS_WL = 6 * MiB;
constexpr size_t WS_ROWTOK = 8 * MiB;
constexpr size_t WS_ROWW = 8 * MiB + 256 * 1024;
constexpr size_t WS_XB = 9 * MiB;
constexpr size_t WS_WIN = 73 * MiB;
constexpr size_t WS_WOABC = 87 * MiB;
constexpr size_t WS_WO = 90 * MiB;
constexpr size_t WS_FGU = 92 * MiB;
constexpr size_t WS_FDN = 103 * MiB;
constexpr size_t WS_P = 109 * MiB;
constexpr size_t WS_HID0 = WS_P;
constexpr float SC_X8 = 8.f, SC_W8 = 64.f, SC_H8 = 8.f;
constexpr size_t WS_MGU = 73 * MiB;
constexpr size_t WS_MDN = 129 * MiB;
constexpr size_t WS_MH = 157 * MiB;
constexpr size_t WS_XG = 276 * MiB;
constexpr size_t WS_END = 557 * MiB;
static_assert(WS_P + (size_t)M * NCOL * 2 <= WS_END && WS_XG + (size_t)MOE_ROWS * D <= WS_END && WS_MH + (size_t)MOE_ROWS * EFF <= WS_XG && WS_MGU + (size_t)8 * 7168 * D <= WS_MDN && WS_MDN + (size_t)8 * D * EFF <= WS_MH && WS_FDN + (size_t)D * DFF * 2 <= WS_P, "d_ws map");
constexpr int CW_BAR = 4096;
constexpr int CW_CNT = 16384;

constexpr int RING_BYTES = 131072;
constexpr int MISC_OFF = 147456 - 256;
constexpr int LDS_BYTES = 147456;

struct Args { const float* in[25]; float* out; unsigned char* ws; int ph_lo, ph_hi; };
struct Ctx { LAS unsigned char* lds; int tid, lane, wave, bid, G; };

__device__ __forceinline__ float shx(float v, int o, int lane) { return __int_as_float(__builtin_amdgcn_ds_bpermute((lane ^ o) << 2, __float_as_int(v))); }
__device__ __forceinline__ float wave_sum(float v, int lane) {
#pragma unroll
    for (int o = 1; o < 64; o <<= 1) v += shx(v, o, lane);
    return v;
}

struct ConvJob { const float* W; int ldw; bf16* WT; int ldk, k0, n0, dst; bool f8; };
__device__ __forceinline__ void conv_load(const ConvJob& j, float (&tv)[32], int lane) {
#pragma unroll
    for (int i = 0; i < 32; ++i) tv[i] = j.W[(size_t)(j.k0 + 2 * i + (lane >> 5)) * j.ldw + j.n0 + (lane & 31)];
}
__device__ __forceinline__ void conv_store(const ConvJob& j, const float (&tv)[32], LAS float* scr, int lane) {
#pragma unroll
    for (int i = 0; i < 32; ++i) scr[(2 * i + (lane >> 5)) * 33 + (lane & 31)] = tv[i];
    LDS_WAIT(); asm volatile("" ::: "memory");
    const int c = lane & 7;
#pragma unroll
    for (int q = 0; q < 4; ++q) { const int n = (lane >> 3) + 8 * q; const LAS float* s = scr + (8 * c) * 33 + n;
        v4u o; o.x = pk2(s[0 * 33], s[1 * 33]); o.y = pk2(s[2 * 33], s[3 * 33]); o.z = pk2(s[4 * 33], s[5 * 33]); o.w = pk2(s[6 * 33], s[7 * 33]);
        *(GAS v4u*)(j.WT + (size_t)(j.dst + n) * j.ldk + j.k0 + 8 * c) = o; }
    LDS_WAIT(); asm volatile("" ::: "memory");
}
__device__ __forceinline__ void conv_store8(const ConvJob& j, const float (&tv)[32], LAS float* scr, int lane) {
#pragma unroll
    for (int i = 0; i < 32; ++i) scr[(2 * i + (lane >> 5)) * 33 + (lane & 31)] = tv[i];
    LDS_WAIT(); asm volatile("" ::: "memory");
    const int c = lane & 3; unsigned char* WT8 = (unsigned char*)j.WT;
#pragma unroll
    for (int q = 0; q < 2; ++q) { const int n = (lane >> 2) + 16 * q; const LAS float* s = scr + (16 * c) * 33 + n;
        v4u o; o.x = pk4_fp8(s[0 * 33] * SC_W8, s[1 * 33] * SC_W8, s[2 * 33] * SC_W8, s[3 * 33] * SC_W8); o.y = pk4_fp8(s[4 * 33] * SC_W8, s[5 * 33] * SC_W8, s[6 * 33] * SC_W8, s[7 * 33] * SC_W8);
        o.z = pk4_fp8(s[8 * 33] * SC_W8, s[9 * 33] * SC_W8, s[10 * 33] * SC_W8, s[11 * 33] * SC_W8); o.w = pk4_fp8(s[12 * 33] * SC_W8, s[13 * 33] * SC_W8, s[14 * 33] * SC_W8, s[15 * 33] * SC_W8);
        *(GAS v4u*)(WT8 + (size_t)(j.dst + n) * j.ldk + j.k0 + 16 * c) = o; }
    LDS_WAIT(); asm volatile("" ::: "memory");
}
__device__ __forceinline__ ConvJob conv_job(const float* W, int K, int N, bf16* WT, int mode, int item, bool f8 = false) {
    const int nblk = N / 32, kb = item / nblk, nb = item - kb * nblk, k0 = 64 * kb, n0 = 32 * nb;
    const int dst = mode == 0 ? n0 : (n0 >> 7) * 256 + (n0 & 127) + (mode == 2 ? 128 : 0);
    return ConvJob{W, N, WT, K, k0, n0, dst, f8};
}
__device__ __forceinline__ ConvJob layer_job(const Args& A, int l, int it) {
    constexpr int I_IN = 16 * 224, I_A = 8 * 32, I_O = 16 * 32, I_G = 16 * 88;
    unsigned char* ws = A.ws; int r = it;
    if (r < I_IN) { const bool gate = (r % 224) >= 128;
        return gate ? conv_job(A.in[2] + (size_t)l * D * NCOL, D, NCOL, (bf16*)(ws + WS_WIN + (size_t)4096 * D), 0, r, true) : conv_job(A.in[2] + (size_t)l * D * NCOL, D, NCOL, (bf16*)(ws + WS_WIN), 0, r); } r -= I_IN;
    if (r < I_A) return conv_job(A.in[4] + (size_t)l * 512 * D, 512, D, (bf16*)(ws + WS_WOABC), 0, r); r -= I_A;
    if (r < I_A) return conv_job(A.in[7] + (size_t)l * 512 * D, 512, D, (bf16*)(ws + WS_WOABC) + 1024 * 512, 0, r); r -= I_A;
    if (r < I_A) return conv_job(A.in[15] + (size_t)l * 512 * D, 512, D, (bf16*)(ws + WS_WOABC) + 2 * 1024 * 512, 0, r); r -= I_A;
    if (r < I_O) return conv_job(A.in[16] + (size_t)l * D * D, D, D, (bf16*)(ws + WS_WO), 0, r); r -= I_O;
    if (r < I_G) return conv_job(A.in[18], D, DFF, (bf16*)(ws + WS_FGU), 1, r); r -= I_G;
    if (r < I_G) return conv_job(A.in[19], D, DFF, (bf16*)(ws + WS_FGU), 2, r); r -= I_G;
    return conv_job(A.in[20], DFF, D, (bf16*)(ws + WS_FDN), 0, r);
}
__device__ __forceinline__ void convert_layer_weights(const Ctx& C, const Args& A, int l) {
    LAS float* scr = (LAS float*)(C.lds + C.wave * 16896);
    const int gw = C.bid * NWAVES + C.wave, NGW = C.G * NWAVES;
    constexpr int I_IN = 16 * 224, I_A = 8 * 32, I_O = 16 * 32, I_G = 16 * 88, I_D = 44 * 32;
    const int nitems = I_IN + 3 * I_A + I_O + (l == 0 ? 2 * I_G + I_D : 0);
    for (int it = gw; it < nitems; it += 2 * NGW) {
        const bool two = it + NGW < nitems;
        const ConvJob j0 = layer_job(A, l, it), j1 = layer_job(A, l, two ? it + NGW : it);
        float t0[32], t1[32];
        conv_load(j0, t0, C.lane); if (two) conv_load(j1, t1, C.lane);
        if (j0.f8) conv_store8(j0, t0, scr, C.lane); else conv_store(j0, t0, scr, C.lane);
        if (two) { if (j1.f8) conv_store8(j1, t1, scr + 64 * 33, C.lane); else conv_store(j1, t1, scr + 64 * 33, C.lane); }
    }
}
__device__ __forceinline__ ConvJob moe_job(const Args& A, int it) {
    constexpr int I_G = 16 * 112, I_D = 56 * 32, PER_E = 2 * I_G + I_D;
    unsigned char* ws = A.ws; const int e = it / PER_E; int r = it - e * PER_E;
    if (r < I_G) return conv_job(A.in[22] + (size_t)e * D * EFF, D, EFF, (bf16*)(ws + WS_MGU + (size_t)e * 7168 * D), 1, r); r -= I_G;
    if (r < I_G) return conv_job(A.in[23] + (size_t)e * D * EFF, D, EFF, (bf16*)(ws + WS_MGU + (size_t)e * 7168 * D), 2, r); r -= I_G;
    return conv_job(A.in[24] + (size_t)e * EFF * D, EFF, D, (bf16*)(ws + WS_MDN + (size_t)e * D * EFF), 0, r);
}
__device__ __forceinline__ void convert_moe_weights(const Ctx& C, const Args& A) {
    LAS float* scr = (LAS float*)(C.lds + C.wave * 16896);
    const int gw = C.bid * NWAVES + C.wave, NGW = C.G * NWAVES;
    constexpr int NIT = NEXP * (2 * 16 * 112 + 56 * 32);
    for (int it = gw; it < NIT; it += 2 * NGW) {
        const bool two = it + NGW < NIT;
        const ConvJob j0 = moe_job(A, it), j1 = moe_job(A, two ? it + NGW : it);
        float t0[32], t1[32];
        conv_load(j0, t0, C.lane); if (two) conv_load(j1, t1, C.lane);
        conv_store8(j0, t0, scr, C.lane); if (two) conv_store8(j1, t1, scr + 64 * 33, C.lane);
    }
}
__device__ __forceinline__ void rope_table(const Ctx& C, unsigned char* ws) {
    const double invf_rev[8] = {0.15915494309189535, 0.03086376340470123, 0.005985185712713705, 0.001160663641240061,
                                0.00022507907903927653, 4.364795279280289e-05, 8.464330808241401e-06, 1.6414262627950345e-06};
    float* ct = (float*)(ws + WS_ROPE); float* st = ct + SEQ * 8;
    for (int g = C.bid * NTHR + C.tid; g < SEQ * 8; g += C.G * NTHR) {
        const int pos = g >> 3, i = g & 7;
        double f = invf_rev[0];
#pragma unroll
        for (int k = 1; k < 8; ++k) f = (i == k) ? invf_rev[k] : f;
        double t = (double)pos * f; t -= floor(t);
        ct[g] = __builtin_amdgcn_cosf((float)t); st[g] = __builtin_amdgcn_sinf((float)t);
    }
}

template <bool ROUTE, bool ALSO8>
__device__ __forceinline__ void norm_rows(const Ctx& C, const float* xin, const float* gain, bf16* XN, const float* router, unsigned char* ws, unsigned char* X8 = nullptr) {
    constexpr int RB = 4;
    const int gw = C.bid * NWAVES + C.wave, NGW = C.G * NWAVES;
    LAS float* R = (LAS float*)C.lds;
    LAS int* rt_tok = (LAS int*)(C.lds + 32768); LAS int* rt_e = rt_tok + 256; LAS float* rt_w = (LAS float*)(rt_e + 256);
    if (ROUTE) { for (int i = C.tid; i < D * NEXP / 4; i += NTHR) ((LAS f32x4*)R)[i] = ((const f32x4*)router)[i];
                 for (int i = C.tid; i < 256; i += NTHR) rt_tok[i] = -1;
                 __syncthreads(); }
    f32x4 g[4];
#pragma unroll
    for (int j = 0; j < 4; ++j) g[j] = ((const f32x4*)gain)[C.lane + 64 * j];
    int slot = C.wave;
    for (int m0 = gw; m0 < M; m0 += RB * NGW) {
        f32x4 v[RB][4];
#pragma unroll
        for (int i = 0; i < RB; ++i) { const int m = m0 + i * NGW; if (m < M) { const GAS f32x4* xr = (const GAS f32x4*)(xin + (size_t)m * D) + C.lane;
#pragma unroll
            for (int j = 0; j < 4; ++j) v[i][j] = xr[64 * j]; } }
#pragma unroll
        for (int i = 0; i < RB; ++i) { const int m = m0 + i * NGW; if (m < M) {
            float s = 0.f;
#pragma unroll
            for (int j = 0; j < 4; ++j) s += (v[i][j].x * v[i][j].x + v[i][j].y * v[i][j].y) + (v[i][j].z * v[i][j].z + v[i][j].w * v[i][j].w);
            const float rstd = 1.0f / sqrtf(wave_sum(s, C.lane) * (1.f / D) + EPS);
            GAS unsigned long long* o8 = (GAS unsigned long long*)(XN + (size_t)m * D) + C.lane;
#pragma unroll
            for (int j = 0; j < 4; ++j) { v[i][j] = v[i][j] * rstd * g[j]; o8[64 * j] = (unsigned long long)pk2(v[i][j].x, v[i][j].y) | ((unsigned long long)pk2(v[i][j].z, v[i][j].w) << 32);
                if (ALSO8) ((unsigned*)(X8 + (size_t)m * D))[C.lane + 64 * j] = pk4_fp8(v[i][j].x * SC_X8, v[i][j].y * SC_X8, v[i][j].z * SC_X8, v[i][j].w * SC_X8); }
            if (ROUTE) {
                float lg[8];
#pragma unroll
                for (int e = 0; e < 8; ++e) lg[e] = 0.f;
#pragma unroll
                for (int j = 0; j < 4; ++j)
#pragma unroll
                    for (int k = 0; k < 4; ++k) { const int d = 4 * C.lane + k + 256 * j; const f32x4 r0 = *(LAS f32x4*)(R + d * 8), r1 = *(LAS f32x4*)(R + d * 8 + 4); const float h = v[i][j][k];
                        lg[0] += h * r0.x; lg[1] += h * r0.y; lg[2] += h * r0.z; lg[3] += h * r0.w; lg[4] += h * r1.x; lg[5] += h * r1.y; lg[6] += h * r1.z; lg[7] += h * r1.w; }
#pragma unroll
                for (int e = 0; e < 8; ++e) lg[e] = wave_sum(lg[e], C.lane);
                float l1 = -INFINITY, l2 = -INFINITY; int e1 = 0, e2 = 0;
#pragma unroll
                for (int e = 0; e < 8; ++e) if (lg[e] > l1) { l1 = lg[e]; e1 = e; }
#pragma unroll
                for (int e = 0; e < 8; ++e) if (e != e1 && lg[e] > l2) { l2 = lg[e]; e2 = e; }
                if (C.lane == 0 && slot < 256) { rt_tok[slot] = m; rt_e[slot] = e1 | (e2 << 8); rt_w[slot] = 1.0f / (1.0f + expf(l2 - l1)); }
                slot += NWAVES;
            } } }
    }
    if (ROUTE) {
        __syncthreads();
        if (C.tid < 16) {
            const int list = C.tid >> 3, e = C.tid & 7; int n = 0;
            for (int sidx = 0; sidx < 256; ++sidx) { const int t = rt_tok[sidx]; const int ee = (rt_e[sidx] >> (8 * list)) & 0xff; n += (t >= 0 && ee == e) ? 1 : 0; }
            gu32* cnt = (gu32*)(ws + WS_CTL) + CW_CNT; int* tokl = (int*)(ws + WS_TOK); float* wl = (float*)(ws + WS_WL);
            unsigned pos = n ? __hip_atomic_fetch_add(cnt + C.tid, (unsigned)n, RLX_AGENT) : 0u;
            for (int sidx = 0; sidx < 256; ++sidx) { const int t = rt_tok[sidx]; const int ee = (rt_e[sidx] >> (8 * list)) & 0xff;
                if (t >= 0 && ee == e) { const float w1 = rt_w[sidx]; tokl[(size_t)C.tid * M + pos] = t; wl[(size_t)C.tid * M + pos] = list == 0 ? w1 : 1.0f - w1; ++pos; } }
        }
        __syncthreads();
    }
}

template <bool ROUTE, bool ALSO8 = false>
__device__ __forceinline__ void norm_rows_b(const Ctx& C, const bf16* xin, const float* gain, bf16* XN, const float* router, unsigned char* ws, unsigned char* X8 = nullptr) {
    constexpr int RB = 4;
    const int gw = C.bid * NWAVES + C.wave, NGW = C.G * NWAVES;
    LAS float* R = (LAS float*)C.lds;
    LAS int* rt_tok = (LAS int*)(C.lds + 32768); LAS int* rt_e = rt_tok + 256; LAS float* rt_w = (LAS float*)(rt_e + 256);
    if (ROUTE) { for (int i = C.tid; i < D * NEXP / 4; i += NTHR) ((LAS f32x4*)R)[i] = ((const f32x4*)router)[i];
                 for (int i = C.tid; i < 256; i += NTHR) rt_tok[i] = -1;
                 __syncthreads(); }
    float g[16];
#pragma unroll
    for (int c = 0; c < 2; ++c) { const f32x4 a = *(const f32x4*)(gain + 512 * c + 8 * C.lane), b = *(const f32x4*)(gain + 512 * c + 8 * C.lane + 4);
        g[8 * c] = a.x; g[8 * c + 1] = a.y; g[8 * c + 2] = a.z; g[8 * c + 3] = a.w; g[8 * c + 4] = b.x; g[8 * c + 5] = b.y; g[8 * c + 6] = b.z; g[8 * c + 7] = b.w; }
    int slot = C.wave;
    for (int m0 = gw; m0 < M; m0 += RB * NGW) {
        v4u raw[RB][2];
#pragma unroll
        for (int i = 0; i < RB; ++i) { const int m = m0 + i * NGW; if (m < M) { const v4u* xr = (const v4u*)(xin + (size_t)m * D) + C.lane; raw[i][0] = xr[0]; raw[i][1] = xr[64]; } }
#pragma unroll
        for (int i = 0; i < RB; ++i) { const int m = m0 + i * NGW; if (m < M) {
            float v[16];
#pragma unroll
            for (int c = 0; c < 2; ++c) { const v4u w = raw[i][c]; v[8 * c] = bflo(w.x); v[8 * c + 1] = bfhi(w.x); v[8 * c + 2] = bflo(w.y); v[8 * c + 3] = bfhi(w.y); v[8 * c + 4] = bflo(w.z); v[8 * c + 5] = bfhi(w.z); v[8 * c + 6] = bflo(w.w); v[8 * c + 7] = bfhi(w.w); }
            float s = 0.f;
#pragma unroll
            for (int k = 0; k < 16; ++k) s += v[k] * v[k];
            const float rstd = 1.0f / sqrtf(wave_sum(s, C.lane) * (1.f / D) + EPS);
#pragma unroll
            for (int k = 0; k < 16; ++k) v[k] = v[k] * rstd * g[k];
            if (ROUTE) {
                v2u* o8 = (v2u*)((unsigned char*)XN + (size_t)m * D) + C.lane;
#pragma unroll
                for (int c = 0; c < 2; ++c) { v2u w; w.x = pk4_fp8(v[8 * c] * SC_X8, v[8 * c + 1] * SC_X8, v[8 * c + 2] * SC_X8, v[8 * c + 3] * SC_X8); w.y = pk4_fp8(v[8 * c + 4] * SC_X8, v[8 * c + 5] * SC_X8, v[8 * c + 6] * SC_X8, v[8 * c + 7] * SC_X8); o8[64 * c] = w; }
            } else {
            v4u* o = (v4u*)(XN + (size_t)m * D) + C.lane;
#pragma unroll
            for (int c = 0; c < 2; ++c) { v4u w; w.x = pk2(v[8 * c], v[8 * c + 1]); w.y = pk2(v[8 * c + 2], v[8 * c + 3]); w.z = pk2(v[8 * c + 4], v[8 * c + 5]); w.w = pk2(v[8 * c + 6], v[8 * c + 7]); o[64 * c] = w; }
            if (ALSO8) { v2u* o8 = (v2u*)(X8 + (size_t)m * D) + C.lane;
#pragma unroll
                for (int c = 0; c < 2; ++c) { v2u w; w.x = pk4_fp8(v[8 * c] * SC_X8, v[8 * c + 1] * SC_X8, v[8 * c + 2] * SC_X8, v[8 * c + 3] * SC_X8); w.y = pk4_fp8(v[8 * c + 4] * SC_X8, v[8 * c + 5] * SC_X8, v[8 * c + 6] * SC_X8, v[8 * c + 7] * SC_X8); o8[64 * c] = w; } }
            }
            if (ROUTE) {
                float lg[8];
#pragma unroll
                for (int e = 0; e < 8; ++e) lg[e] = 0.f;
#pragma unroll
                for (int c = 0; c < 2; ++c)
#pragma unroll
                    for (int k = 0; k < 8; ++k) { const int d = 512 * c + 8 * C.lane + k; const f32x4 r0 = *(LAS f32x4*)(R + d * 8), r1 = *(LAS f32x4*)(R + d * 8 + 4); const float h = v[8 * c + k];
                        lg[0] += h * r0.x; lg[1] += h * r0.y; lg[2] += h * r0.z; lg[3] += h * r0.w; lg[4] += h * r1.x; lg[5] += h * r1.y; lg[6] += h * r1.z; lg[7] += h * r1.w; }
#pragma unroll
                for (int e = 0; e < 8; ++e) lg[e] = wave_sum(lg[e], C.lane);
                float l1 = -INFINITY, l2 = -INFINITY; int e1 = 0, e2 = 0;
#pragma unroll
                for (int e = 0; e < 8; ++e) if (lg[e] > l1) { l1 = lg[e]; e1 = e; }
#pragma unroll
                for (int e = 0; e < 8; ++e) if (e != e1 && lg[e] > l2) { l2 = lg[e]; e2 = e; }
                if (C.lane == 0 && slot < 256) { rt_tok[slot] = m; rt_e[slot] = e1 | (e2 << 8); rt_w[slot] = 1.0f / (1.0f + expf(l2 - l1)); }
                slot += NWAVES;
            } } }
    }
    if (ROUTE) {
        __syncthreads();
        if (C.tid < 16) {
            const int list = C.tid >> 3, e = C.tid & 7; int n = 0;
            for (int sidx = 0; sidx < 256; ++sidx) { const int t = rt_tok[sidx]; const int ee = (rt_e[sidx] >> (8 * list)) & 0xff; n += (t >= 0 && ee == e) ? 1 : 0; }
            gu32* cnt = (gu32*)(ws + WS_CTL) + CW_CNT; int* tokl = (int*)(ws + WS_TOK); float* wl = (float*)(ws + WS_WL);
            unsigned pos = n ? __hip_atomic_fetch_add(cnt + C.tid, (unsigned)n, RLX_AGENT) : 0u;
            for (int sidx = 0; sidx < 256; ++sidx) { const int t = rt_tok[sidx]; const int ee = (rt_e[sidx] >> (8 * list)) & 0xff;
                if (t >= 0 && ee == e) { const float w1 = rt_w[sidx]; tokl[(size_t)C.tid * M + pos] = t; wl[(size_t)C.tid * M + pos] = list == 0 ? w1 : 1.0f - w1; ++pos; } }
        }
        __syncthreads();
    }
}

__device__ __forceinline__ void qk_item(const Ctx& C, const Args& A, int l, int item) {
    unsigned char* ws = A.ws; bf16* P = (bf16*)(ws + WS_P);
    const float* ct = (const float*)(ws + WS_ROPE); const float* st = ct + SEQ * 8;
    const int rb = item >> 3, h = item & 7, ch = C.tid & 7, rg = C.tid >> 3;
    LAS float* part = (LAS float*)C.lds;
    for (int which = 0; which < 2; ++which) {
        const float* gn = A.in[which == 0 ? 5 : 6] + l * HD + ch * 8;
        const f32x4 ga = *(const f32x4*)gn, gb = *(const f32x4*)(gn + 4);
        const float gv[8] = {ga.x, ga.y, ga.z, ga.w, gb.x, gb.y, gb.z, gb.w};
        float ks[8];
#pragma unroll
        for (int j = 0; j < 8; ++j) ks[j] = 0.f;
        v4u wv[4]; f32x4 c0[4], c1[4], s0[4], s1[4];
#pragma unroll
        for (int pass = 0; pass < 4; ++pass) { const int row = rb * 256 + pass * 64 + rg, pos = row & (SEQ - 1);
            wv[pass] = *(const v4u*)(P + (size_t)row * NCOL + (which == 0 ? C_Q : C_K) + h * HD + ch * 8);
            c0[pass] = *(const f32x4*)(ct + pos * 8); c1[pass] = *(const f32x4*)(ct + pos * 8 + 4); s0[pass] = *(const f32x4*)(st + pos * 8); s1[pass] = *(const f32x4*)(st + pos * 8 + 4); }
#pragma unroll
        for (int pass = 0; pass < 4; ++pass) {
            const int row = rb * 256 + pass * 64 + rg;
            bf16* p = P + (size_t)row * NCOL + (which == 0 ? C_Q : C_K) + h * HD + ch * 8;
            const v4u w = wv[pass];
            float v[8] = {bflo(w.x), bfhi(w.x), bflo(w.y), bfhi(w.y), bflo(w.z), bfhi(w.z), bflo(w.w), bfhi(w.w)};
            const float cs8[8] = {c0[pass].x, c0[pass].y, c0[pass].z, c0[pass].w, c1[pass].x, c1[pass].y, c1[pass].z, c1[pass].w};
            const float sn8[8] = {s0[pass].x, s0[pass].y, s0[pass].z, s0[pass].w, s1[pass].x, s1[pass].y, s1[pass].z, s1[pass].w};
            float ss = 0.f;
#pragma unroll
            for (int j = 0; j < 8; ++j) ss += v[j] * v[j];
            ss += shx(ss, 1, C.lane); ss += shx(ss, 2, C.lane); ss += shx(ss, 4, C.lane);
            const float rstd = 1.0f / sqrtf(ss * (1.f / HD) + EPS);
#pragma unroll
            for (int j = 0; j < 8; ++j) v[j] = v[j] * rstd * gv[j];
#pragma unroll
            for (int j = 0; j < 8; ++j) {
                const float other = shx(v[j], 1, C.lane);
                const float rot = (ch == 0) ? (v[j] * cs8[j] - other * sn8[j]) : (v[j] * cs8[j] + other * sn8[j]);
                v[j] = (ch < 2) ? rot : v[j];
            }
            if (which == 0) {
#pragma unroll
                for (int j = 0; j < 8; ++j) v[j] *= QSCALE;
            } else {
#pragma unroll
                for (int j = 0; j < 8; ++j) ks[j] += v[j];
            }
            v4u o; o.x = pk2(v[0], v[1]); o.y = pk2(v[2], v[3]); o.z = pk2(v[4], v[5]); o.w = pk2(v[6], v[7]);
            *(v4u*)p = o;
        }
        if (which == 1) {
#pragma unroll
            for (int j = 0; j < 8; ++j) part[rg * 64 + ch * 8 + j] = ks[j];
            __syncthreads();
            if (C.tid < 64) { float s = 0.f;
#pragma unroll 16
                for (int r = 0; r < 64; ++r) s += part[r * 64 + C.tid];
                const int b = rb >> 4, blk = rb & 15;
                ((float*)(ws + WS_KMEAN))[(size_t)((b * NH + h) * NBLK + blk) * HD + C.tid] = s * (1.f / 256.f); }
            __syncthreads();
        }
    }
}
__device__ __forceinline__ void conva_tasks(const Ctx& C, const Args& A, int l) {
    bf16* P = (bf16*)(A.ws + WS_P); const float* cw = A.in[3] + l * 3 * 512;
    const int stride = C.G * NTHR;
    for (int g0 = C.bid * NTHR + C.tid; g0 < M * 64; g0 += 4 * stride) {
        v4u xa[4][3], ca[4][3], ba[4];
#pragma unroll
        for (int i = 0; i < 4; ++i) { const int g = g0 + i * stride; if (g < M * 64) { const int row = g >> 6, c = (g & 63) * 8, t = row & (SEQ - 1);
            const bf16* base = P + (size_t)row * NCOL + c;
#pragma unroll
            for (int k = 0; k < 3; ++k) { const int dt = 2 - k; if (t >= dt) { xa[i][k] = *(const v4u*)(base - (size_t)dt * NCOL + C_XA); ca[i][k] = *(const v4u*)(base - (size_t)dt * NCOL + C_CA); } else { xa[i][k] = (v4u){0u, 0u, 0u, 0u}; ca[i][k] = xa[i][k]; } }
            ba[i] = *(const v4u*)(base + C_BA); } }
#pragma unroll
        for (int i = 0; i < 4; ++i) { const int g = g0 + i * stride; if (g < M * 64) { const int row = g >> 6, c = (g & 63) * 8;
            float acc[8];
#pragma unroll
            for (int j = 0; j < 8; ++j) acc[j] = 0.f;
#pragma unroll
            for (int k = 0; k < 3; ++k) {
                const v4u x = xa[i][k], cc = ca[i][k];
                const f32x4 w0 = *(const f32x4*)(cw + k * 512 + c), w1 = *(const f32x4*)(cw + k * 512 + c + 4);
                acc[0] += w0.x * (bflo(x.x) * bflo(cc.x)); acc[1] += w0.y * (bfhi(x.x) * bfhi(cc.x)); acc[2] += w0.z * (bflo(x.y) * bflo(cc.y)); acc[3] += w0.w * (bfhi(x.y) * bfhi(cc.y));
                acc[4] += w1.x * (bflo(x.z) * bflo(cc.z)); acc[5] += w1.y * (bfhi(x.z) * bfhi(cc.z)); acc[6] += w1.z * (bflo(x.w) * bflo(cc.w)); acc[7] += w1.w * (bfhi(x.w) * bfhi(cc.w));
            }
            const v4u b = ba[i];
            v4u o; o.x = pk2(bflo(b.x) * acc[0], bfhi(b.x) * acc[1]); o.y = pk2(bflo(b.y) * acc[2], bfhi(b.y) * acc[3]);
            o.z = pk2(bflo(b.z) * acc[4], bfhi(b.z) * acc[5]); o.w = pk2(bflo(b.w) * acc[6], bfhi(b.w) * acc[7]);
            *(v4u*)(P + (size_t)row * NCOL + c + C_BA) = o; } }
    }
}
__device__ __forceinline__ void lru_pass1_phase(const Ctx& C, const Args& A, int l) {
    typedef pg8::bf16x8 bx8;
    unsigned char* ws = A.ws; const bf16* P = (const bf16*)(ws + WS_P);
    bf16* LA = (bf16*)A.out + (size_t)M * D; bf16* UU = LA + (size_t)M * 512;
    const int hb = C.wave, lane = C.lane, fr = lane & 15, fq = lane >> 4, c = hb * 64 + lane;
    bx8 wR[2][4], wI[2][4]; float bR[4], bI[4];
    { const float* wrp = A.in[10] + (size_t)l * 32768 + hb * 4096; const float* wip = A.in[12] + (size_t)l * 32768 + hb * 4096;
#pragma unroll
      for (int ks = 0; ks < 2; ++ks)
#pragma unroll
        for (int ct = 0; ct < 4; ++ct) { const int k0 = 32 * ks + 8 * fq, col = 16 * ct + fr; v4u a, b2;
            a.x = pk2(wrp[(k0 + 0) * 64 + col], wrp[(k0 + 1) * 64 + col]); a.y = pk2(wrp[(k0 + 2) * 64 + col], wrp[(k0 + 3) * 64 + col]);
            a.z = pk2(wrp[(k0 + 4) * 64 + col], wrp[(k0 + 5) * 64 + col]); a.w = pk2(wrp[(k0 + 6) * 64 + col], wrp[(k0 + 7) * 64 + col]);
            b2.x = pk2(wip[(k0 + 0) * 64 + col], wip[(k0 + 1) * 64 + col]); b2.y = pk2(wip[(k0 + 2) * 64 + col], wip[(k0 + 3) * 64 + col]);
            b2.z = pk2(wip[(k0 + 4) * 64 + col], wip[(k0 + 5) * 64 + col]); b2.w = pk2(wip[(k0 + 6) * 64 + col], wip[(k0 + 7) * 64 + col]);
            wR[ks][ct] = __builtin_bit_cast(bx8, a); wI[ks][ct] = __builtin_bit_cast(bx8, b2); }
#pragma unroll
      for (int ct = 0; ct < 4; ++ct) { bR[ct] = A.in[11][l * 512 + hb * 64 + 16 * ct + fr]; bI[ct] = A.in[13][l * 512 + hb * 64 + 16 * ct + fr]; } }
    const float lam = A.in[14][l * 512 + c];
    const float sp = log1pf(expf(-lam));
    const float* cw = A.in[8] + l * 4 * 512 + c; const float w0 = cw[0], w1 = cw[512], w2 = cw[1024], w3 = cw[1536], bc = A.in[9][l * 512 + c];
    LAS unsigned char* wl = C.lds + hb * 13312;
    LAS unsigned short* Xs = (LAS unsigned short*)wl; LAS unsigned* Gs = (LAS unsigned*)(wl + 4608);
    for (int item = C.bid; item < BATCH * NCH; item += C.G) {
        const int b = item >> 6, ci = item & 63;
        const size_t row0 = (size_t)b * SEQ + ci * LCH;
        const bf16* xcp = P + row0 * NCOL + C_XC + c;
        float x3 = 0.f, x2 = 0.f, x1 = 0.f;
        if (ci > 0) { x3 = bf2f(*(xcp - 3 * (size_t)NCOL)); x2 = bf2f(*(xcp - 2 * (size_t)NCOL)); x1 = bf2f(*(xcp - (size_t)NCOL)); }
        float Ap = 1.f, h = 0.f;
#pragma unroll 1
        for (int sub = 0; sub < 2; ++sub) {
            { bf16 xin[32];
#pragma unroll
              for (int r = 0; r < 32; ++r) xin[r] = xcp[(size_t)(sub * 32 + r) * NCOL];
#pragma unroll
              for (int r = 0; r < 32; ++r) { const float x0 = bf2f(xin[r]); const float xv = w0 * x3 + w1 * x2 + w2 * x1 + w3 * x0 + bc; x3 = x2; x2 = x1; x1 = x0; Xs[r * 72 + lane] = f2bf(xv); } }
            LDS_WAIT();
            pg8::f32x4 aR[2][4], aI[2][4];
#pragma unroll
            for (int rt = 0; rt < 2; ++rt)
#pragma unroll
                for (int ct = 0; ct < 4; ++ct) { aR[rt][ct] = (pg8::f32x4){0.f, 0.f, 0.f, 0.f}; aI[rt][ct] = (pg8::f32x4){0.f, 0.f, 0.f, 0.f}; }
#pragma unroll
            for (int rt = 0; rt < 2; ++rt)
#pragma unroll
                for (int ks = 0; ks < 2; ++ks) { const bx8 af = *(const LAS bx8*)(wl + (16 * rt + fr) * 144 + (32 * ks + 8 * fq) * 2);
#pragma unroll
                    for (int ct = 0; ct < 4; ++ct) { aR[rt][ct] = __builtin_amdgcn_mfma_f32_16x16x32_bf16(af, wR[ks][ct], aR[rt][ct], 0, 0, 0); aI[rt][ct] = __builtin_amdgcn_mfma_f32_16x16x32_bf16(af, wI[ks][ct], aI[rt][ct], 0, 0, 0); } }
#pragma unroll
            for (int rt = 0; rt < 2; ++rt)
#pragma unroll
                for (int ct = 0; ct < 4; ++ct)
#pragma unroll
                    for (int jj = 0; jj < 4; ++jj) Gs[(16 * rt + 4 * fq + jj) * 68 + 16 * ct + fr] = pk2(sigmoidf_(aR[rt][ct][jj] + bR[ct]), sigmoidf_(aI[rt][ct][jj] + bI[ct]));
            LDS_WAIT();
#pragma unroll 4
            for (int r = 0; r < 32; ++r) {
                const unsigned g = Gs[r * 68 + lane]; const float xv = bf2f(Xs[r * 72 + lane]);
                const float la = bfround(-8.0f * bflo(g) * sp), a = __expf(la), x2l = 2.0f * la;
                const float em = (x2l > -0.25f) ? -(x2l * (1.f + x2l * (0.5f + x2l * (0.16666667f + x2l * (0.041666668f + x2l * (0.0083333338f + x2l * 0.0013888889f)))))) : (1.0f - __expf(x2l));
                const float u = bfround(sqrtf(em) * (bfhi(g) * xv));
                Ap *= a; h = a * h + u;
                Gs[r * 68 + lane] = pk2(la, u);
            }
            LDS_WAIT();
#pragma unroll
            for (int q = 0; q < 4; ++q) { const int rr = (lane >> 3) + 8 * q, ch = lane & 7;
                const v4u w0 = *(const LAS v4u*)(Gs + rr * 68 + ch * 8), w1 = *(const LAS v4u*)(Gs + rr * 68 + ch * 8 + 4);
                v4u lo, hi;
                lo.x = (w0.x & 0xffffu) | (w0.y << 16); lo.y = (w0.z & 0xffffu) | (w0.w << 16); lo.z = (w1.x & 0xffffu) | (w1.y << 16); lo.w = (w1.z & 0xffffu) | (w1.w << 16);
                hi.x = (w0.x >> 16) | (w0.y & 0xffff0000u); hi.y = (w0.z >> 16) | (w0.w & 0xffff0000u); hi.z = (w1.x >> 16) | (w1.y & 0xffff0000u); hi.w = (w1.z >> 16) | (w1.w & 0xffff0000u);
                const size_t o = (row0 + sub * 32 + rr) * 512 + hb * 64 + ch * 8;
                *(v4u*)(LA + o) = lo; *(v4u*)(UU + o) = hi; }
            LDS_WAIT();
        }
        ((f32x2*)(ws + WS_SUM))[(size_t)(b * NCH + ci) * 512 + c] = (f32x2){Ap, h};
    }
}
__device__ __forceinline__ void lru_pass2_item(const Ctx& C, const Args& A, int item) {
    unsigned char* ws = A.ws; bf16* P = (bf16*)(ws + WS_P);
    const bf16* LA = (const bf16*)A.out + (size_t)M * D; const bf16* UU = LA + (size_t)M * 512;
    const int b = item >> 6, ci = item & 63, w = C.wave, lane = C.lane, c8 = lane * 8;
    LAS f32x4* comp = (LAS f32x4*)C.lds;
    LAS f32x4* loc = comp + 8 * 64 * 4;
    const size_t row0 = (size_t)b * SEQ + ci * LCH + w * 8;
    v4u la4[8], u4[8];
#pragma unroll
    for (int r = 0; r < 8; ++r) { la4[r] = *(const v4u*)(LA + (row0 + r) * 512 + c8); u4[r] = *(const v4u*)(UU + (row0 + r) * 512 + c8); }
    float fa[8], fh[8];
#pragma unroll
    for (int k = 0; k < 8; ++k) { fa[k] = 1.f; fh[k] = 0.f; }
    { const int clo = (ci * w) >> 3, chi = (ci * (w + 1)) >> 3;
      const f32x4* sm = (const f32x4*)(ws + WS_SUM) + ((size_t)(b * NCH) * 512 + c8) / 2;
      for (int cc = clo; cc < chi; ++cc) { const f32x4* s = sm + (size_t)cc * 256;
#pragma unroll
        for (int q = 0; q < 4; ++q) { const f32x4 v = s[q]; fh[2 * q] = v.x * fh[2 * q] + v.y; fa[2 * q] *= v.x; fh[2 * q + 1] = v.z * fh[2 * q + 1] + v.w; fa[2 * q + 1] *= v.z; } } }
#pragma unroll
    for (int q = 0; q < 4; ++q) comp[(w * 64 + lane) * 4 + q] = (f32x4){fa[2 * q], fh[2 * q], fa[2 * q + 1], fh[2 * q + 1]};
    float ta[8], th[8];
#pragma unroll
    for (int k = 0; k < 8; ++k) { ta[k] = 1.f; th[k] = 0.f; }
#pragma unroll
    for (int r = 0; r < 8; ++r) { const v4u lw = la4[r], uw = u4[r];
        const float l8[8] = {bflo(lw.x), bfhi(lw.x), bflo(lw.y), bfhi(lw.y), bflo(lw.z), bfhi(lw.z), bflo(lw.w), bfhi(lw.w)};
        const float u8[8] = {bflo(uw.x), bfhi(uw.x), bflo(uw.y), bfhi(uw.y), bflo(uw.z), bfhi(uw.z), bflo(uw.w), bfhi(uw.w)};
#pragma unroll
        for (int k = 0; k < 8; ++k) { const float a = __expf(l8[k]); ta[k] *= a; th[k] = a * th[k] + u8[k]; } }
#pragma unroll
    for (int q = 0; q < 4; ++q) loc[(w * 64 + lane) * 4 + q] = (f32x4){ta[2 * q], th[2 * q], ta[2 * q + 1], th[2 * q + 1]};
    __syncthreads();
#pragma unroll
    for (int r = 0; r < 8; ++r) asm volatile("" : "+v"(la4[r]), "+v"(u4[r]));
    v4u g4[8];
#pragma unroll
    for (int r = 0; r < 8; ++r) g4[r] = *(const v4u*)(P + (row0 + r) * NCOL + C_GC + c8);
    float h[8];
#pragma unroll
    for (int k = 0; k < 8; ++k) h[k] = 0.f;
#pragma unroll
    for (int ww = 0; ww < 8; ++ww)
#pragma unroll
        for (int q = 0; q < 4; ++q) { const f32x4 v = comp[(ww * 64 + lane) * 4 + q]; h[2 * q] = v.x * h[2 * q] + v.y; h[2 * q + 1] = v.z * h[2 * q + 1] + v.w; }
    for (int ww = 0; ww < w; ++ww)
#pragma unroll
        for (int q = 0; q < 4; ++q) { const f32x4 v = loc[(ww * 64 + lane) * 4 + q]; h[2 * q] = v.x * h[2 * q] + v.y; h[2 * q + 1] = v.z * h[2 * q + 1] + v.w; }
#pragma unroll
    for (int r = 0; r < 8; ++r) { const v4u lw = la4[r], uw = u4[r], gw = g4[r];
        const float l8[8] = {bflo(lw.x), bfhi(lw.x), bflo(lw.y), bfhi(lw.y), bflo(lw.z), bfhi(lw.z), bflo(lw.w), bfhi(lw.w)};
        const float u8[8] = {bflo(uw.x), bfhi(uw.x), bflo(uw.y), bfhi(uw.y), bflo(uw.z), bfhi(uw.z), bflo(uw.w), bfhi(uw.w)};
        const float g8[8] = {bflo(gw.x), bfhi(gw.x), bflo(gw.y), bfhi(gw.y), bflo(gw.z), bfhi(gw.z), bflo(gw.w), bfhi(gw.w)};
        float y[8];
#pragma unroll
        for (int k = 0; k < 8; ++k) { h[k] = __expf(l8[k]) * h[k] + u8[k]; const float x = g8[k]; y[k] = x * rcp_(1.0f + __expf(-1.5957691216f * (x + 0.044715f * x * x * x))) * h[k]; }
        v4u o; o.x = pk2(y[0], y[1]); o.y = pk2(y[2], y[3]); o.z = pk2(y[4], y[5]); o.w = pk2(y[6], y[7]);
        *(v4u*)(P + (row0 + r) * NCOL + C_GC + c8) = o; }
    __syncthreads();
}

struct PlainSched {
    pg8::TileOrder T; const char* A; const char* B; size_t tA, tB;
    __device__ __forceinline__ bool next(int i, pg8::Unit& u) const { int pm, pn; if (!T.map((long)i * T.G + T.c, pm, pn)) return false;
        u.pm = pm; u.pn = pn; u.a = A + (size_t)pm * tA; u.b = B + (size_t)pn * tB; u.x = 0; return true; }
    __device__ __forceinline__ void a_ready(const pg8::Unit&) const {}
    __device__ __forceinline__ void done(const pg8::Unit&) const {}
};
struct MergeSched {
    pg8::TileOrder T; const char* P; const char* W;
    __device__ __forceinline__ bool next(int i, pg8::Unit& u) const { const int ti = i / 3, br = i - 3 * ti; int pm, pn; if (!T.map((long)ti * T.G + T.c, pm, pn)) return false;
        const int colA = br == 0 ? C_BA : (br == 1 ? C_Q : C_GC);
        u.pm = pm; u.pn = pn; u.a = P + ((size_t)pm * 256 * NCOL + colA) * 2; u.b = W + ((size_t)br * 1024 * 512 + (size_t)pn * 256 * 512) * 2; u.x = br; return true; }
    __device__ __forceinline__ void a_ready(const pg8::Unit&) const {}
    __device__ __forceinline__ void done(const pg8::Unit&) const {}
};
struct MoeTiles {
    int nt[8]; int ntiles;
    __device__ __forceinline__ void init(const unsigned* cnt) { ntiles = 0;
#pragma unroll
        for (int e = 0; e < 8; ++e) { nt[e] = (int)((cnt[e] + 255u) >> 8); ntiles += nt[e]; } }
    __device__ __forceinline__ void locate(int pm, int& e, int& base) const { e = 0; base = 0; int cum = 0;
#pragma unroll
        for (int k = 0; k < 7; ++k) { cum += nt[k]; if (pm >= cum) { e = k + 1; base = cum; } } }
};
struct MoeSched {
    pg8::TileOrder T; MoeTiles mt; const char* A; size_t tA; const char* W; size_t eStride, tB;
    __device__ __forceinline__ bool next(int i, pg8::Unit& u) const { int pm, pn; if (!T.map((long)i * T.G + T.c, pm, pn)) return false;
        int e, base; mt.locate(pm, e, base);
        u.pm = pm; u.pn = pn; u.a = A + (size_t)pm * tA; u.b = W + (size_t)e * eStride + (size_t)pn * tB; u.x = e; return true; }
    __device__ __forceinline__ void a_ready(const pg8::Unit&) const {}
    __device__ __forceinline__ void done(const pg8::Unit&) const {}
};

struct EpiMerge {
    static constexpr bool PERM = true, AFTER_DRAIN = false, CHAIN = true;
    bf16* MG; const bf16* P;
    __device__ __forceinline__ void operator()(const pg8::f32x4 (&)[2][2][4][2], const pg8::Unit&, int, int, int, int) const {}
    __device__ __forceinline__ bool chain(pg8::f32x4 (&acc)[2][2][4][2], const pg8::Unit& u, int wr, int wc, int fr, int fq) const {
        const int br = u.x, row0 = u.pm * 256 + wr * 64 + fr, col0 = u.pn * 256 + wc * 32 + 8 * fq;
#pragma unroll
        for (int ai = 0; ai < 2; ++ai) {
            v4u gn[4][2], gd[4][2];
#pragma unroll
            for (int m = 0; m < 4; ++m)
#pragma unroll
                for (int bj = 0; bj < 2; ++bj) { const size_t row = (size_t)(row0 + ai * 128 + m * 16); const int col = col0 + bj * 128;
                    gn[m][bj] = *(const v4u*)(P + row * NCOL + C_G + br * 1024 + col);
                    gd[m][bj] = (br < 2) ? *(const v4u*)(P + row * NCOL + C_G + (br + 1) * 1024 + col) : (v4u){0u, 0u, 0u, 0u}; }
#pragma unroll
            for (int m = 0; m < 4; ++m)
#pragma unroll
                for (int bj = 0; bj < 2; ++bj) { const size_t row = (size_t)(row0 + ai * 128 + m * 16); const int col = col0 + bj * 128;
                    const v4u a = gn[m][bj], d = gd[m][bj];
                    const float an[8] = {bflo(a.x), bfhi(a.x), bflo(a.y), bfhi(a.y), bflo(a.z), bfhi(a.z), bflo(a.w), bfhi(a.w)};
                    const float dn[8] = {bflo(d.x), bfhi(d.x), bflo(d.y), bfhi(d.y), bflo(d.z), bfhi(d.z), bflo(d.w), bfhi(d.w)};
                    float f[8];
#pragma unroll
                    for (int k = 0; k < 8; ++k) f[k] = (br < 2) ? an[k] * rcp_(fmaxf(dn[k], 1e-30f)) : an[k];
                    pg8::f32x4& v0 = acc[ai][bj][m][0]; pg8::f32x4& v1 = acc[ai][bj][m][1];
                    v0[0] *= f[0]; v0[1] *= f[1]; v0[2] *= f[2]; v0[3] *= f[3]; v1[0] *= f[4]; v1[1] *= f[5]; v1[2] *= f[6]; v1[3] *= f[7];
                    if (br == 2) { v4u w; w.x = pk2(v0[0], v0[1]); w.y = pk2(v0[2], v0[3]); w.z = pk2(v1[0], v1[1]); w.w = pk2(v1[2], v1[3]); *(v4u*)(MG + row * D + col) = w; } }
            asm volatile("" ::: "memory");
        }
        return br < 2;
    }
};
template <bool BASE_F32>
struct EpiRes {
    static constexpr bool PERM = true, AFTER_DRAIN = false, CHAIN = false;
    const void* base; bf16* out;
    __device__ __forceinline__ void operator()(const pg8::f32x4 (&acc)[2][2][4][2], const pg8::Unit& u, int wr, int wc, int fr, int fq) const {
        const int row0 = u.pm * 256 + wr * 64 + fr, col0 = u.pn * 256 + wc * 32 + 8 * fq;
#pragma unroll
        for (int ai = 0; ai < 2; ++ai) {
            f32x4 b0[4][2], b1[4][2];
#pragma unroll
            for (int m = 0; m < 4; ++m)
#pragma unroll
                for (int bj = 0; bj < 2; ++bj) { const size_t off = (size_t)(row0 + ai * 128 + m * 16) * D + col0 + bj * 128;
                    if (BASE_F32) { b0[m][bj] = *(const f32x4*)((const float*)base + off); b1[m][bj] = *(const f32x4*)((const float*)base + off + 4); }
                    else { const v4u w = *(const v4u*)((const bf16*)base + off); b0[m][bj] = (f32x4){bflo(w.x), bfhi(w.x), bflo(w.y), bfhi(w.y)}; b1[m][bj] = (f32x4){bflo(w.z), bfhi(w.z), bflo(w.w), bfhi(w.w)}; } }
#pragma unroll
            for (int m = 0; m < 4; ++m)
#pragma unroll
                for (int bj = 0; bj < 2; ++bj) { const size_t off = (size_t)(row0 + ai * 128 + m * 16) * D + col0 + bj * 128;
                    const f32x4 r0 = b0[m][bj] + acc[ai][bj][m][0], r1 = b1[m][bj] + acc[ai][bj][m][1];
                    v4u w; w.x = pk2(r0[0], r0[1]); w.y = pk2(r0[2], r0[3]); w.z = pk2(r1[0], r1[1]); w.w = pk2(r1[2], r1[3]);
                    *(v4u*)(out + off) = w; }
            asm volatile("" ::: "memory");
        }
    }
};
struct EpiSwiGLU {
    static constexpr bool PERM = true, AFTER_DRAIN = false, CHAIN = false;
    bf16* H; int ldc;
    __device__ __forceinline__ void operator()(const pg8::f32x4 (&acc)[2][2][4][2], const pg8::Unit& u, int wr, int wc, int fr, int fq) const {
        const int row0 = u.pm * 256 + wr * 64 + fr, col0 = u.pn * 128 + wc * 32 + 8 * fq;
#pragma unroll
        for (int ai = 0; ai < 2; ++ai)
#pragma unroll
            for (int m = 0; m < 4; ++m) { const f32x4 g0 = acc[ai][0][m][0], g1 = acc[ai][0][m][1], u0 = acc[ai][1][m][0], u1 = acc[ai][1][m][1];
                v4u w; w.x = pk2(g0[0] * sigmoidf_(g0[0]) * u0[0], g0[1] * sigmoidf_(g0[1]) * u0[1]); w.y = pk2(g0[2] * sigmoidf_(g0[2]) * u0[2], g0[3] * sigmoidf_(g0[3]) * u0[3]);
                w.z = pk2(g1[0] * sigmoidf_(g1[0]) * u1[0], g1[1] * sigmoidf_(g1[1]) * u1[1]); w.w = pk2(g1[2] * sigmoidf_(g1[2]) * u1[2], g1[3] * sigmoidf_(g1[3]) * u1[3]);
                *(v4u*)(H + (size_t)(row0 + ai * 128 + m * 16) * ldc + col0) = w; }
    }
};
struct EpiSwiGLU8 {
    static constexpr bool PERM = true, AFTER_DRAIN = false, CHAIN = false;
    unsigned char* H; int ldc;
    __device__ __forceinline__ void operator()(const pg8::f32x4 (&acc)[2][2][4][2], const pg8::Unit& u, int wr, int wc, int fr, int fq) const {
        const int row0 = u.pm * 256 + wr * 64 + fr, colw = u.pn * 128 + wc * 32; constexpr float ds = 1.0f / (SC_X8 * SC_W8);
        const bool odd = (fq & 1) != 0;
        unsigned char* p = H + (size_t)(row0 + (odd ? 16 : 0)) * ldc + colw + 8 * (fq & ~1);
#pragma unroll
        for (int ai = 0; ai < 2; ++ai)
#pragma unroll
            for (int mp = 0; mp < 2; ++mp) {
                v2u x[2];
#pragma unroll
                for (int h = 0; h < 2; ++h) { const int m = 2 * mp + h;
                    const f32x4 g0 = acc[ai][0][m][0] * ds, g1 = acc[ai][0][m][1] * ds, u0 = acc[ai][1][m][0] * (ds * SC_H8), u1 = acc[ai][1][m][1] * (ds * SC_H8);
                    x[h].x = pk4_fp8(g0[0] * sigmoidf_(g0[0]) * u0[0], g0[1] * sigmoidf_(g0[1]) * u0[1], g0[2] * sigmoidf_(g0[2]) * u0[2], g0[3] * sigmoidf_(g0[3]) * u0[3]);
                    x[h].y = pk4_fp8(g1[0] * sigmoidf_(g1[0]) * u1[0], g1[1] * sigmoidf_(g1[1]) * u1[1], g1[2] * sigmoidf_(g1[2]) * u1[2], g1[3] * sigmoidf_(g1[3]) * u1[3]); }
                const auto sx = __builtin_amdgcn_permlane16_swap(x[0].x, x[1].x, false, false), sy = __builtin_amdgcn_permlane16_swap(x[0].y, x[1].y, false, false);
                v4u w; w.x = sx[0]; w.y = sy[0]; w.z = sx[1]; w.w = sy[1];
                *(v4u*)(p + (size_t)(ai * 128 + mp * 32) * ldc) = w; }
    }
};
template <bool OUT_F32>
struct EpiScatter {
    static constexpr bool PERM = true, AFTER_DRAIN = false, CHAIN = false;
    const int* rowtok; const float* roww; const bf16* XB; void* out; float ds;
    __device__ __forceinline__ void operator()(const pg8::f32x4 (&acc)[2][2][4][2], const pg8::Unit& u, int wr, int wc, int fr, int fq) const {
        const int row0 = u.pm * 256 + wr * 64 + fr, col0 = u.pn * 256 + wc * 32 + 8 * fq;
#pragma unroll
        for (int ai = 0; ai < 2; ++ai) {
            int tok[4]; float w[4]; v4u bw[4][2];
#pragma unroll
            for (int m = 0; m < 4; ++m) { const int gr = row0 + ai * 128 + m * 16; tok[m] = rowtok[gr]; w[m] = roww[gr] * ds; }
#pragma unroll
            for (int m = 0; m < 4; ++m)
#pragma unroll
                for (int bj = 0; bj < 2; ++bj) bw[m][bj] = (tok[m] >= 0) ? *(const v4u*)(XB + (size_t)tok[m] * D + col0 + bj * 128) : (v4u){0u, 0u, 0u, 0u};
#pragma unroll
            for (int m = 0; m < 4; ++m) if (tok[m] >= 0) {
#pragma unroll
                for (int bj = 0; bj < 2; ++bj) { const size_t off = (size_t)tok[m] * D + col0 + bj * 128; const v4u b = bw[m][bj];
                    const f32x4 r0 = (f32x4){bflo(b.x), bfhi(b.x), bflo(b.y), bfhi(b.y)} + acc[ai][bj][m][0] * w[m], r1 = (f32x4){bflo(b.z), bfhi(b.z), bflo(b.w), bfhi(b.w)} + acc[ai][bj][m][1] * w[m];
                    if (OUT_F32) { *(f32x4*)((float*)out + off) = r0; *(f32x4*)((float*)out + off + 4) = r1; }
                    else { v4u o; o.x = pk2(r0[0], r0[1]); o.y = pk2(r0[2], r0[3]); o.z = pk2(r1[0], r1[1]); o.w = pk2(r1[2], r1[3]); *(v4u*)((bf16*)out + off) = o; } } }
            asm volatile("" ::: "memory");
        }
    }
};
__device__ __forceinline__ void moe_gather(const Ctx& C, unsigned char* ws, const bf16* XN, int list) {
    const unsigned* cnt = (const unsigned*)(ws + WS_CTL) + CW_CNT + list * 8;
    MoeTiles mt; mt.init(cnt);
    const int* tokl = (const int*)(ws + WS_TOK) + (size_t)list * 8 * M; const float* wl = (const float*)(ws + WS_WL) + (size_t)list * 8 * M;
    int* rowtok = (int*)(ws + WS_ROWTOK); float* roww = (float*)(ws + WS_ROWW);
    unsigned char* XG = ws + WS_XG; const unsigned char* XN8 = (const unsigned char*)XN;
    const int gw = C.bid * NWAVES + C.wave, NGW = C.G * NWAVES, nrows = mt.ntiles * 256;
    for (int g0 = gw; g0 < nrows; g0 += 4 * NGW) {
        int tok[4]; float w[4]; v4u a[4];
#pragma unroll
        for (int i = 0; i < 4; ++i) { const int gr = g0 + i * NGW; tok[i] = -1; w[i] = 0.f;
            if (gr < nrows) { int e, base; mt.locate(gr >> 8, e, base); const int local = ((gr >> 8) - base) * 256 + (gr & 255);
                if (local < (int)cnt[e]) { tok[i] = tokl[(size_t)e * M + local]; w[i] = wl[(size_t)e * M + local]; } } }
#pragma unroll
        for (int i = 0; i < 4; ++i) { a[i] = (v4u){0u, 0u, 0u, 0u};
            if (tok[i] >= 0) a[i] = ((const v4u*)(XN8 + (size_t)tok[i] * D))[C.lane]; }
#pragma unroll
        for (int i = 0; i < 4; ++i) { const int gr = g0 + i * NGW;
            if (gr < nrows) { if (C.lane == 0) { rowtok[gr] = tok[i]; roww[gr] = w[i]; }
                ((v4u*)(XG + (size_t)gr * D))[C.lane] = a[i]; } }
    }
}

__global__ void __launch_bounds__(NTHR, 2) fwd(Args args) {
    extern __shared__ __attribute__((aligned(16))) unsigned char lds_raw[];
    Ctx C; C.lds = (LAS unsigned char*)lds_raw; C.tid = threadIdx.x; C.lane = C.tid & 63; C.wave = __builtin_amdgcn_readfirstlane(C.tid >> 6); C.bid = blockIdx.x; C.G = gridDim.x;
    unsigned char* ws = args.ws;
    volatile LAS unsigned* MISC = (volatile LAS unsigned*)(C.lds + MISC_OFF);
    for (int u = C.tid; u < (LDS_BYTES - RING_BYTES) / 4; u += NTHR) ((LAS unsigned*)(C.lds + RING_BYTES))[u] = 0u;
    __syncthreads();
    const int lo = args.ph_lo, hi = args.ph_hi;
    const int wave_s = C.wave;
    XcdBarrier bar; bar.bar = (unsigned*)(ws + WS_CTL) + CW_BAR; bar.x = 0; bar.st = nullptr;
    if (MK_ONE_LAUNCH || hi - lo > 1) bar = xcd_barrier_post((unsigned*)(ws + WS_CTL) + CW_BAR, MISC + 8, C.tid == 0);
#if MK_ONE_LAUNCH
#define IN(k) true
#else
#define IN(k) (lo <= (k) && (k) < hi)
#endif
#define FRESH() do { unsigned z_ = 0u; asm volatile("" : "+v"(z_)); int t_ = wave_s * 64 + (int)__builtin_amdgcn_mbcnt_hi(~0u, __builtin_amdgcn_mbcnt_lo(~0u, z_)); asm volatile("" : "+v"(t_)); C.tid = t_; C.lane = t_ & 63; C.wave = wave_s; } while (0)
#if MK_ONE_LAUNCH
#define SEAM(k) xcd_barrier(bar, C.tid == 0)
#else
#define SEAM(k) do { if (IN(k) && IN((k) + 1)) xcd_barrier(bar, C.tid == 0); } while (0)
#endif
    bf16* XN = (bf16*)args.out; bf16* P = (bf16*)(ws + WS_P); bf16* XB = (bf16*)(ws + WS_XB);
    unsigned char* XN8 = (unsigned char*)args.out + (size_t)64 * MiB;

    if (IN(0)) { FRESH(); convert_layer_weights(C, args, 0); rope_table(C, ws); norm_rows<false, true>(C, args.in[0], args.in[1], XN, nullptr, ws, XN8); SEAM(0); }

#pragma unroll
    for (int l = 0; l < 2; ++l) {
        const int pb = 1 + 9 * l;
        if (IN(pb + 0)) { FRESH();
            {
                PlainSched S; S.T.init(M / 256, C_G / 256, C.G, C.bid); S.A = (const char*)XN; S.B = (const char*)(ws + WS_WIN); S.tA = (size_t)256 * D * 2; S.tB = (size_t)256 * D * 2;
                pg8::EpiBf16 E{P, NCOL, 1 << 30, 1.0f};
                pg8::gemm_phase<pg8::EpiBf16, PlainSched, true, true>(C.tid, C.lds, pg8::Gemm{D, D, D}, S, E); }
            FRESH();
            {
                PlainSched S; S.T.init(M / 256, (NCOL - C_G) / 256, C.G, C.bid); S.A = (const char*)XN8; S.B = (const char*)(ws + WS_WIN + (size_t)8 * MiB); S.tA = (size_t)256 * D; S.tB = (size_t)256 * D;
                pg8::EpiBf16 E{P + C_G, NCOL, 0, 1.0f / (SC_X8 * SC_W8)};
                pg8::gemm_phase<pg8::EpiBf16, PlainSched, true, true, true>(C.tid, C.lds, pg8::Gemm{D, D, D}, S, E); }
            SEAM(pb + 0);
        }
        if (IN(pb + 1)) { FRESH();
            lru_pass1_phase(C, args, l);
            __syncthreads(); FRESH();
            for (int it = C.bid; it < (M / 256) * NH; it += C.G) qk_item(C, args, l, it);
            FRESH();
            conva_tasks(C, args, l);
            SEAM(pb + 1);
        }
        if (IN(pb + 2)) { FRESH();
            {
                static_assert(moba::LDS_BYTES <= RING_BYTES, "attention scratch fits the ring region");
                const int v0 = (C.G % 8 == 0) ? (C.bid % 8) * (C.G / 8) + C.bid / 8 : C.bid;
                for (int v = v0; v < BATCH * NH * 4; v += C.G) { const int s = v & 3, bh = v >> 2;
#pragma unroll 1
                    for (int i = 0; i < 4; ++i) { const int qb = (i == 0) ? s : (i == 1) ? 7 - s : (i == 2) ? 8 + s : 15 - s;
                        moba::moba_unit(C.tid, bh >> 3, bh & 7, qb, (moba::bf16raw*)P, (const float*)(ws + WS_KMEAN), (char*)lds_raw); } }
            }
            FRESH();
            for (int it = C.bid; it < BATCH * NCH; it += C.G) lru_pass2_item(C, args, it);
            SEAM(pb + 2);
        }
        if (IN(pb + 3)) { FRESH();
            MergeSched S; S.T.init(M / 256, D / 256, C.G, C.bid); S.P = (const char*)P; S.W = (const char*)(ws + WS_WOABC);
            EpiMerge E{XN, P};
            pg8::gemm_phase<EpiMerge, MergeSched, true, true>(C.tid, C.lds, pg8::Gemm{512, NCOL, 512}, S, E);
            SEAM(pb + 3);
        }
        if (IN(pb + 4)) { FRESH();
            PlainSched S; S.T.init(M / 256, D / 256, C.G, C.bid); S.A = (const char*)XN; S.B = (const char*)(ws + WS_WO); S.tA = (size_t)256 * D * 2; S.tB = (size_t)256 * D * 2;
            if (l == 0) { EpiRes<true> E{args.in[0], XB}; pg8::gemm_phase<EpiRes<true>, PlainSched, true, true>(C.tid, C.lds, pg8::Gemm{D, D, D}, S, E); }
            else { EpiRes<false> E{XB, XB}; pg8::gemm_phase<EpiRes<false>, PlainSched, true, true>(C.tid, C.lds, pg8::Gemm{D, D, D}, S, E); }
            SEAM(pb + 4);
        }
        if (l == 0) {
            if (IN(pb + 5)) { FRESH(); norm_rows_b<false>(C, XB, args.in[17], (bf16*)(ws + WS_P + (size_t)200 * MiB), nullptr, ws); SEAM(pb + 5); }
            if (IN(pb + 6)) { FRESH();
                PlainSched S; S.T.init(M / 256, 2 * DFF / 256, C.G, C.bid); S.A = (const char*)(ws + WS_P + (size_t)200 * MiB); S.B = (const char*)(ws + WS_FGU);     S.tA = (size_t)256 * D * 2; S.tB = (size_t)256 * D * 2;
                EpiSwiGLU E{(bf16*)(ws + WS_HID0), DFF};
                pg8::gemm_phase<EpiSwiGLU, PlainSched, true, true>(C.tid, C.lds, pg8::Gemm{D, D, D}, S, E);
                SEAM(pb + 6);
            }
            if (IN(pb + 7)) { FRESH();
                PlainSched S; S.T.init(M / 256, D / 256, C.G, C.bid); S.A = (const char*)(ws + WS_HID0); S.B = (const char*)(ws + WS_FDN); S.tA = (size_t)256 * DFF * 2; S.tB = (size_t)256 * DFF * 2;
                EpiRes<false> E{XB, XB};
                pg8::gemm_phase<EpiRes<false>, PlainSched, true, true>(C.tid, C.lds, pg8::Gemm{DFF, DFF, DFF}, S, E);
                SEAM(pb + 7);
            }
            if (IN(pb + 8)) { FRESH(); convert_layer_weights(C, args, 1); norm_rows_b<false, true>(C, XB, args.in[1] + D, XN, nullptr, ws, XN8); SEAM(pb + 8); }
        } else {
            if (IN(15)) { FRESH(); norm_rows_b<true>(C, XB, args.in[17] + D, XN, args.in[21], ws); convert_moe_weights(C, args); SEAM(15); }
#pragma unroll 1
            for (int list = 0; list < 2; ++list) {
                const int q0 = 16 + 3 * list;
                if (IN(q0)) { FRESH(); moe_gather(C, ws, XN, list); SEAM(q0); }
                if (IN(q0 + 1)) { FRESH();
                    MoeSched S; S.mt.init((const unsigned*)(ws + WS_CTL) + CW_CNT + list * 8); S.T.init(S.mt.ntiles, 2 * EFF / 256, C.G, C.bid);
                    S.A = (const char*)(ws + WS_XG); S.tA = (size_t)256 * D; S.W = (const char*)(ws + WS_MGU); S.eStride = (size_t)7168 * D; S.tB = (size_t)256 * D;
                    EpiSwiGLU8 E{ws + WS_MH, EFF};
                    pg8::gemm_phase<EpiSwiGLU8, MoeSched, true, true, true>(C.tid, C.lds, pg8::Gemm{D, D, D}, S, E);
                    SEAM(q0 + 1);
                }
                if (IN(q0 + 2)) { FRESH();
                    MoeSched S; S.mt.init((const unsigned*)(ws + WS_CTL) + CW_CNT + list * 8); S.T.init(S.mt.ntiles, D / 256, C.G, C.bid);
                    S.A = (const char*)(ws + WS_MH); S.tA = (size_t)256 * EFF; S.W = (const char*)(ws + WS_MDN); S.eStride = (size_t)D * EFF; S.tB = (size_t)256 * EFF;
                    constexpr float dsc = 1.0f / (SC_H8 * SC_W8);
                    if (list == 0) { EpiScatter<false> E{(const int*)(ws + WS_ROWTOK), (const float*)(ws + WS_ROWW), XB, XB, dsc}; pg8::gemm_phase<EpiScatter<false>, MoeSched, true, true, true>(C.tid, C.lds, pg8::Gemm{EFF, EFF, EFF}, S, E); }
                    else { EpiScatter<true> E{(const int*)(ws + WS_ROWTOK), (const float*)(ws + WS_ROWW), XB, args.out, dsc}; pg8::gemm_phase<EpiScatter<true>, MoeSched, true, true, true>(C.tid, C.lds, pg8::Gemm{EFF, EFF, EFF}, S, E); }
                    if (list == 0) SEAM(q0 + 2);
                }
            }
        }
    }
#undef IN
#undef SEAM
}

extern "C" void kernel_launch(void* const* d_in, const int* in_sizes, int n_in, void* d_out, int out_size, void* d_ws, size_t ws_size, hipStream_t stream) {
    static int grid = 0;
    if (grid == 0) {
        if (n_in != 25 || in_sizes[0] != M * D || out_size != M * D || ws_size < WS_END) { fprintf(stderr, "kernel_launch: unexpected shapes (n_in %d, in0 %d, out %d, ws %zu); nothing launched\n", n_in, n_in > 0 ? in_sizes[0] : -1, out_size, ws_size); grid = -1; return; }
        int dev = 0, cus = 0, per_cu = 0;
        if (hipGetDevice(&dev) != hipSuccess || hipDeviceGetAttribute(&cus, hipDeviceAttributeMultiprocessorCount, dev) != hipSuccess) { grid = -1; return; }
        if (hipFuncSetAttribute((const void*)fwd, hipFuncAttributeMaxDynamicSharedMemorySize, LDS_BYTES) != hipSuccess) { fprintf(stderr, "kernel_launch: hipFuncSetAttribute failed\n"); grid = -1; return; }
        if (hipOccupancyMaxActiveBlocksPerMultiprocessor(&per_cu, (const void*)fwd, NTHR, LDS_BYTES) != hipSuccess || per_cu < 1) { fprintf(stderr, "kernel_launch: occupancy query reports %d workgroups per CU\n", per_cu); }
        (void)hipGetLastError();
        grid = cus;
    }
    if (grid < 0) return;
    if (hipMemsetAsync((char*)d_ws + WS_CTL, 0, CTL_ZERO_BYTES, stream) != hipSuccess) return;
    Args a{};
    for (int i = 0; i < 25; ++i) a.in[i] = (const float*)d_in[i];
    a.out = (float*)d_out; a.ws = (unsigned char*)d_ws;
#if MK_ONE_LAUNCH
    a.ph_lo = 0; a.ph_hi = N_PHASES;
    hipLaunchKernelGGL(fwd, dim3(grid), dim3(NTHR), LDS_BYTES, stream, a);
#else
    for (int p = 0; p < N_PHASES; ++p) { a.ph_lo = p; a.ph_hi = p + 1; hipLaunchKernelGGL(fwd, dim3(grid), dim3(NTHR), LDS_BYTES, stream, a); }
#endif
}
```

```cpp
#include <hip/hip_runtime.h>
#include <cstdio>
#include <cstdint>

namespace pg8 {
#define PG8_LAS __attribute__((address_space(3)))
typedef unsigned short bf16_t;
typedef short bf16x8 __attribute__((ext_vector_type(8)));
typedef float f32x4 __attribute__((ext_vector_type(4)));
typedef unsigned u32x4 __attribute__((ext_vector_type(4)));
constexpr int BM = 256, BK = 64, HALF = 128, HTB = HALF * BK * 2  , STAGE_BYTES = 8 * HTB, NXCD = 8, WGM = 8;

__host__ __device__ __forceinline__ int lds_byte(int r, int c) { const int st = (r >> 4) * 2 + (c >> 5), rr = r & 15, cc = c & 31, ob = rr * 64 + cc * 2; return st * 1024 + (ob ^ (((ob >> 9) & 1) << 5)); }
__host__ __device__ __forceinline__ void stage_rc(int b, int& R, int& C) { const int st = b / 1024, sb = b % 1024, swz = sb ^ (((sb >> 9) & 1) << 5); R = (st >> 1) * 16 + swz / 64; C = (st & 1) * 32 + (swz % 64) / 2; }
__host__ __device__ __forceinline__ int perm32(int rho) { const int n = rho >> 4, i = rho & 15; return 8 * (i >> 2) + 4 * n + (i & 3); }

struct Unit { int pm, pn; const char* a; const char* b; int x; };
struct Gemm { int K, lda, ldb; };

struct TileOrder {
    int nM, nN, nwg, G, c;
    __device__ __forceinline__ void init(int nM_, int nN_, int G_, int c_) { nM = nM_; nN = nN_; nwg = nM * nN; G = G_; c = c_; }
    __device__ __forceinline__ bool map(long L, int& pm, int& pn) const {
        if (L >= nwg) return false;
        int wgid = (int)L; { const int q = nwg / NXCD, r = nwg % NXCD, xcd = wgid % NXCD, off = wgid / NXCD; wgid = (xcd < r ? xcd * (q + 1) : r * (q + 1) + (xcd - r) * q) + off; }
        const int nig = WGM * nN, gid = wgid / nig, fm = gid * WGM, gsz = (nM - fm) < WGM ? (nM - fm) : WGM;
        pm = fm + ((wgid % nig) % gsz); pn = (wgid % nig) / gsz; return true;
    }
};

typedef float f32x2_cv __attribute__((ext_vector_type(2))); typedef __bf16 bf16x2_cv __attribute__((ext_vector_type(2)));
__device__ __forceinline__ unsigned cvt_pk_bf16(float lo, float hi) { const f32x2_cv v = {lo, hi}; const bf16x2_cv b = __builtin_convertvector(v, bf16x2_cv); return __builtin_bit_cast(unsigned, b); }

struct EpiBf16 {
    static constexpr bool PERM = true, AFTER_DRAIN = false, CHAIN = false;
    bf16_t* O; int ldc; int sig_from; float ds;
    __device__ __forceinline__ void operator()(const f32x4 (&acc)[2][2][4][2], const Unit& u, int wr, int wc, int fr, int fq) const {
        const int row0 = u.pm * BM + wr * 64 + fr; const int col0 = u.pn * BM + wc * 32 + 8 * fq;
#pragma unroll
        for (int ai = 0; ai < 2; ++ai)
#pragma unroll
            for (int m = 0; m < 4; ++m) { bf16_t* rowp = O + (size_t)(row0 + ai * HALF + m * 16) * ldc + col0;
#pragma unroll
                for (int bj = 0; bj < 2; ++bj) { f32x4 v0 = acc[ai][bj][m][0] * ds, v1 = acc[ai][bj][m][1] * ds;
                    if (u.pn >= sig_from) {
#pragma unroll
                        for (int k = 0; k < 4; ++k) { v0[k] = __builtin_amdgcn_rcpf(1.0f + __expf(-v0[k])); v1[k] = __builtin_amdgcn_rcpf(1.0f + __expf(-v1[k])); } }
                    u32x4 w; w.x = cvt_pk_bf16(v0[0], v0[1]); w.y = cvt_pk_bf16(v0[2], v0[3]); w.z = cvt_pk_bf16(v1[0], v1[1]); w.w = cvt_pk_bf16(v1[2], v1[3]);
                    *(u32x4*)(rowp + bj * HALF) = w; } }
    }
};

typedef int pg8_v4i __attribute__((ext_vector_type(4))); typedef int pg8_v8i __attribute__((ext_vector_type(8)));
__device__ __forceinline__ pg8_v8i f8cat(bf16x8 lo, bf16x8 hi) { const pg8_v4i a = __builtin_bit_cast(pg8_v4i, lo), b = __builtin_bit_cast(pg8_v4i, hi); return __builtin_shufflevector(a, b, 0, 1, 2, 3, 4, 5, 6, 7); }
template <class Epi, class Sched, bool ALIGN_EPI = false, bool SP2 = false, bool F8 = false>
__device__ __forceinline__ void gemm_phase(int tid_, PG8_LAS unsigned char* lds, const Gemm g, const Sched& S, const Epi& E) {
    const int tid = tid_, wid = __builtin_amdgcn_readfirstlane(tid >> 6), lane = tid & 63, wr = wid >> 2, wc = wid & 3, fr = lane & 15, fq = lane >> 4;
    const int K = g.K, nt = F8 ? K / 128 : K / BK; constexpr int ESZ = F8 ? 1 : 2;
    unsigned voffA[2], voffB[2];
#pragma unroll
    for (int i = 0; i < 2; ++i) { int R, C; stage_rc(tid * 16 + i * 8192, R, C); const int Rb = Epi::PERM ? ((R & ~31) + perm32(R & 31)) : R;
        voffA[i] = (unsigned)(R * g.lda * ESZ + C * 2); voffB[i] = (unsigned)(Rb * g.ldb * ESZ + C * 2); }
    const size_t kstep = (size_t)(BK * 2);
    const size_t hstepA = (size_t)HALF * g.lda * ESZ, hstepB = (size_t)HALF * g.ldb * ESZ;
    const unsigned ldsw = (unsigned)wid * 1024u;
    const int aoff = lds_byte(wr * 64 + fr, fq * 8), boff = lds_byte(wc * 32 + fr, fq * 8);
#define PG8_SA(b, h) (((b) * 2 + (h)) * HTB)
#define PG8_SB(b, h) ((4 + (b) * 2 + (h)) * HTB)
#define PG8_STAGE(bufoff, gbase, voff) do { _Pragma("unroll") for (int _i = 0; _i < 2; ++_i) \
        __builtin_amdgcn_global_load_lds((const unsigned*)((const char*)(gbase) + (voff)[_i]), (PG8_LAS unsigned*)(lds + (bufoff) + ldsw + _i * 8192), 16, 0, 0); } while (0)
#define PG8_LDA(dst, b, h) do { _Pragma("unroll") for (int m = 0; m < 4; ++m) { const bf16x8 lo_ = *(const PG8_LAS bf16x8*)(lds + PG8_SA(b, h) + aoff + m * 2048), hi_ = *(const PG8_LAS bf16x8*)(lds + PG8_SA(b, h) + aoff + m * 2048 + 1024); \
        if constexpr (F8) dst##8[m] = f8cat(lo_, hi_); else { dst[m][0] = lo_; dst[m][1] = hi_; } } } while (0)
#define PG8_LDB(dst, b, h) do { _Pragma("unroll") for (int n = 0; n < 2; ++n) { const bf16x8 lo_ = *(const PG8_LAS bf16x8*)(lds + PG8_SB(b, h) + boff + n * 2048), hi_ = *(const PG8_LAS bf16x8*)(lds + PG8_SB(b, h) + boff + n * 2048 + 1024); \
        if constexpr (F8) dst##8[n] = f8cat(lo_, hi_); else { dst[n][0] = lo_; dst[n][1] = hi_; } } } while (0)
#define PG8_MMA(ai, bj, At, Bt) do { __builtin_amdgcn_s_setprio(1); _Pragma("unroll") for (int m = 0; m < 4; ++m) _Pragma("unroll") for (int n = 0; n < 2; ++n) { \
        if constexpr (F8) asm volatile("v_mfma_scale_f32_16x16x128_f8f6f4 %0, %1, %2, %0, %3, %3 op_sel_hi:[0,0,0]" : "+v"(acc[ai][bj][m][n]) : "v"(Bt##8[n]), "v"(At##8[m]), "v"(f8scale));   \
        else { _Pragma("unroll") for (int k = 0; k < 2; ++k) acc[ai][bj][m][n] = __builtin_amdgcn_mfma_f32_16x16x32_bf16(Bt[n][k], At[m][k], acc[ai][bj][m][n], 0, 0, 0); } } __builtin_amdgcn_s_setprio(0); } while (0)
#define PG8_WAIT_V(n) asm volatile("s_waitcnt vmcnt(" #n ")" ::: "memory")
#define PG8_WAIT_L(n) asm volatile("s_waitcnt lgkmcnt(" #n ")" ::: "memory")
#define PG8_BAR __builtin_amdgcn_s_barrier()
#define PG8_SCHED __builtin_amdgcn_sched_barrier(0)
    Unit cur, nxt; int ui = 0;
    if (!S.next(0, cur)) return;
    f32x4 acc[2][2][4][2];
#pragma unroll
    for (int a = 0; a < 2; ++a)
#pragma unroll
        for (int b = 0; b < 2; ++b)
#pragma unroll
            for (int m = 0; m < 4; ++m)
#pragma unroll
                for (int n = 0; n < 2; ++n) acc[a][b][m][n] = (f32x4){0.f, 0.f, 0.f, 0.f};
    bf16x8 At[4][2], B0[2][2], B1[2][2]; pg8_v8i At8[4], B08[2], B18[2]; const int f8scale = 0x7f7f7f7f;
    const char* cA = cur.a; const char* cB = cur.b;
    S.a_ready(cur);
    if constexpr (SP2) {
        PG8_STAGE(PG8_SB(0, 0), cB, voffB); PG8_STAGE(PG8_SB(0, 1), cB + hstepB, voffB); PG8_STAGE(PG8_SA(0, 0), cA, voffA); PG8_STAGE(PG8_SA(0, 1), cA + hstepA, voffA);
        if (wr == 1) PG8_BAR;
        PG8_WAIT_V(2); PG8_BAR;
        PG8_STAGE(PG8_SB(1, 0), cB + kstep, voffB); PG8_STAGE(PG8_SA(1, 0), cA + kstep, voffA); PG8_STAGE(PG8_SB(1, 1), cB + hstepB + kstep, voffB);
        PG8_WAIT_V(6); PG8_BAR;
    } else {
        PG8_STAGE(PG8_SB(0, 0), cB, voffB); PG8_STAGE(PG8_SA(0, 0), cA, voffA); PG8_STAGE(PG8_SB(0, 1), cB + hstepB, voffB); PG8_STAGE(PG8_SA(0, 1), cA + hstepA, voffA);
        if (wr == 1) PG8_BAR;
        PG8_WAIT_V(4); PG8_BAR;
        PG8_STAGE(PG8_SB(1, 0), cB + kstep, voffB); PG8_STAGE(PG8_SA(1, 0), cA + kstep, voffA); PG8_STAGE(PG8_SB(1, 1), cB + hstepB + kstep, voffB);
        PG8_WAIT_V(6); PG8_BAR;
    }
    for (;;) {
        const bool has_next = S.next(ui + 1, nxt);
        const char* nA = has_next ? nxt.a : cA; const char* nB = has_next ? nxt.b : cB;
#pragma unroll 1
        for (int t = 0; t < nt; t += 2) {
            const bool last = (t == nt - 2);
            const char* a1 = cA + (size_t)(t + 1) * kstep;
            const char* a2 = last ? nA : cA + (size_t)(t + 2) * kstep; const char* b2 = last ? nB : cB + (size_t)(t + 2) * kstep;
            const char* a3 = a2 + kstep; const char* b3 = b2 + kstep;
            if (last && has_next) S.a_ready(nxt);
            if constexpr (SP2) {
            PG8_LDB(B0, 0, 0); PG8_LDB(B1, 0, 1); PG8_SCHED; PG8_LDA(At, 0, 0); PG8_STAGE(PG8_SA(1, 1), a1 + hstepA, voffA);
            PG8_WAIT_V(8); PG8_WAIT_L(0); PG8_BAR; PG8_MMA(0, 0, At, B0); PG8_MMA(0, 1, At, B1); PG8_BAR; PG8_SCHED;
            PG8_LDA(At, 0, 1); PG8_STAGE(PG8_SB(0, 0), b2, voffB); PG8_STAGE(PG8_SB(0, 1), b2 + hstepB, voffB); PG8_STAGE(PG8_SA(0, 0), a2, voffA);
            PG8_WAIT_V(8); PG8_WAIT_L(0); PG8_BAR; PG8_MMA(1, 0, At, B0); PG8_MMA(1, 1, At, B1); PG8_BAR; PG8_SCHED;
            PG8_LDB(B0, 1, 0); PG8_LDB(B1, 1, 1); PG8_SCHED; PG8_LDA(At, 1, 0); PG8_STAGE(PG8_SA(0, 1), a2 + hstepA, voffA);
            PG8_WAIT_V(8); PG8_WAIT_L(0); PG8_BAR; PG8_MMA(0, 0, At, B0); PG8_MMA(0, 1, At, B1); PG8_BAR; PG8_SCHED;
            PG8_LDA(At, 1, 1); PG8_STAGE(PG8_SB(1, 0), b3, voffB); PG8_STAGE(PG8_SB(1, 1), b3 + hstepB, voffB); PG8_STAGE(PG8_SA(1, 0), a3, voffA);
            PG8_WAIT_V(8); PG8_WAIT_L(0); PG8_BAR; PG8_MMA(1, 0, At, B0); PG8_MMA(1, 1, At, B1); PG8_BAR; PG8_SCHED;
            } else {
            PG8_LDB(B0, 0, 0); PG8_SCHED; PG8_LDA(At, 0, 0); PG8_STAGE(PG8_SA(1, 1), a1 + hstepA, voffA);
            PG8_WAIT_L(8); PG8_BAR; PG8_WAIT_L(0); PG8_MMA(0, 0, At, B0); PG8_BAR; PG8_SCHED;
            PG8_LDB(B1, 0, 1); PG8_STAGE(PG8_SB(0, 0), b2, voffB);
            PG8_BAR; PG8_WAIT_L(0); PG8_MMA(0, 1, At, B1); PG8_BAR;
            PG8_LDA(At, 0, 1); PG8_STAGE(PG8_SA(0, 0), a2, voffA);
            PG8_BAR; PG8_WAIT_L(0); PG8_MMA(1, 0, At, B0); PG8_BAR; PG8_SCHED;
            PG8_STAGE(PG8_SB(0, 1), b2 + hstepB, voffB);
            PG8_WAIT_V(6); PG8_BAR; PG8_MMA(1, 1, At, B1); PG8_BAR;
            PG8_LDB(B0, 1, 0); PG8_SCHED; PG8_LDA(At, 1, 0); PG8_STAGE(PG8_SA(0, 1), a2 + hstepA, voffA);
            PG8_WAIT_L(8); PG8_BAR; PG8_WAIT_L(0); PG8_MMA(0, 0, At, B0); PG8_BAR; PG8_SCHED;
            PG8_LDB(B1, 1, 1); PG8_STAGE(PG8_SB(1, 0), b3, voffB);
            PG8_BAR; PG8_WAIT_L(0); PG8_MMA(0, 1, At, B1); PG8_BAR;
            PG8_LDA(At, 1, 1); PG8_STAGE(PG8_SA(1, 0), a3, voffA);
            PG8_BAR; PG8_WAIT_L(0); PG8_MMA(1, 0, At, B0); PG8_BAR; PG8_SCHED;
            PG8_STAGE(PG8_SB(1, 1), b3 + hstepB, voffB);
            PG8_WAIT_V(6); PG8_BAR; PG8_MMA(1, 1, At, B1); PG8_BAR;
            }
        }
        if constexpr (ALIGN_EPI) { if (wr == 0) PG8_BAR; }
        if constexpr (F8) asm volatile("s_nop 15\n\ts_nop 7" ::: "memory");
        bool keep = false;
        if constexpr (!Epi::AFTER_DRAIN) { if constexpr (Epi::CHAIN) keep = E.chain(acc, cur, wr, wc, fr, fq); else E(acc, cur, wr, wc, fr, fq); S.done(cur); }
        if (!has_next) break;
        if (!keep) {
#pragma unroll
        for (int a = 0; a < 2; ++a)
#pragma unroll
            for (int b = 0; b < 2; ++b)
#pragma unroll
                for (int m = 0; m < 4; ++m)
#pragma unroll
                    for (int n = 0; n < 2; ++n) acc[a][b][m][n] = (f32x4){0.f, 0.f, 0.f, 0.f};
        }
        cur = nxt; cA = nA; cB = nB; ++ui;
        if constexpr (ALIGN_EPI) { if (wr == 1) PG8_BAR; }
    }
    PG8_WAIT_V(0);
    if constexpr (!ALIGN_EPI) { if (wr == 0) PG8_BAR; }
    PG8_BAR;
    if constexpr (Epi::AFTER_DRAIN) { E.fused(acc, cur, wr, wc, fr, fq, lds, wid, lane); S.done(cur); }
#undef PG8_SA
#undef PG8_SB
#undef PG8_STAGE
#undef PG8_LDA
#undef PG8_LDB
#undef PG8_MMA
#undef PG8_WAIT_V
#undef PG8_WAIT_L
#undef PG8_BAR
#undef PG8_SCHED
}
}

#define GAS __attribute__((address_space(1)))
#define LAS __attribute__((address_space(3)))
typedef unsigned short bf16;
typedef unsigned v4u __attribute__((ext_vector_type(4)));
typedef unsigned v2u __attribute__((ext_vector_type(2)));
typedef float f32x4 __attribute__((ext_vector_type(4)));
typedef float f32x2 __attribute__((ext_vector_type(2)));
typedef GAS unsigned gu32;
#define RLX_AGENT __ATOMIC_RELAXED, __HIP_MEMORY_SCOPE_AGENT
#define LDS_WAIT() asm volatile("s_waitcnt lgkmcnt(0)" ::: "memory")
#define VM_WAIT() asm volatile("s_waitcnt vmcnt(0)" ::: "memory")
__device__ __forceinline__ unsigned pk2(float lo, float hi) { return pg8::cvt_pk_bf16(lo, hi); }
__device__ __forceinline__ float bflo(unsigned w) { return __uint_as_float(w << 16); }
__device__ __forceinline__ float bfhi(unsigned w) { return __uint_as_float(w & 0xffff0000u); }
__device__ __forceinline__ float bf2f(bf16 b) { return __uint_as_float((unsigned)b << 16); }
__device__ __forceinline__ bf16 f2bf(float f) { return (bf16)(pk2(f, 0.f) & 0xffffu); }
__device__ __forceinline__ float bfround(float f) { return bflo(pk2(f, 0.f)); }
__device__ __forceinline__ unsigned pk4_fp8(float a, float b, float c, float d) {
    a = fminf(fmaxf(a, -448.f), 448.f); b = fminf(fmaxf(b, -448.f), 448.f); c = fminf(fmaxf(c, -448.f), 448.f); d = fminf(fmaxf(d, -448.f), 448.f);
    int p = 0; p = __builtin_amdgcn_cvt_pk_fp8_f32(a, b, p, false); p = __builtin_amdgcn_cvt_pk_fp8_f32(c, d, p, true); return (unsigned)p; }
__device__ __forceinline__ float rcp_(float x) { return __builtin_amdgcn_rcpf(x); }
__device__ __forceinline__ float sigmoidf_(float x) { return rcp_(1.0f + __expf(-x)); }

#define XB_TMO      128
#define XB_XCNT(j)  (256  + 64 * (j))
#define XB_XSUB(j)  (1280 + 64 * (j))
#define XB_XGEN(j)  (2304 + 64 * (j))
#define XB_TOP      3328
#define XB_TOPGEN   3392
#define XCD_BAR_WORDS 3456
#define XB_SPIN_CAP (1u << 18)

__device__ __forceinline__ unsigned xb_ld(unsigned* p)              { return __hip_atomic_load(p, __ATOMIC_RELAXED, __HIP_MEMORY_SCOPE_AGENT); }
__device__ __forceinline__ unsigned xb_add(unsigned* p, unsigned v) { return __hip_atomic_fetch_add(p, v, __ATOMIC_RELAXED, __HIP_MEMORY_SCOPE_AGENT); }
__device__ __forceinline__ unsigned xb_xcc_id() { return (unsigned)__builtin_amdgcn_s_getreg((3 << 11) | 20) & 0xFu; }
#define XB_SPIN(cond, bar) do { unsigned _sp = 0; while (cond) { __builtin_amdgcn_s_sleep(1); \
    if ((++_sp & 255u) == 0u) { if (xb_ld(&(bar)[XB_TMO])) break; if (_sp > XB_SPIN_CAP) { atomicAdd(&(bar)[XB_TMO], 1u); break; } } } } while (0)

struct XcdBarrier {
    unsigned* bar; unsigned x;
    volatile LAS unsigned* st;
};

__device__ __forceinline__ XcdBarrier xcd_barrier_post(unsigned* bar, volatile LAS unsigned* st, bool leader) {
    XcdBarrier b; b.bar = bar; b.x = xb_xcc_id(); b.st = st;
    if (leader) (void)xb_add(&bar[XB_XCNT(b.x)], 1u);
    return b;
}
__device__ __forceinline__ void xcd_barrier_complete(unsigned* bar, unsigned x, unsigned& nloc, unsigned& nx) {
    const unsigned G = gridDim.x * gridDim.y * gridDim.z;
    unsigned sum, cnt, mine, sp = 0u;
    for (;;) {
        sum = 0u; cnt = 0u; mine = 0u;
#pragma unroll
        for (unsigned j = 0; j < 16; ++j) { const unsigned c = xb_ld(&bar[XB_XCNT(j)]); sum += c; cnt += (c > 0u) ? 1u : 0u; mine = (j == x) ? c : mine; }
        if (sum == G) break;
        __builtin_amdgcn_s_sleep(1);
        if ((++sp & 255u) == 0u) { if (xb_ld(&bar[XB_TMO])) break; if (sp > XB_SPIN_CAP) { atomicAdd(&bar[XB_TMO], 1u); break; } }
    }
    nloc = mine > 0u ? mine : 1u; nx = cnt > 0u ? cnt : 1u;
}

__device__ __forceinline__ void xcd_barrier(const XcdBarrier& b_, bool leader) {
    XcdBarrier b = b_; asm volatile("" : "+s"(b.x));
    asm volatile("s_waitcnt vmcnt(0)" ::: "memory");
    __syncthreads();
    if (leader) {
        unsigned* bar = b.bar;
        __builtin_amdgcn_s_waitcnt(0);
        unsigned nloc = b.st[0], nx = b.st[1];
        if (nloc == 0u) { xcd_barrier_complete(bar, b.x, nloc, nx); b.st[0] = nloc; b.st[1] = nx; }
        const unsigned old = xb_add(&bar[XB_XSUB(b.x)], 1u);
        const unsigned gen = old / nloc;
        if (old + 1u == (gen + 1u) * nloc) {
            __builtin_amdgcn_fence(__ATOMIC_RELEASE, "agent");
            asm volatile("s_waitcnt vmcnt(0)" ::: "memory");
            const unsigned og = xb_add(&bar[XB_TOP], 1u);
            const unsigned tg = og / nx;
            if (og + 1u == (tg + 1u) * nx) xb_add(&bar[XB_TOPGEN], 1u);
            else XB_SPIN(xb_ld(&bar[XB_TOPGEN]) == tg, bar);
            __builtin_amdgcn_fence(__ATOMIC_ACQUIRE, "agent");
            xb_add(&bar[XB_XGEN(b.x)], 1u);
            asm volatile("s_waitcnt vmcnt(0)" ::: "memory");
        } else {
            XB_SPIN(xb_ld(&bar[XB_XGEN(b.x)]) == gen, bar);
            __builtin_amdgcn_fence(__ATOMIC_ACQUIRE, "agent");
            asm volatile("s_waitcnt vmcnt(0)" ::: "memory");
        }
    }
    __syncthreads();
}

namespace moba {
using bf16x8=__attribute__((ext_vector_type(8)))short;
using s16x4=__attribute__((ext_vector_type(4)))short;
using f32x16=__attribute__((ext_vector_type(16)))float;
using u32x4=__attribute__((ext_vector_type(4)))unsigned;
typedef unsigned short bf16raw;
constexpr int SEQL=4096,NHEAD=8,HDIM=64,DM=7168;
constexpr int COLQ=1536,COLK=2048,COLV=2560;
constexpr int NW=8,QBLK=32,QB=QBLK*NW,KVBLK=64;
__device__ __forceinline__ int crow(int r,int hi){return (r&3)+8*(r>>2)+4*hi;}
#define SBAR() __builtin_amdgcn_sched_barrier(0)
__device__ __forceinline__ void cmask(f32x16&p0,f32x16&p1,int jb,int qrel,int hi){
  const float NEG=-INFINITY; int kb=64*jb+4*hi;
  #pragma unroll
  for(int r=0;r<16;++r){int kv=kb+(r&3)+8*(r>>2); if(kv>qrel)p0[r]=NEG; if(kv+32>qrel)p1[r]=NEG;}
}
constexpr int NSLOT=3, SLOTB=8192;
constexpr int LDS_K=0, LDS_V=NSLOT*SLOTB, LDS_WS=2*NSLOT*SLOTB, LDS_OST=LDS_WS+NW*64*4, LDS_KM=LDS_OST+NW*4096, LDS_BYTES=LDS_KM+4096;
__device__ __forceinline__ void glds16(const void*gsrc,unsigned lds_dst){unsigned keep;
  asm volatile("s_mov_b32 %0, m0\n\ts_mov_b32 m0, %2\n\ts_nop 0\n\tglobal_load_lds_dwordx4 %1, off\n\ts_mov_b32 m0, %0":"=&s"(keep):"v"(gsrc),"s"(lds_dst):"memory");}
typedef float f32x2_t __attribute__((ext_vector_type(2))); typedef __bf16 bf16x2_t __attribute__((ext_vector_type(2)));
__device__ __forceinline__ unsigned cvtpk_s(float lo,float hi){f32x2_t v={lo,hi};bf16x2_t b=__builtin_convertvector(v,bf16x2_t);return __builtin_bit_cast(unsigned,b);}
#define WAIT_BAR(N) asm volatile("s_waitcnt vmcnt(" #N ") lgkmcnt(0)\n\ts_barrier":::"memory")

__device__ __forceinline__ void qkt(f32x16&p0,f32x16&p1,const char*Kslot,const bf16x8*qr,int r32,int hi){
  const char*kb=Kslot+hi*1024+r32*16; const f32x16 zf=f32x16{};
  #pragma unroll
  for(int d0=0;d0<4;++d0){
    const bf16x8 b0=*reinterpret_cast<const bf16x8*>(kb+d0*2048);
    const bf16x8 b1=*reinterpret_cast<const bf16x8*>(kb+d0*2048+512);
    if(d0==0){p0=__builtin_amdgcn_mfma_f32_32x32x16_bf16(b0,qr[0],zf,0,0,0);p1=__builtin_amdgcn_mfma_f32_32x32x16_bf16(b1,qr[0],zf,0,0,0);}
    else{p0=__builtin_amdgcn_mfma_f32_32x32x16_bf16(b0,qr[d0],p0,0,0,0);p1=__builtin_amdgcn_mfma_f32_32x32x16_bf16(b1,qr[d0],p1,0,0,0);}}
}
typedef __attribute__((address_space(3))) const char* lds_cptr;
typedef short v4i16_t __attribute__((ext_vector_type(4)));
__device__ __forceinline__ void kload8(bf16x8*kf,lds_cptr kp){
  kf[0]=*(const __attribute__((address_space(3))) bf16x8*)(kp);      kf[1]=*(const __attribute__((address_space(3))) bf16x8*)(kp+512);
  kf[2]=*(const __attribute__((address_space(3))) bf16x8*)(kp+2048); kf[3]=*(const __attribute__((address_space(3))) bf16x8*)(kp+2560);
  kf[4]=*(const __attribute__((address_space(3))) bf16x8*)(kp+4096); kf[5]=*(const __attribute__((address_space(3))) bf16x8*)(kp+4608);
  kf[6]=*(const __attribute__((address_space(3))) bf16x8*)(kp+6144); kf[7]=*(const __attribute__((address_space(3))) bf16x8*)(kp+6656);
}
__device__ __forceinline__ void kload2(bf16x8*kf,lds_cptr kp,int j){ kf[2*j]=*(const __attribute__((address_space(3))) bf16x8*)(kp+j*2048); kf[2*j+1]=*(const __attribute__((address_space(3))) bf16x8*)(kp+j*2048+512); }
__device__ __forceinline__ s16x4 vtr(lds_cptr p){ return __builtin_bit_cast(s16x4,__builtin_amdgcn_ds_read_tr16_b64_v4i16((__attribute__((address_space(3))) v4i16_t*)p)); }
__device__ __forceinline__ void pv(f32x16*o,int vb,bf16x8 pa0,bf16x8 pa1,bf16x8 pa2,bf16x8 pa3){
  #pragma unroll
  for(int d0=0;d0<2;++d0){s16x4 lo[4],hi[4];
    #pragma unroll
    for(int ks=0;ks<4;++ks){
      asm volatile("ds_read_b64_tr_b16 %0,%1 offset:%c2":"=&v"(lo[ks]):"v"(vb),"i"(d0*4096+ks*1024):"memory");
      asm volatile("ds_read_b64_tr_b16 %0,%1 offset:%c2":"=&v"(hi[ks]):"v"(vb),"i"(d0*4096+ks*1024+512):"memory");}
    asm volatile("s_waitcnt lgkmcnt(0)":::"memory");SBAR();
    #define PK(k) (bf16x8){lo[k][0],lo[k][1],lo[k][2],lo[k][3],hi[k][0],hi[k][1],hi[k][2],hi[k][3]}
    o[d0]=__builtin_amdgcn_mfma_f32_32x32x16_bf16(pa0,PK(0),o[d0],0,0,0);
    o[d0]=__builtin_amdgcn_mfma_f32_32x32x16_bf16(pa1,PK(1),o[d0],0,0,0);
    o[d0]=__builtin_amdgcn_mfma_f32_32x32x16_bf16(pa2,PK(2),o[d0],0,0,0);
    o[d0]=__builtin_amdgcn_mfma_f32_32x32x16_bf16(pa3,PK(3),o[d0],0,0,0);
    #undef PK
  }
}
__device__ __forceinline__ float bfl(short s){return __uint_as_float(((unsigned)(unsigned short)s)<<16);}

__device__ __forceinline__ void moba_unit(int tid_in,int b,int h,int qb,bf16raw*P,const float*KM,char*shm,int ocol=COLQ){
  int tid=tid_in; asm volatile("":"+v"(tid));
  const int lane=tid&63,r32=lane&31,hi=lane>>5; const int wid=__builtin_amdgcn_readfirstlane(tid>>6);
  const long rowbase=(long)b*SEQL; const int q0=qb*QB;
  bf16raw*Qw=P+(rowbase+q0+wid*QBLK)*DM+COLQ+h*HDIM;
  const bf16raw*Kh=P+rowbase*DM+COLK+h*HDIM,*Vh=P+rowbase*DM+COLV+h*HDIM;
  const unsigned lds0=(unsigned)(uintptr_t)shm;
  float*wsf=(float*)(shm+LDS_WS)+wid*64;
  bf16x8 qr[4];
  #pragma unroll
  for(int d0=0;d0<4;++d0)qr[d0]=*reinterpret_cast<const bf16x8*>(&Qw[(long)r32*DM+d0*16+hi*8]);
  unsigned selbits=(1u<<qb)-1u;
  if(qb>3){
    float*kml=(float*)(shm+LDS_KM);
    { const float*src=KM+(long)((b*NHEAD+h)*16)*HDIM; const f32x2_t v=*(const f32x2_t*)(src+2*tid); *(f32x2_t*)(kml+2*tid)=v; }
    asm volatile("s_waitcnt vmcnt(0) lgkmcnt(0)\n\ts_barrier":::"memory");
    float qf[32];
    #pragma unroll
    for(int d0=0;d0<4;++d0)
      #pragma unroll
      for(int e=0;e<8;++e)qf[d0*8+e]=bfl(qr[d0][e]);
    float g0=-INFINITY,g1=-INFINITY,g2=-INFINITY; int s0=0,s1=0,s2=0;
    for(int jb=0;jb<qb;++jb){
      const float*kr=kml+jb*64+hi*8; float g=0.f;
      #pragma unroll
      for(int d0=0;d0<4;++d0){ const f32x2_t*k2=(const f32x2_t*)(kr+d0*16);
        #pragma unroll
        for(int e=0;e<4;++e){ const f32x2_t kv=k2[e]; g+=qf[d0*8+2*e]*kv.x; g+=qf[d0*8+2*e+1]*kv.y; } }
      {auto rr=__builtin_amdgcn_permlane32_swap(__float_as_uint(g),__float_as_uint(g),false,false);g=__uint_as_float(rr[0])+__uint_as_float(rr[1]);}
      if(g>g0){g2=g1;s2=s1;g1=g0;s1=s0;g0=g;s0=jb;} else if(g>g1){g2=g1;s2=s1;g1=g;s1=jb;} else if(g>g2){g2=g;s2=jb;}
    }
    selbits=(1u<<s0)|(1u<<s1)|(1u<<s2);
  }
  #define TMASK(t) (((t)<4)?0xffffffffu:(0u-((selbits>>(((t)-4)>>2))&1u)))
  const bf16raw*ksrc=Kh+(long)lane*DM+wid*8;
  const bf16raw*vsrc=Vh+(long)(16*(wid&3)+(lane>>2))*DM+(wid>>2)*32+(lane&3)*8;
  const unsigned kdst=lds0+LDS_K+wid*1024, vdst=lds0+LDS_V+wid*1024;
  #define KT(t) (((t)<4)?(4*qb+(t)):((t)-4))
  #define DMA_K(t,slot) glds16(ksrc+(long)KT(t)*KVBLK*DM,(unsigned)__builtin_amdgcn_readfirstlane(kdst+(slot)))
  #define DMA_V(t,slot) glds16(vsrc+(long)KT(t)*KVBLK*DM,(unsigned)__builtin_amdgcn_readfirstlane(vdst+(slot)))
  const char*Kbase=shm+LDS_K; bf16x8 kf[8];
  const lds_cptr shm3=(lds_cptr)shm; const lds_cptr kp0=shm3+LDS_K+hi*1024+r32*16; const lds_cptr vp0=shm3+LDS_V+((lane>>4)&1)*32+(lane&3)*8+(4*hi+((lane&15)>>2))*64;
  const int vb0=(int)(lds0+LDS_V)+((lane>>4)&1)*32+(lane&3)*8+(4*hi+((lane&15)>>2))*64;
  const int NT=4*qb+4;
  DMA_K(0,0);DMA_V(0,0);DMA_K(1,SLOTB);
  float l_reg=0.f;f32x16 o[2];o[0]=f32x16{};o[1]=f32x16{};
  const int qrel=wid*QBLK+r32;
  f32x16 pA0,pA1,pB0,pB1;
  int sl_prev=0,sl_cur=0,sl_next=SLOTB;
  #define ROT() do{sl_prev=sl_cur;sl_cur=sl_next;sl_next=(sl_next==(NSLOT-1)*SLOTB)?0:sl_next+SLOTB;}while(0)
  DMA_K(2,2*SLOTB);
  WAIT_BAR(3);
  qkt(pA0,pA1,Kbase,qr,r32,hi);asm volatile("s_nop 15\n\ts_nop 7":"+v"(pA0),"+v"(pA1));cmask(pA0,pA1,0,qrel,hi);
  _Pragma("unroll") for(int r=0;r<16;++r){pA0[r]=__builtin_amdgcn_exp2f(pA0[r]);pA1[r]=__builtin_amdgcn_exp2f(pA1[r]);}
  WAIT_BAR(0);
  DMA_K(3,0);DMA_V(1,SLOTB);
  ROT();
  kload8(kf,kp0+sl_cur);
  WAIT_BAR(2);
  s16x4 vlo[8],vhi[8]; u32x4 pw0,pw1,pw2,pw3;
  const f32x16 zf=f32x16{};
  #define PKW(P,B) (cvtpk_s(P[B],P[B+1])&mprev_)
  #define PAF(k) __builtin_bit_cast(bf16x8,pw##k)
  #define VFR(i) (bf16x8){vlo[i][0],vlo[i][1],vlo[i][2],vlo[i][3],vhi[i][0],vhi[i][1],vhi[i][2],vhi[i][3]}
  #define PIN(x) asm volatile("":"+v"(x))
  #define GAPA(MF,A0,A1,A2,A3,W0,W1,PW) do{ MF; sacc+=A0; sacc+=A1; sacc+=A2; sacc+=A3; PIN(sacc); W0; W1; PIN(PW); SBAR(); }while(0)
  #define EX(v) __builtin_amdgcn_exp2f(v)
  #define GAPB(MF,X,B) do{ MF; X[B]=EX(X[B]); X[B+1]=EX(X[B+1]); X[B+2]=EX(X[B+2]); X[B+3]=EX(X[B+3]); PIN(X); SBAR(); }while(0)
  #define VRD(i) do{ vlo[i]=vtr(vp_+(((i)>>2)*4096+((i)&3)*1024)); vhi[i]=vtr(vp_+(((i)>>2)*4096+((i)&3)*1024+512)); }while(0)
  #define KRD(G,j) do{ if(G){ kload2(kf,kp0+sl_next,j); SBAR(); } }while(0)
  #define STEP(C0,C1,P0,P1,t,GK,GV,GL,CM) do{ SBAR(); \
    const unsigned mprev_=TMASK((t)-1); \
    const lds_cptr vp_=vp0+sl_prev; \
    VRD(0); SBAR(); float sacc=(P0[0]+P0[1]); \
    GAPA(C0=__builtin_amdgcn_mfma_f32_32x32x16_bf16(kf[0],qr[0],zf,0,0,0), P0[2],P0[3],P0[4],P0[5],     pw0[0]=PKW(P0,0), pw0[1]=PKW(P0,2), pw0); \
    VRD(4); SBAR(); GAPA(C1=__builtin_amdgcn_mfma_f32_32x32x16_bf16(kf[1],qr[0],zf,0,0,0), P0[6],P0[7],P0[8],P0[9],     pw0[2]=PKW(P0,4), pw0[3]=PKW(P0,6), pw0); \
    VRD(1); SBAR(); GAPA(C0=__builtin_amdgcn_mfma_f32_32x32x16_bf16(kf[2],qr[1],C0,0,0,0),   P0[10],P0[11],P0[12],P0[13], pw1[0]=PKW(P0,8), pw1[1]=PKW(P0,10), pw1); \
    VRD(5); SBAR(); GAPA(C1=__builtin_amdgcn_mfma_f32_32x32x16_bf16(kf[3],qr[1],C1,0,0,0),   P0[14],P0[15],P1[0],P1[1],   pw1[2]=PKW(P0,12),pw1[3]=PKW(P0,14), pw1); \
    VRD(2); SBAR(); GAPA(C0=__builtin_amdgcn_mfma_f32_32x32x16_bf16(kf[4],qr[2],C0,0,0,0),   P1[2],P1[3],P1[4],P1[5],     pw2[0]=PKW(P1,0), pw2[1]=PKW(P1,2), pw2); \
    VRD(6); SBAR(); GAPA(C1=__builtin_amdgcn_mfma_f32_32x32x16_bf16(kf[5],qr[2],C1,0,0,0),   P1[6],P1[7],P1[8],P1[9],     pw2[2]=PKW(P1,4), pw2[3]=PKW(P1,6), pw2); \
    VRD(3); SBAR(); GAPA(C0=__builtin_amdgcn_mfma_f32_32x32x16_bf16(kf[6],qr[3],C0,0,0,0),   P1[10],P1[11],P1[12],P1[13], pw3[0]=PKW(P1,8), pw3[1]=PKW(P1,10), pw3); \
    VRD(7); SBAR(); GAPA(C1=__builtin_amdgcn_mfma_f32_32x32x16_bf16(kf[7],qr[3],C1,0,0,0),   P1[14],P1[15],0.f,0.f,       pw3[2]=PKW(P1,12),pw3[3]=PKW(P1,14), pw3); \
    l_reg+=__uint_as_float(__float_as_uint(sacc)&mprev_); \
    if(GK){DMA_K((t)+3,sl_cur);} if(GV){DMA_V((t)+1,sl_next);} \
    if(CM){cmask(C0,C1,(t),qrel,hi);} \
    SBAR(); \
    GAPB(o[0]=__builtin_amdgcn_mfma_f32_32x32x16_bf16(PAF(0),VFR(0),o[0],0,0,0), C0,0); \
    GAPB(o[1]=__builtin_amdgcn_mfma_f32_32x32x16_bf16(PAF(0),VFR(4),o[1],0,0,0), C0,4); \
    KRD(GL,0); GAPB(o[0]=__builtin_amdgcn_mfma_f32_32x32x16_bf16(PAF(1),VFR(1),o[0],0,0,0), C0,8); \
    KRD(GL,1); GAPB(o[1]=__builtin_amdgcn_mfma_f32_32x32x16_bf16(PAF(1),VFR(5),o[1],0,0,0), C0,12); \
    KRD(GL,2); GAPB(o[0]=__builtin_amdgcn_mfma_f32_32x32x16_bf16(PAF(2),VFR(2),o[0],0,0,0), C1,0); \
    KRD(GL,3); GAPB(o[1]=__builtin_amdgcn_mfma_f32_32x32x16_bf16(PAF(2),VFR(6),o[1],0,0,0), C1,4); \
    GAPB(o[0]=__builtin_amdgcn_mfma_f32_32x32x16_bf16(PAF(3),VFR(3),o[0],0,0,0), C1,8); \
    GAPB(o[1]=__builtin_amdgcn_mfma_f32_32x32x16_bf16(PAF(3),VFR(7),o[1],0,0,0), C1,12); \
    }while(0)
  #define ENDW(tt) do{ if((tt)+3<NT){WAIT_BAR(2);} else if((tt)+2<NT){WAIT_BAR(1);} else {WAIT_BAR(0);} }while(0)
  STEP(pB0,pB1,pA0,pA1,1,(4<NT),true,true,true);          ENDW(1); ROT();
  STEP(pA0,pA1,pB0,pB1,2,(5<NT),true,true,true);          ENDW(2); ROT();
  STEP(pB0,pB1,pA0,pA1,3,(6<NT),(4<NT),(4<NT),true);
  if(NT>4){
    ENDW(3); ROT();
    int t=4;
    for(;t+5<NT;t+=2){
      STEP(pA0,pA1,pB0,pB1,t,true,true,true,false);     WAIT_BAR(2); ROT();
      STEP(pB0,pB1,pA0,pA1,t+1,true,true,true,false);   WAIT_BAR(2); ROT();
    }
    for(;t+2<NT;t+=2){
      STEP(pA0,pA1,pB0,pB1,t,(t+3<NT),(t+1<NT),(t+1<NT),false);       ENDW(t);   ROT();
      STEP(pB0,pB1,pA0,pA1,t+1,(t+4<NT),(t+2<NT),(t+2<NT),false);     ENDW(t+1); ROT();
    }
    STEP(pA0,pA1,pB0,pB1,t,false,true,true,false);      ENDW(t); ROT();
    STEP(pB0,pB1,pA0,pA1,t+1,false,false,false,false);
  }
  { const unsigned mprev_=TMASK(NT-1);
    float sacc=pB0[0]+pB0[1]; _Pragma("unroll") for(int r=2;r<16;++r)sacc+=pB0[r]; _Pragma("unroll") for(int r=0;r<16;++r)sacc+=pB1[r]; l_reg+=__uint_as_float(__float_as_uint(sacc)&mprev_);
    pw0=(u32x4){PKW(pB0,0),PKW(pB0,2),PKW(pB0,4),PKW(pB0,6)};pw1=(u32x4){PKW(pB0,8),PKW(pB0,10),PKW(pB0,12),PKW(pB0,14)};pw2=(u32x4){PKW(pB1,0),PKW(pB1,2),PKW(pB1,4),PKW(pB1,6)};pw3=(u32x4){PKW(pB1,8),PKW(pB1,10),PKW(pB1,12),PKW(pB1,14)};
    SBAR(); pv(o,vb0+sl_cur,PAF(0),PAF(1),PAF(2),PAF(3)); }
  #undef PKW
  #undef PAF
  #undef VFR
  #undef PIN
  #undef GAPA
  #undef GAPB
  #undef EX
  #undef VRD
  #undef KRD
  #undef STEP
  #undef ENDW
  {auto rr=__builtin_amdgcn_permlane32_swap(__float_as_uint(l_reg),__float_as_uint(l_reg),false,false);l_reg=__uint_as_float(rr[0])+__uint_as_float(rr[1]);}
  if(hi==0)wsf[32+r32]=l_reg;asm volatile("s_waitcnt lgkmcnt(0)":::"memory");
  float rli[16];
  #pragma unroll
  for(int r=0;r<16;++r)rli[r]=__builtin_amdgcn_rcpf(wsf[32+crow(r,hi)]);
  { bf16raw*stg=(bf16raw*)(shm+LDS_OST)+wid*2048;
    #pragma unroll
    for(int r=0;r<16;++r){const int orow=crow(r,hi);
      #pragma unroll
      for(int d0=0;d0<2;++d0)stg[orow*64+d0*32+r32]=(bf16raw)(cvtpk_s(o[d0][r]*rli[r],0.f)&0xffffu);}
    asm volatile("s_waitcnt lgkmcnt(0)":::"memory");
    #pragma unroll
    for(int i=0;i<4;++i){const int row=i*8+(lane>>3),ch=lane&7; const u32x4 v=*(const u32x4*)(stg+row*64+ch*8); *(u32x4*)(Qw+(ocol-COLQ)+(long)row*DM+ch*8)=v;} }
  asm volatile("s_waitcnt lgkmcnt(0)\n\ts_barrier":::"memory");
  #undef DMA_K
  #undef DMA_V
  #undef KT
  #undef TMASK
  #undef ROT
}
#undef SBAR
#undef WAIT_BAR
}

constexpr int NWAVES = 8, NTHR = NWAVES * 64;
#ifndef MK_ONE_LAUNCH
#define MK_ONE_LAUNCH 1
#endif
constexpr int BATCH = 8, SEQ = 4096, D = 1024, M = BATCH * SEQ;
constexpr int NCOL = 7168;
constexpr int C_XA = 0, C_BA = 512, C_CA = 1024, C_Q = 1536, C_K = 2048, C_V = 2560, C_XC = 3072, C_GC = 3584, C_G = 4096;
constexpr int NH = 8, HD = 64, BLK = 256, NBLK = SEQ / BLK;
constexpr int DFF = 2816, EFF = 3584, NEXP = 8;
constexpr int LCH = 64, NCH = SEQ / LCH;
constexpr float EPS = 1e-6f;
constexpr float QSCALE = 0.18033688011112042f;
constexpr int MOE_DOWN_COST = 3;
constexpr int MOE_TILES = 136, MOE_ROWS = MOE_TILES * 256;
constexpr int N_PHASES = 20;

constexpr size_t MiB = 1u << 20;
constexpr size_t WS_CTL = 0, CTL_ZERO_BYTES = 1 * MiB;
constexpr size_t WS_ROPE = 1 * MiB;
constexpr size_t WS_KMEAN = 1 * MiB + 256 * 1024;
constexpr size_t WS_SUM = 2 * MiB;
constexpr size_t WS_TOK = 4 * MiB;
constexpr size_t WS_WL = 6 * MiB;
constexpr size_t WS_ROWTOK = 8 * MiB;
constexpr size_t WS_ROWW = 8 * MiB + 256 * 1024;
constexpr size_t ROWTAB_LIST = 512 * 1024;
constexpr size_t WS_XB = 9 * MiB;
constexpr size_t WS_WIN = 73 * MiB;
constexpr size_t WS_WOABC = 87 * MiB;
constexpr size_t WS_WO = 90 * MiB;
constexpr size_t WS_FGU = 92 * MiB;
constexpr size_t WS_FDN = 103 * MiB;
constexpr size_t WS_P = 109 * MiB;
constexpr size_t WS_HID0 = WS_P;
constexpr float SC_X8 = 8.f, SC_W8 = 64.f, SC_H8 = 8.f;
constexpr size_t WS_MGU = 73 * MiB;
constexpr size_t WS_MDN = 129 * MiB;
constexpr size_t WS_MH = 157 * MiB;
constexpr size_t MH_LIST = (size_t)MOE_ROWS * EFF, XG_LIST = (size_t)MOE_ROWS * D;
constexpr size_t WS_XG = 395 * MiB;
constexpr size_t WS_END = 557 * MiB;
static_assert(WS_P + (size_t)M * NCOL * 2 <= WS_END && WS_XG + 2 * XG_LIST <= WS_END && WS_MH + 2 * MH_LIST <= WS_XG && (size_t)MOE_ROWS * 4 <= 256 * 1024 && WS_MGU + (size_t)8 * 7168 * D <= WS_MDN && WS_MDN + (size_t)8 * D * EFF <= WS_MH && WS_FDN + (size_t)D * DFF * 2 <= WS_P, "d_ws map");
constexpr int CW_BAR = 4096;
constexpr int CW_CNT = 16384;

constexpr int RING_BYTES = 131072;
constexpr int MISC_OFF = 147456 - 256;
constexpr int LDS_BYTES = 147456;

struct Args { const float* in[25]; float* out; unsigned char* ws; int ph_lo, ph_hi; };
struct Ctx { LAS unsigned char* lds; int tid, lane, wave, bid, G; };

__device__ __forceinline__ float shx(float v, int o, int lane) { return __int_as_float(__builtin_amdgcn_ds_bpermute((lane ^ o) << 2, __float_as_int(v))); }
__device__ __forceinline__ float wave_sum(float v, int lane) {
#pragma unroll
    for (int o = 1; o < 64; o <<= 1) v += shx(v, o, lane);
    return v;
}

struct ConvJob { const float* W; int ldw; bf16* WT; int ldk, k0, n0, dst; bool f8; };
__device__ __forceinline__ void conv_load(const ConvJob& j, float (&tv)[32], int lane) {
#pragma unroll
    for (int i = 0; i < 32; ++i) tv[i] = j.W[(size_t)(j.k0 + 2 * i + (lane >> 5)) * j.ldw + j.n0 + (lane & 31)];
}
__device__ __forceinline__ void conv_store(const ConvJob& j, const float (&tv)[32], LAS float* scr, int lane) {
#pragma unroll
    for (int i = 0; i < 32; ++i) scr[(2 * i + (lane >> 5)) * 33 + (lane & 31)] = tv[i];
    LDS_WAIT(); asm volatile("" ::: "memory");
    const int c = lane & 7;
#pragma unroll
    for (int q = 0; q < 4; ++q) { const int n = (lane >> 3) + 8 * q; const LAS float* s = scr + (8 * c) * 33 + n;
        v4u o; o.x = pk2(s[0 * 33], s[1 * 33]); o.y = pk2(s[2 * 33], s[3 * 33]); o.z = pk2(s[4 * 33], s[5 * 33]); o.w = pk2(s[6 * 33], s[7 * 33]);
        *(GAS v4u*)(j.WT + (size_t)(j.dst + n) * j.ldk + j.k0 + 8 * c) = o; }
    LDS_WAIT(); asm volatile("" ::: "memory");
}
__device__ __forceinline__ void conv_store8(const ConvJob& j, const float (&tv)[32], LAS float* scr, int lane) {
#pragma unroll
    for (int i = 0; i < 32; ++i) scr[(2 * i + (lane >> 5)) * 33 + (lane & 31)] = tv[i];
    LDS_WAIT(); asm volatile("" ::: "memory");
    const int c = lane & 3; unsigned char* WT8 = (unsigned char*)j.WT;
#pragma unroll
    for (int q = 0; q < 2; ++q) { const int n = (lane >> 2) + 16 * q; const LAS float* s = scr + (16 * c) * 33 + n;
        v4u o; o.x = pk4_fp8(s[0 * 33] * SC_W8, s[1 * 33] * SC_W8, s[2 * 33] * SC_W8, s[3 * 33] * SC_W8); o.y = pk4_fp8(s[4 * 33] * SC_W8, s[5 * 33] * SC_W8, s[6 * 33] * SC_W8, s[7 * 33] * SC_W8);
        o.z = pk4_fp8(s[8 * 33] * SC_W8, s[9 * 33] * SC_W8, s[10 * 33] * SC_W8, s[11 * 33] * SC_W8); o.w = pk4_fp8(s[12 * 33] * SC_W8, s[13 * 33] * SC_W8, s[14 * 33] * SC_W8, s[15 * 33] * SC_W8);
        *(GAS v4u*)(WT8 + (size_t)(j.dst + n) * j.ldk + j.k0 + 16 * c) = o; }
    LDS_WAIT(); asm volatile("" ::: "memory");
}
__device__ __forceinline__ ConvJob conv_job(const float* W, int K, int N, bf16* WT, int mode, int item, bool f8 = false) {
    const int nblk = N / 32, kb = item / nblk, nb = item - kb * nblk, k0 = 64 * kb, n0 = 32 * nb;
    const int dst = mode == 0 ? n0 : (n0 >> 7) * 256 + (n0 & 127) + (mode == 2 ? 128 : 0);
    return ConvJob{W, N, WT, K, k0, n0, dst, f8};
}
__device__ __forceinline__ ConvJob layer_job(const Args& A, int l, int it) {
    constexpr int I_IN = 16 * 224, I_A = 8 * 32, I_O = 16 * 32, I_G = 16 * 88;
    unsigned char* ws = A.ws; int r = it;
    if (r < I_IN) { const bool gate = (r % 224) >= 128;
        return gate ? conv_job(A.in[2] + (size_t)l * D * NCOL, D, NCOL, (bf16*)(ws + WS_WIN + (size_t)4096 * D), 0, r, true) : conv_job(A.in[2] + (size_t)l * D * NCOL, D, NCOL, (bf16*)(ws + WS_WIN), 0, r); } r -= I_IN;
    if (r < I_A) return conv_job(A.in[4] + (size_t)l * 512 * D, 512, D, (bf16*)(ws + WS_WOABC), 0, r); r -= I_A;
    if (r < I_A) return conv_job(A.in[7] + (size_t)l * 512 * D, 512, D, (bf16*)(ws + WS_WOABC) + 1024 * 512, 0, r); r -= I_A;
    if (r < I_A) return conv_job(A.in[15] + (size_t)l * 512 * D, 512, D, (bf16*)(ws + WS_WOABC) + 2 * 1024 * 512, 0, r); r -= I_A;
    if (r < I_O) return conv_job(A.in[16] + (size_t)l * D * D, D, D, (bf16*)(ws + WS_WO), 0, r); r -= I_O;
    if (r < I_G) return conv_job(A.in[18], D, DFF, (bf16*)(ws + WS_FGU), 1, r); r -= I_G;
    if (r < I_G) return conv_job(A.in[19], D, DFF, (bf16*)(ws + WS_FGU), 2, r); r -= I_G;
    return conv_job(A.in[20], DFF, D, (bf16*)(ws + WS_FDN), 0, r);
}
__device__ __forceinline__ void convert_layer_weights(const Ctx& C, const Args& A, int l) {
    LAS float* scr = (LAS float*)(C.lds + C.wave * 16896);
    const int gw = C.bid * NWAVES + C.wave, NGW = C.G * NWAVES;
    constexpr int I_IN = 16 * 224, I_A = 8 * 32, I_O = 16 * 32, I_G = 16 * 88, I_D = 44 * 32;
    const int nitems = I_IN + 3 * I_A + I_O + (l == 0 ? 2 * I_G + I_D : 0);
    for (int it = gw; it < nitems; it += 2 * NGW) {
        const bool two = it + NGW < nitems;
        const ConvJob j0 = layer_job(A, l, it), j1 = layer_job(A, l, two ? it + NGW : it);
        float t0[32], t1[32];
        conv_load(j0, t0, C.lane); if (two) conv_load(j1, t1, C.lane);
        if (j0.f8) conv_store8(j0, t0, scr, C.lane); else conv_store(j0, t0, scr, C.lane);
        if (two) { if (j1.f8) conv_store8(j1, t1, scr + 64 * 33, C.lane); else conv_store(j1, t1, scr + 64 * 33, C.lane); }
    }
}
__device__ __forceinline__ ConvJob moe_job(const Args& A, int it) {
    constexpr int I_G = 16 * 112, I_D = 56 * 32, PER_E = 2 * I_G + I_D;
    unsigned char* ws = A.ws; const int e = it / PER_E; int r = it - e * PER_E;
    if (r < I_G) return conv_job(A.in[22] + (size_t)e * D * EFF, D, EFF, (bf16*)(ws + WS_MGU + (size_t)e * 7168 * D), 1, r); r -= I_G;
    if (r < I_G) return conv_job(A.in[23] + (size_t)e * D * EFF, D, EFF, (bf16*)(ws + WS_MGU + (size_t)e * 7168 * D), 2, r); r -= I_G;
    return conv_job(A.in[24] + (size_t)e * EFF * D, EFF, D, (bf16*)(ws + WS_MDN + (size_t)e * D * EFF), 0, r);
}
__device__ __forceinline__ void convert_moe_weights(const Ctx& C, const Args& A) {
    LAS float* scr = (LAS float*)(C.lds + C.wave * 16896);
    const int gw = C.bid * NWAVES + C.wave, NGW = C.G * NWAVES;
    constexpr int NIT = NEXP * (2 * 16 * 112 + 56 * 32);
    for (int it = gw; it < NIT; it += 2 * NGW) {
        const bool two = it + NGW < NIT;
        const ConvJob j0 = moe_job(A, it), j1 = moe_job(A, two ? it + NGW : it);
        float t0[32], t1[32];
        conv_load(j0, t0, C.lane); if (two) conv_load(j1, t1, C.lane);
        conv_store8(j0, t0, scr, C.lane); if (two) conv_store8(j1, t1, scr + 64 * 33, C.lane);
    }
}
__device__ __forceinline__ void rope_table(const Ctx& C, unsigned char* ws) {
    const double invf_rev[8] = {0.15915494309189535, 0.03086376340470123, 0.005985185712713705, 0.001160663641240061,
                                0.00022507907903927653, 4.364795279280289e-05, 8.464330808241401e-06, 1.6414262627950345e-06};
    float* ct = (float*)(ws + WS_ROPE); float* st = ct + SEQ * 8;
    for (int g = C.bid * NTHR + C.tid; g < SEQ * 8; g += C.G * NTHR) {
        const int pos = g >> 3, i = g & 7;
        double f = invf_rev[0];
#pragma unroll
        for (int k = 1; k < 8; ++k) f = (i == k) ? invf_rev[k] : f;
        double t = (double)pos * f; t -= floor(t);
        ct[g] = __builtin_amdgcn_cosf((float)t); st[g] = __builtin_amdgcn_sinf((float)t);
    }
}

template <bool ROUTE, bool ALSO8>
__device__ __forceinline__ void norm_rows(const Ctx& C, const float* xin, const float* gain, bf16* XN, const float* router, unsigned char* ws, unsigned char* X8 = nullptr) {
    constexpr int RB = 4;
    const int gw = C.bid * NWAVES + C.wave, NGW = C.G * NWAVES;
    LAS float* R = (LAS float*)C.lds;
    LAS int* rt_tok = (LAS int*)(C.lds + 32768); LAS int* rt_e = rt_tok + 256; LAS float* rt_w = (LAS float*)(rt_e + 256);
    if (ROUTE) { for (int i = C.tid; i < D * NEXP / 4; i += NTHR) ((LAS f32x4*)R)[i] = ((const f32x4*)router)[i];
                 for (int i = C.tid; i < 256; i += NTHR) rt_tok[i] = -1;
                 __syncthreads(); }
    f32x4 g[4];
#pragma unroll
    for (int j = 0; j < 4; ++j) g[j] = ((const f32x4*)gain)[C.lane + 64 * j];
    int slot = C.wave;
    for (int m0 = gw; m0 < M; m0 += RB * NGW) {
        f32x4 v[RB][4];
#pragma unroll
        for (int i = 0; i < RB; ++i) { const int m = m0 + i * NGW; if (m < M) { const GAS f32x4* xr = (const GAS f32x4*)(xin + (size_t)m * D) + C.lane;
#pragma unroll
            for (int j = 0; j < 4; ++j) v[i][j] = xr[64 * j]; } }
#pragma unroll
        for (int i = 0; i < RB; ++i) { const int m = m0 + i * NGW; if (m < M) {
            float s = 0.f;
#pragma unroll
            for (int j = 0; j < 4; ++j) s += (v[i][j].x * v[i][j].x + v[i][j].y * v[i][j].y) + (v[i][j].z * v[i][j].z + v[i][j].w * v[i][j].w);
            const float rstd = 1.0f / sqrtf(wave_sum(s, C.lane) * (1.f / D) + EPS);
            GAS unsigned long long* o8 = (GAS unsigned long long*)(XN + (size_t)m * D) + C.lane;
#pragma unroll
            for (int j = 0; j < 4; ++j) { v[i][j] = v[i][j] * rstd * g[j]; o8[64 * j] = (unsigned long long)pk2(v[i][j].x, v[i][j].y) | ((unsigned long long)pk2(v[i][j].z, v[i][j].w) << 32);
                if (ALSO8) ((unsigned*)(X8 + (size_t)m * D))[C.lane + 64 * j] = pk4_fp8(v[i][j].x * SC_X8, v[i][j].y * SC_X8, v[i][j].z * SC_X8, v[i][j].w * SC_X8); }
            if (ROUTE) {
                float lg[8];
#pragma unroll
                for (int e = 0; e < 8; ++e) lg[e] = 0.f;
#pragma unroll
                for (int j = 0; j < 4; ++j)
#pragma unroll
                    for (int k = 0; k < 4; ++k) { const int d = 4 * C.lane + k + 256 * j; const f32x4 r0 = *(LAS f32x4*)(R + d * 8), r1 = *(LAS f32x4*)(R + d * 8 + 4); const float h = v[i][j][k];
                        lg[0] += h * r0.x; lg[1] += h * r0.y; lg[2] += h * r0.z; lg[3] += h * r0.w; lg[4] += h * r1.x; lg[5] += h * r1.y; lg[6] += h * r1.z; lg[7] += h * r1.w; }
#pragma unroll
                for (int e = 0; e < 8; ++e) lg[e] = wave_sum(lg[e], C.lane);
                float l1 = -INFINITY, l2 = -INFINITY; int e1 = 0, e2 = 0;
#pragma unroll
                for (int e = 0; e < 8; ++e) if (lg[e] > l1) { l1 = lg[e]; e1 = e; }
#pragma unroll
                for (int e = 0; e < 8; ++e) if (e != e1 && lg[e] > l2) { l2 = lg[e]; e2 = e; }
                if (C.lane == 0 && slot < 256) { rt_tok[slot] = m; rt_e[slot] = e1 | (e2 << 8); rt_w[slot] = 1.0f / (1.0f + expf(l2 - l1)); }
                slot += NWAVES;
            } } }
    }
    if (ROUTE) {
        __syncthreads();
        if (C.tid < 16) {
            const int list = C.tid >> 3, e = C.tid & 7; int n = 0;
            for (int sidx = 0; sidx < 256; ++sidx) { const int t = rt_tok[sidx]; const int ee = (rt_e[sidx] >> (8 * list)) & 0xff; n += (t >= 0 && ee == e) ? 1 : 0; }
            gu32* cnt = (gu32*)(ws + WS_CTL) + CW_CNT; int* tokl = (int*)(ws + WS_TOK); float* wl = (float*)(ws + WS_WL);
            unsigned pos = n ? __hip_atomic_fetch_add(cnt + C.tid, (unsigned)n, RLX_AGENT) : 0u;
            for (int sidx = 0; sidx < 256; ++sidx) { const int t = rt_tok[sidx]; const int ee = (rt_e[sidx] >> (8 * list)) & 0xff;
                if (t >= 0 && ee == e) { const float w1 = rt_w[sidx]; tokl[(size_t)C.tid * M + pos] = t; wl[(size_t)C.tid * M + pos] = list == 0 ? w1 : 1.0f - w1; ++pos; } }
        }
        __syncthreads();
    }
}

template <bool ROUTE, bool ALSO8 = false>
__device__ __forceinline__ void norm_rows_b(const Ctx& C, const bf16* xin, const float* gain, bf16* XN, const float* router, unsigned char* ws, unsigned char* X8 = nullptr) {
    constexpr int RB = 4;
    const int gw = C.bid * NWAVES + C.wave, NGW = C.G * NWAVES;
    LAS float* R = (LAS float*)C.lds;
    LAS int* rt_tok = (LAS int*)(C.lds + 32768); LAS int* rt_e = rt_tok + 256; LAS float* rt_w = (LAS float*)(rt_e + 256);
    if (ROUTE) { for (int i = C.tid; i < D * NEXP / 4; i += NTHR) ((LAS f32x4*)R)[i] = ((const f32x4*)router)[i];
                 for (int i = C.tid; i < 256; i += NTHR) rt_tok[i] = -1;
                 __syncthreads(); }
    float g[16];
#pragma unroll
    for (int c = 0; c < 2; ++c) { const f32x4 a = *(const f32x4*)(gain + 512 * c + 8 * C.lane), b = *(const f32x4*)(gain + 512 * c + 8 * C.lane + 4);
        g[8 * c] = a.x; g[8 * c + 1] = a.y; g[8 * c + 2] = a.z; g[8 * c + 3] = a.w; g[8 * c + 4] = b.x; g[8 * c + 5] = b.y; g[8 * c + 6] = b.z; g[8 * c + 7] = b.w; }
    int slot = C.wave;
    for (int m0 = gw; m0 < M; m0 += RB * NGW) {
        v4u raw[RB][2];
#pragma unroll
        for (int i = 0; i < RB; ++i) { const int m = m0 + i * NGW; if (m < M) { const v4u* xr = (const v4u*)(xin + (size_t)m * D) + C.lane; raw[i][0] = xr[0]; raw[i][1] = xr[64]; } }
#pragma unroll
        for (int i = 0; i < RB; ++i) { const int m = m0 + i * NGW; if (m < M) {
            float v[16];
#pragma unroll
            for (int c = 0; c < 2; ++c) { const v4u w = raw[i][c]; v[8 * c] = bflo(w.x); v[8 * c + 1] = bfhi(w.x); v[8 * c + 2] = bflo(w.y); v[8 * c + 3] = bfhi(w.y); v[8 * c + 4] = bflo(w.z); v[8 * c + 5] = bfhi(w.z); v[8 * c + 6] = bflo(w.w); v[8 * c + 7] = bfhi(w.w); }
            float s = 0.f;
#pragma unroll
            for (int k = 0; k < 16; ++k) s += v[k] * v[k];
            const float rstd = 1.0f / sqrtf(wave_sum(s, C.lane) * (1.f / D) + EPS);
#pragma unroll
            for (int k = 0; k < 16; ++k) v[k] = v[k] * rstd * g[k];
            if (ROUTE) {
                v2u* o8 = (v2u*)((unsigned char*)XN + (size_t)m * D) + C.lane;
#pragma unroll
                for (int c = 0; c < 2; ++c) { v2u w; w.x = pk4_fp8(v[8 * c] * SC_X8, v[8 * c + 1] * SC_X8, v[8 * c + 2] * SC_X8, v[8 * c + 3] * SC_X8); w.y = pk4_fp8(v[8 * c + 4] * SC_X8, v[8 * c + 5] * SC_X8, v[8 * c + 6] * SC_X8, v[8 * c + 7] * SC_X8); o8[64 * c] = w; }
            } else {
            v4u* o = (v4u*)(XN + (size_t)m * D) + C.lane;
#pragma unroll
            for (int c = 0; c < 2; ++c) { v4u w; w.x = pk2(v[8 * c], v[8 * c + 1]); w.y = pk2(v[8 * c + 2], v[8 * c + 3]); w.z = pk2(v[8 * c + 4], v[8 * c + 5]); w.w = pk2(v[8 * c + 6], v[8 * c + 7]); o[64 * c] = w; }
            if (ALSO8) { v2u* o8 = (v2u*)(X8 + (size_t)m * D) + C.lane;
#pragma unroll
                for (int c = 0; c < 2; ++c) { v2u w; w.x = pk4_fp8(v[8 * c] * SC_X8, v[8 * c + 1] * SC_X8, v[8 * c + 2] * SC_X8, v[8 * c + 3] * SC_X8); w.y = pk4_fp8(v[8 * c + 4] * SC_X8, v[8 * c + 5] * SC_X8, v[8 * c + 6] * SC_X8, v[8 * c + 7] * SC_X8); o8[64 * c] = w; } }
            }
            if (ROUTE) {
                float lg[8];
#pragma unroll
                for (int e = 0; e < 8; ++e) lg[e] = 0.f;
#pragma unroll
                for (int c = 0; c < 2; ++c)
#pragma unroll
                    for (int k = 0; k < 8; ++k) { const int d = 512 * c + 8 * C.lane + k; const f32x4 r0 = *(LAS f32x4*)(R + d * 8), r1 = *(LAS f32x4*)(R + d * 8 + 4); const float h = v[8 * c + k];
                        lg[0] += h * r0.x; lg[1] += h * r0.y; lg[2] += h * r0.z; lg[3] += h * r0.w; lg[4] += h * r1.x; lg[5] += h * r1.y; lg[6] += h * r1.z; lg[7] += h * r1.w; }
#pragma unroll
                for (int e = 0; e < 8; ++e) lg[e] = wave_sum(lg[e], C.lane);
                float l1 = -INFINITY, l2 = -INFINITY; int e1 = 0, e2 = 0;
#pragma unroll
                for (int e = 0; e < 8; ++e) if (lg[e] > l1) { l1 = lg[e]; e1 = e; }
#pragma unroll
                for (int e = 0; e < 8; ++e) if (e != e1 && lg[e] > l2) { l2 = lg[e]; e2 = e; }
                if (C.lane == 0 && slot < 256) { rt_tok[slot] = m; rt_e[slot] = e1 | (e2 << 8); rt_w[slot] = 1.0f / (1.0f + expf(l2 - l1)); }
                slot += NWAVES;
            } } }
    }
    if (ROUTE) {
        __syncthreads();
        if (C.tid < 16) {
            const int list = C.tid >> 3, e = C.tid & 7; int n = 0;
            for (int sidx = 0; sidx < 256; ++sidx) { const int t = rt_tok[sidx]; const int ee = (rt_e[sidx] >> (8 * list)) & 0xff; n += (t >= 0 && ee == e) ? 1 : 0; }
            gu32* cnt = (gu32*)(ws + WS_CTL) + CW_CNT; int* tokl = (int*)(ws + WS_TOK); float* wl = (float*)(ws + WS_WL);
            unsigned pos = n ? __hip_atomic_fetch_add(cnt + C.tid, (unsigned)n, RLX_AGENT) : 0u;
            for (int sidx = 0; sidx < 256; ++sidx) { const int t = rt_tok[sidx]; const int ee = (rt_e[sidx] >> (8 * list)) & 0xff;
                if (t >= 0 && ee == e) { const float w1 = rt_w[sidx]; tokl[(size_t)C.tid * M + pos] = t; wl[(size_t)C.tid * M + pos] = list == 0 ? w1 : 1.0f - w1; ++pos; } }
        }
        __syncthreads();
    }
}

__device__ __forceinline__ void qk_item(const Ctx& C, const Args& A, int l, int item) {
    unsigned char* ws = A.ws; bf16* P = (bf16*)(ws + WS_P);
    const float* ct = (const float*)(ws + WS_ROPE); const float* st = ct + SEQ * 8;
    const int rb = item >> 3, h = item & 7, ch = C.tid & 7, rg = C.tid >> 3;
    LAS float* part = (LAS float*)C.lds;
    for (int which = 0; which < 2; ++which) {
        const float* gn = A.in[which == 0 ? 5 : 6] + l * HD + ch * 8;
        const f32x4 ga = *(const f32x4*)gn, gb = *(const f32x4*)(gn + 4);
        const float gv[8] = {ga.x, ga.y, ga.z, ga.w, gb.x, gb.y, gb.z, gb.w};
        float ks[8];
#pragma unroll
        for (int j = 0; j < 8; ++j) ks[j] = 0.f;
        v4u wv[4]; f32x4 c0[4], c1[4], s0[4], s1[4];
#pragma unroll
        for (int pass = 0; pass < 4; ++pass) { const int row = rb * 256 + pass * 64 + rg, pos = row & (SEQ - 1);
            wv[pass] = *(const v4u*)(P + (size_t)row * NCOL + (which == 0 ? C_Q : C_K) + h * HD + ch * 8);
            c0[pass] = *(const f32x4*)(ct + pos * 8); c1[pass] = *(const f32x4*)(ct + pos * 8 + 4); s0[pass] = *(const f32x4*)(st + pos * 8); s1[pass] = *(const f32x4*)(st + pos * 8 + 4); }
#pragma unroll
        for (int pass = 0; pass < 4; ++pass) {
            const int row = rb * 256 + pass * 64 + rg;
            bf16* p = P + (size_t)row * NCOL + (which == 0 ? C_Q : C_K) + h * HD + ch * 8;
            const v4u w = wv[pass];
            float v[8] = {bflo(w.x), bfhi(w.x), bflo(w.y), bfhi(w.y), bflo(w.z), bfhi(w.z), bflo(w.w), bfhi(w.w)};
            const float cs8[8] = {c0[pass].x, c0[pass].y, c0[pass].z, c0[pass].w, c1[pass].x, c1[pass].y, c1[pass].z, c1[pass].w};
            const float sn8[8] = {s0[pass].x, s0[pass].y, s0[pass].z, s0[pass].w, s1[pass].x, s1[pass].y, s1[pass].z, s1[pass].w};
            float ss = 0.f;
#pragma unroll
            for (int j = 0; j < 8; ++j) ss += v[j] * v[j];
            ss += shx(ss, 1, C.lane); ss += shx(ss, 2, C.lane); ss += shx(ss, 4, C.lane);
            const float rstd = 1.0f / sqrtf(ss * (1.f / HD) + EPS);
#pragma unroll
            for (int j = 0; j < 8; ++j) v[j] = v[j] * rstd * gv[j];
#pragma unroll
            for (int j = 0; j < 8; ++j) {
                const float other = shx(v[j], 1, C.lane);
                const float rot = (ch == 0) ? (v[j] * cs8[j] - other * sn8[j]) : (v[j] * cs8[j] + other * sn8[j]);
                v[j] = (ch < 2) ? rot : v[j];
            }
            if (which == 0) {
#pragma unroll
                for (int j = 0; j < 8; ++j) v[j] *= QSCALE;
            } else {
#pragma unroll
                for (int j = 0; j < 8; ++j) ks[j] += v[j];
            }
            v4u o; o.x = pk2(v[0], v[1]); o.y = pk2(v[2], v[3]); o.z = pk2(v[4], v[5]); o.w = pk2(v[6], v[7]);
            *(v4u*)p = o;
        }
        if (which == 1) {
#pragma unroll
            for (int j = 0; j < 8; ++j) part[rg * 64 + ch * 8 + j] = ks[j];
            __syncthreads();
            if (C.tid < 64) { float s = 0.f;
#pragma unroll 16
                for (int r = 0; r < 64; ++r) s += part[r * 64 + C.tid];
                const int b = rb >> 4, blk = rb & 15;
                ((float*)(ws + WS_KMEAN))[(size_t)((b * NH + h) * NBLK + blk) * HD + C.tid] = s * (1.f / 256.f); }
            __syncthreads();
        }
    }
}
__device__ __forceinline__ void conva_tasks(const Ctx& C, const Args& A, int l) {
    bf16* P = (bf16*)(A.ws + WS_P); const float* cw = A.in[3] + l * 3 * 512;
    const int stride = C.G * NTHR;
    for (int g0 = C.bid * NTHR + C.tid; g0 < M * 64; g0 += 4 * stride) {
        v4u xa[4][3], ca[4][3], ba[4];
#pragma unroll
        for (int i = 0; i < 4; ++i) { const int g = g0 + i * stride; if (g < M * 64) { const int row = g >> 6, c = (g & 63) * 8, t = row & (SEQ - 1);
            const bf16* base = P + (size_t)row * NCOL + c;
#pragma unroll
            for (int k = 0; k < 3; ++k) { const int dt = 2 - k; if (t >= dt) { xa[i][k] = *(const v4u*)(base - (size_t)dt * NCOL + C_XA); ca[i][k] = *(const v4u*)(base - (size_t)dt * NCOL + C_CA); } else { xa[i][k] = (v4u){0u, 0u, 0u, 0u}; ca[i][k] = xa[i][k]; } }
            ba[i] = *(const v4u*)(base + C_BA); } }
#pragma unroll
        for (int i = 0; i < 4; ++i) { const int g = g0 + i * stride; if (g < M * 64) { const int row = g >> 6, c = (g & 63) * 8;
            float acc[8];
#pragma unroll
            for (int j = 0; j < 8; ++j) acc[j] = 0.f;
#pragma unroll
            for (int k = 0; k < 3; ++k) {
                const v4u x = xa[i][k], cc = ca[i][k];
                const f32x4 w0 = *(const f32x4*)(cw + k * 512 + c), w1 = *(const f32x4*)(cw + k * 512 + c + 4);
                acc[0] += w0.x * (bflo(x.x) * bflo(cc.x)); acc[1] += w0.y * (bfhi(x.x) * bfhi(cc.x)); acc[2] += w0.z * (bflo(x.y) * bflo(cc.y)); acc[3] += w0.w * (bfhi(x.y) * bfhi(cc.y));
                acc[4] += w1.x * (bflo(x.z) * bflo(cc.z)); acc[5] += w1.y * (bfhi(x.z) * bfhi(cc.z)); acc[6] += w1.z * (bflo(x.w) * bflo(cc.w)); acc[7] += w1.w * (bfhi(x.w) * bfhi(cc.w));
            }
            const v4u b = ba[i];
            v4u o; o.x = pk2(bflo(b.x) * acc[0], bfhi(b.x) * acc[1]); o.y = pk2(bflo(b.y) * acc[2], bfhi(b.y) * acc[3]);
            o.z = pk2(bflo(b.z) * acc[4], bfhi(b.z) * acc[5]); o.w = pk2(bflo(b.w) * acc[6], bfhi(b.w) * acc[7]);
            *(v4u*)(P + (size_t)row * NCOL + c + C_BA) = o; } }
    }
}
__device__ __forceinline__ void lru_pass1_phase(const Ctx& C, const Args& A, int l) {
    typedef pg8::bf16x8 bx8;
    unsigned char* ws = A.ws; const bf16* P = (const bf16*)(ws + WS_P);
    bf16* LA = (bf16*)A.out + (size_t)M * D; bf16* UU = LA + (size_t)M * 512;
    const int hb = C.wave, lane = C.lane, fr = lane & 15, fq = lane >> 4, c = hb * 64 + lane;
    bx8 wR[2][4], wI[2][4]; float bR[4], bI[4];
    { const float* wrp = A.in[10] + (size_t)l * 32768 + hb * 4096; const float* wip = A.in[12] + (size_t)l * 32768 + hb * 4096;
#pragma unroll
      for (int ks = 0; ks < 2; ++ks)
#pragma unroll
        for (int ct = 0; ct < 4; ++ct) { const int k0 = 32 * ks + 8 * fq, col = 16 * ct + fr; v4u a, b2;
            a.x = pk2(wrp[(k0 + 0) * 64 + col], wrp[(k0 + 1) * 64 + col]); a.y = pk2(wrp[(k0 + 2) * 64 + col], wrp[(k0 + 3) * 64 + col]);
            a.z = pk2(wrp[(k0 + 4) * 64 + col], wrp[(k0 + 5) * 64 + col]); a.w = pk2(wrp[(k0 + 6) * 64 + col], wrp[(k0 + 7) * 64 + col]);
            b2.x = pk2(wip[(k0 + 0) * 64 + col], wip[(k0 + 1) * 64 + col]); b2.y = pk2(wip[(k0 + 2) * 64 + col], wip[(k0 + 3) * 64 + col]);
            b2.z = pk2(wip[(k0 + 4) * 64 + col], wip[(k0 + 5) * 64 + col]); b2.w = pk2(wip[(k0 + 6) * 64 + col], wip[(k0 + 7) * 64 + col]);
            wR[ks][ct] = __builtin_bit_cast(bx8, a); wI[ks][ct] = __builtin_bit_cast(bx8, b2); }
#pragma unroll
      for (int ct = 0; ct < 4; ++ct) { bR[ct] = A.in[11][l * 512 + hb * 64 + 16 * ct + fr]; bI[ct] = A.in[13][l * 512 + hb * 64 + 16 * ct + fr]; } }
    const float lam = A.in[14][l * 512 + c];
    const float sp = log1pf(expf(-lam));
    const float* cw = A.in[8] + l * 4 * 512 + c; const float w0 = cw[0], w1 = cw[512], w2 = cw[1024], w3 = cw[1536], bc = A.in[9][l * 512 + c];
    LAS unsigned char* wl = C.lds + hb * 13312;
    LAS unsigned short* Xs = (LAS unsigned short*)wl; LAS unsigned* Gs = (LAS unsigned*)(wl + 4608);
    for (int item = C.bid; item < BATCH * NCH; item += C.G) {
        const int b = item >> 6, ci = item & 63;
        const size_t row0 = (size_t)b * SEQ + ci * LCH;
        const bf16* xcp = P + row0 * NCOL + C_XC + c;
        float x3 = 0.f, x2 = 0.f, x1 = 0.f;
        if (ci > 0) { x3 = bf2f(*(xcp - 3 * (size_t)NCOL)); x2 = bf2f(*(xcp - 2 * (size_t)NCOL)); x1 = bf2f(*(xcp - (size_t)NCOL)); }
        float Ap = 1.f, h = 0.f;
#pragma unroll 1
        for (int sub = 0; sub < 2; ++sub) {
            { bf16 xin[32];
#pragma unroll
              for (int r = 0; r < 32; ++r) xin[r] = xcp[(size_t)(sub * 32 + r) * NCOL];
#pragma unroll
              for (int r = 0; r < 32; ++r) { const float x0 = bf2f(xin[r]); const float xv = w0 * x3 + w1 * x2 + w2 * x1 + w3 * x0 + bc; x3 = x2; x2 = x1; x1 = x0; Xs[r * 72 + lane] = f2bf(xv); } }
            LDS_WAIT();
            pg8::f32x4 aR[2][4], aI[2][4];
#pragma unroll
            for (int rt = 0; rt < 2; ++rt)
#pragma unroll
                for (int ct = 0; ct < 4; ++ct) { aR[rt][ct] = (pg8::f32x4){0.f, 0.f, 0.f, 0.f}; aI[rt][ct] = (pg8::f32x4){0.f, 0.f, 0.f, 0.f}; }
#pragma unroll
            for (int rt = 0; rt < 2; ++rt)
#pragma unroll
                for (int ks = 0; ks < 2; ++ks) { const bx8 af = *(const LAS bx8*)(wl + (16 * rt + fr) * 144 + (32 * ks + 8 * fq) * 2);
#pragma unroll
                    for (int ct = 0; ct < 4; ++ct) { aR[rt][ct] = __builtin_amdgcn_mfma_f32_16x16x32_bf16(af, wR[ks][ct], aR[rt][ct], 0, 0, 0); aI[rt][ct] = __builtin_amdgcn_mfma_f32_16x16x32_bf16(af, wI[ks][ct], aI[rt][ct], 0, 0, 0); } }
#pragma unroll
            for (int rt = 0; rt < 2; ++rt)
#pragma unroll
                for (int ct = 0; ct < 4; ++ct)
#pragma unroll
                    for (int jj = 0; jj < 4; ++jj) Gs[(16 * rt + 4 * fq + jj) * 68 + 16 * ct + fr] = pk2(sigmoidf_(aR[rt][ct][jj] + bR[ct]), sigmoidf_(aI[rt][ct][jj] + bI[ct]));
            LDS_WAIT();
#pragma unroll 4
            for (int r = 0; r < 32; ++r) {
                const unsigned g = Gs[r * 68 + lane]; const float xv = bf2f(Xs[r * 72 + lane]);
                const float la = bfround(-8.0f * bflo(g) * sp), a = __expf(la), x2l = 2.0f * la;
                const float em = (x2l > -0.25f) ? -(x2l * (1.f + x2l * (0.5f + x2l * (0.16666667f + x2l * (0.041666668f + x2l * (0.0083333338f + x2l * 0.0013888889f)))))) : (1.0f - __expf(x2l));
                const float u = bfround(sqrtf(em) * (bfhi(g) * xv));
                Ap *= a; h = a * h + u;
                Gs[r * 68 + lane] = pk2(la, u);
            }
            LDS_WAIT();
#pragma unroll
            for (int q = 0; q < 4; ++q) { const int rr = (lane >> 3) + 8 * q, ch = lane & 7;
                const v4u w0 = *(const LAS v4u*)(Gs + rr * 68 + ch * 8), w1 = *(const LAS v4u*)(Gs + rr * 68 + ch * 8 + 4);
                v4u lo, hi;
                lo.x = (w0.x & 0xffffu) | (w0.y << 16); lo.y = (w0.z & 0xffffu) | (w0.w << 16); lo.z = (w1.x & 0xffffu) | (w1.y << 16); lo.w = (w1.z & 0xffffu) | (w1.w << 16);
                hi.x = (w0.x >> 16) | (w0.y & 0xffff0000u); hi.y = (w0.z >> 16) | (w0.w & 0xffff0000u); hi.z = (w1.x >> 16) | (w1.y & 0xffff0000u); hi.w = (w1.z >> 16) | (w1.w & 0xffff0000u);
                const size_t o = (row0 + sub * 32 + rr) * 512 + hb * 64 + ch * 8;
                *(v4u*)(LA + o) = lo; *(v4u*)(UU + o) = hi; }
            LDS_WAIT();
        }
        ((f32x2*)(ws + WS_SUM))[(size_t)(b * NCH + ci) * 512 + c] = (f32x2){Ap, h};
    }
}
__device__ __forceinline__ void lru_pass2_item(const Ctx& C, const Args& A, int item) {
    unsigned char* ws = A.ws; bf16* P = (bf16*)(ws + WS_P);
    const bf16* LA = (const bf16*)A.out + (size_t)M * D; const bf16* UU = LA + (size_t)M * 512;
    const int b = item >> 6, ci = item & 63, w = C.wave, lane = C.lane, c8 = lane * 8;
    LAS f32x4* comp = (LAS f32x4*)C.lds;
    LAS f32x4* loc = comp + 8 * 64 * 4;
    const size_t row0 = (size_t)b * SEQ + ci * LCH + w * 8;
    v4u la4[8], u4[8];
#pragma unroll
    for (int r = 0; r < 8; ++r) { la4[r] = *(const v4u*)(LA + (row0 + r) * 512 + c8); u4[r] = *(const v4u*)(UU + (row0 + r) * 512 + c8); }
    float fa[8], fh[8];
#pragma unroll
    for (int k = 0; k < 8; ++k) { fa[k] = 1.f; fh[k] = 0.f; }
    { const int clo = (ci * w) >> 3, chi = (ci * (w + 1)) >> 3;
      const f32x4* sm = (const f32x4*)(ws + WS_SUM) + ((size_t)(b * NCH) * 512 + c8) / 2;
      for (int cc = clo; cc < chi; ++cc) { const f32x4* s = sm + (size_t)cc * 256;
#pragma unroll
        for (int q = 0; q < 4; ++q) { const f32x4 v = s[q]; fh[2 * q] = v.x * fh[2 * q] + v.y; fa[2 * q] *= v.x; fh[2 * q + 1] = v.z * fh[2 * q + 1] + v.w; fa[2 * q + 1] *= v.z; } } }
#pragma unroll
    for (int q = 0; q < 4; ++q) comp[(w * 64 + lane) * 4 + q] = (f32x4){fa[2 * q], fh[2 * q], fa[2 * q + 1], fh[2 * q + 1]};
    float ta[8], th[8];
#pragma unroll
    for (int k = 0; k < 8; ++k) { ta[k] = 1.f; th[k] = 0.f; }
#pragma unroll
    for (int r = 0; r < 8; ++r) { const v4u lw = la4[r], uw = u4[r];
        const float l8[8] = {bflo(lw.x), bfhi(lw.x), bflo(lw.y), bfhi(lw.y), bflo(lw.z), bfhi(lw.z), bflo(lw.w), bfhi(lw.w)};
        const float u8[8] = {bflo(uw.x), bfhi(uw.x), bflo(uw.y), bfhi(uw.y), bflo(uw.z), bfhi(uw.z), bflo(uw.w), bfhi(uw.w)};
#pragma unroll
        for (int k = 0; k < 8; ++k) { const float a = __expf(l8[k]); ta[k] *= a; th[k] = a * th[k] + u8[k]; } }
#pragma unroll
    for (int q = 0; q < 4; ++q) loc[(w * 64 + lane) * 4 + q] = (f32x4){ta[2 * q], th[2 * q], ta[2 * q + 1], th[2 * q + 1]};
    __syncthreads();
#pragma unroll
    for (int r = 0; r < 8; ++r) asm volatile("" : "+v"(la4[r]), "+v"(u4[r]));
    v4u g4[8];
#pragma unroll
    for (int r = 0; r < 8; ++r) g4[r] = *(const v4u*)(P + (row0 + r) * NCOL + C_GC + c8);
    float h[8];
#pragma unroll
    for (int k = 0; k < 8; ++k) h[k] = 0.f;
#pragma unroll
    for (int ww = 0; ww < 8; ++ww)
#pragma unroll
        for (int q = 0; q < 4; ++q) { const f32x4 v = comp[(ww * 64 + lane) * 4 + q]; h[2 * q] = v.x * h[2 * q] + v.y; h[2 * q + 1] = v.z * h[2 * q + 1] + v.w; }
    for (int ww = 0; ww < w; ++ww)
#pragma unroll
        for (int q = 0; q < 4; ++q) { const f32x4 v = loc[(ww * 64 + lane) * 4 + q]; h[2 * q] = v.x * h[2 * q] + v.y; h[2 * q + 1] = v.z * h[2 * q + 1] + v.w; }
#pragma unroll
    for (int r = 0; r < 8; ++r) { const v4u lw = la4[r], uw = u4[r], gw = g4[r];
        const float l8[8] = {bflo(lw.x), bfhi(lw.x), bflo(lw.y), bfhi(lw.y), bflo(lw.z), bfhi(lw.z), bflo(lw.w), bfhi(lw.w)};
        const float u8[8] = {bflo(uw.x), bfhi(uw.x), bflo(uw.y), bfhi(uw.y), bflo(uw.z), bfhi(uw.z), bflo(uw.w), bfhi(uw.w)};
        const float g8[8] = {bflo(gw.x), bfhi(gw.x), bflo(gw.y), bfhi(gw.y), bflo(gw.z), bfhi(gw.z), bflo(gw.w), bfhi(gw.w)};
        float y[8];
#pragma unroll
        for (int k = 0; k < 8; ++k) { h[k] = __expf(l8[k]) * h[k] + u8[k]; const float x = g8[k]; y[k] = x * rcp_(1.0f + __expf(-1.5957691216f * (x + 0.044715f * x * x * x))) * h[k]; }
        v4u o; o.x = pk2(y[0], y[1]); o.y = pk2(y[2], y[3]); o.z = pk2(y[4], y[5]); o.w = pk2(y[6], y[7]);
        *(v4u*)(P + (row0 + r) * NCOL + C_GC + c8) = o; }
    __syncthreads();
}

struct PlainSched {
    pg8::TileOrder T; const char* A; const char* B; size_t tA, tB;
    __device__ __forceinline__ bool next(int i, pg8::Unit& u) const { int pm, pn; if (!T.map((long)i * T.G + T.c, pm, pn)) return false;
        u.pm = pm; u.pn = pn; u.a = A + (size_t)pm * tA; u.b = B + (size_t)pn * tB; u.x = 0; return true; }
    __device__ __forceinline__ void a_ready(const pg8::Unit&) const {}
    __device__ __forceinline__ void done(const pg8::Unit&) const {}
};
struct MergeSched {
    pg8::TileOrder T; const char* P; const char* W;
    __device__ __forceinline__ bool next(int i, pg8::Unit& u) const { const int ti = i / 3, br = i - 3 * ti; int pm, pn; if (!T.map((long)ti * T.G + T.c, pm, pn)) return false;
        const int colA = br == 0 ? C_BA : (br == 1 ? C_Q : C_GC);
        u.pm = pm; u.pn = pn; u.a = P + ((size_t)pm * 256 * NCOL + colA) * 2; u.b = W + ((size_t)br * 1024 * 512 + (size_t)pn * 256 * 512) * 2; u.x = br; return true; }
    __device__ __forceinline__ void a_ready(const pg8::Unit&) const {}
    __device__ __forceinline__ void done(const pg8::Unit&) const {}
};
struct MoeTiles {
    int nt[8]; int ntiles;
    __device__ __forceinline__ void init(const unsigned* cnt) { ntiles = 0;
#pragma unroll
        for (int e = 0; e < 8; ++e) { nt[e] = (int)((cnt[e] + 255u) >> 8); ntiles += nt[e]; } }
    __device__ __forceinline__ void locate(int pm, int& e, int& base) const { e = 0; base = 0; int cum = 0;
#pragma unroll
        for (int k = 0; k < 7; ++k) { cum += nt[k]; if (pm >= cum) { e = k + 1; base = cum; } } }
};
struct MoeSched {
    pg8::TileOrder T; MoeTiles mt; const char* A; size_t tA; const char* W; size_t eStride, tB; int skipE, skipR;
    __device__ __forceinline__ bool next(int i, pg8::Unit& u) const { int pm, pn;
        const int ge = T.G - skipE;
        const long L = (T.c < skipE) ? (long)skipR * ge + (long)i * T.G + T.c : (i < skipR ? (long)i * ge + (T.c - skipE) : (long)skipR * ge + (long)(i - skipR) * T.G + T.c);
        if (!T.map(L, pm, pn)) return false;
        int e, base; mt.locate(pm, e, base);
        u.pm = pm; u.pn = pn; u.a = A + (size_t)pm * tA; u.b = W + (size_t)e * eStride + (size_t)pn * tB; u.x = e; return true; }
    __device__ __forceinline__ void a_ready(const pg8::Unit&) const {}
    __device__ __forceinline__ void done(const pg8::Unit&) const {}
};

struct EpiMerge {
    static constexpr bool PERM = true, AFTER_DRAIN = false, CHAIN = true;
    bf16* MG; const bf16* P;
    __device__ __forceinline__ void operator()(const pg8::f32x4 (&)[2][2][4][2], const pg8::Unit&, int, int, int, int) const {}
    __device__ __forceinline__ bool chain(pg8::f32x4 (&acc)[2][2][4][2], const pg8::Unit& u, int wr, int wc, int fr, int fq) const {
        const int br = u.x, row0 = u.pm * 256 + wr * 64 + fr, col0 = u.pn * 256 + wc * 32 + 8 * fq;
#pragma unroll
        for (int ai = 0; ai < 2; ++ai) {
            v4u gn[4][2], gd[4][2];
#pragma unroll
            for (int m = 0; m < 4; ++m)
#pragma unroll
                for (int bj = 0; bj < 2; ++bj) { const size_t row = (size_t)(row0 + ai * 128 + m * 16); const int col = col0 + bj * 128;
                    gn[m][bj] = *(const v4u*)(P + row * NCOL + C_G + br * 1024 + col);
                    gd[m][bj] = (br < 2) ? *(const v4u*)(P + row * NCOL + C_G + (br + 1) * 1024 + col) : (v4u){0u, 0u, 0u, 0u}; }
#pragma unroll
            for (int m = 0; m < 4; ++m)
#pragma unroll
                for (int bj = 0; bj < 2; ++bj) { const size_t row = (size_t)(row0 + ai * 128 + m * 16); const int col = col0 + bj * 128;
                    const v4u a = gn[m][bj], d = gd[m][bj];
                    const float an[8] = {bflo(a.x), bfhi(a.x), bflo(a.y), bfhi(a.y), bflo(a.z), bfhi(a.z), bflo(a.w), bfhi(a.w)};
                    const float dn[8] = {bflo(d.x), bfhi(d.x), bflo(d.y), bfhi(d.y), bflo(d.z), bfhi(d.z), bflo(d.w), bfhi(d.w)};
                    float f[8];
#pragma unroll
                    for (int k = 0; k < 8; ++k) f[k] = (br < 2) ? an[k] * rcp_(fmaxf(dn[k], 1e-30f)) : an[k];
                    pg8::f32x4& v0 = acc[ai][bj][m][0]; pg8::f32x4& v1 = acc[ai][bj][m][1];
                    v0[0] *= f[0]; v0[1] *= f[1]; v0[2] *= f[2]; v0[3] *= f[3]; v1[0] *= f[4]; v1[1] *= f[5]; v1[2] *= f[6]; v1[3] *= f[7];
                    if (br == 2) { v4u w; w.x = pk2(v0[0], v0[1]); w.y = pk2(v0[2], v0[3]); w.z = pk2(v1[0], v1[1]); w.w = pk2(v1[2], v1[3]); *(v4u*)(MG + row * D + col) = w; } }
            asm volatile("" ::: "memory");
        }
        return br < 2;
    }
};
template <bool BASE_F32>
struct EpiRes {
    static constexpr bool PERM = true, AFTER_DRAIN = false, CHAIN = false;
    const void* base; bf16* out;
    __device__ __forceinline__ void operator()(const pg8::f32x4 (&acc)[2][2][4][2], const pg8::Unit& u, int wr, int wc, int fr, int fq) const {
        const int row0 = u.pm * 256 + wr * 64 + fr, col0 = u.pn * 256 + wc * 32 + 8 * fq;
#pragma unroll
        for (int ai = 0; ai < 2; ++ai) {
            f32x4 b0[4][2], b1[4][2];
#pragma unroll
            for (int m = 0; m < 4; ++m)
#pragma unroll
                for (int bj = 0; bj < 2; ++bj) { const size_t off = (size_t)(row0 + ai * 128 + m * 16) * D + col0 + bj * 128;
                    if (BASE_F32) { b0[m][bj] = *(const f32x4*)((const float*)base + off); b1[m][bj] = *(const f32x4*)((const float*)base + off + 4); }
                    else { const v4u w = *(const v4u*)((const bf16*)base + off); b0[m][bj] = (f32x4){bflo(w.x), bfhi(w.x), bflo(w.y), bfhi(w.y)}; b1[m][bj] = (f32x4){bflo(w.z), bfhi(w.z), bflo(w.w), bfhi(w.w)}; } }
#pragma unroll
            for (int m = 0; m < 4; ++m)
#pragma unroll
                for (int bj = 0; bj < 2; ++bj) { const size_t off = (size_t)(row0 + ai * 128 + m * 16) * D + col0 + bj * 128;
                    const f32x4 r0 = b0[m][bj] + acc[ai][bj][m][0], r1 = b1[m][bj] + acc[ai][bj][m][1];
                    v4u w; w.x = pk2(r0[0], r0[1]); w.y = pk2(r0[2], r0[3]); w.z = pk2(r1[0], r1[1]); w.w = pk2(r1[2], r1[3]);
                    *(v4u*)(out + off) = w; }
            asm volatile("" ::: "memory");
        }
    }
};
struct EpiSwiGLU {
    static constexpr bool PERM = true, AFTER_DRAIN = false, CHAIN = false;
    bf16* H; int ldc;
    __device__ __forceinline__ void operator()(const pg8::f32x4 (&acc)[2][2][4][2], const pg8::Unit& u, int wr, int wc, int fr, int fq) const {
        const int row0 = u.pm * 256 + wr * 64 + fr, col0 = u.pn * 128 + wc * 32 + 8 * fq;
#pragma unroll
        for (int ai = 0; ai < 2; ++ai)
#pragma unroll
            for (int m = 0; m < 4; ++m) { const f32x4 g0 = acc[ai][0][m][0], g1 = acc[ai][0][m][1], u0 = acc[ai][1][m][0], u1 = acc[ai][1][m][1];
                v4u w; w.x = pk2(g0[0] * sigmoidf_(g0[0]) * u0[0], g0[1] * sigmoidf_(g0[1]) * u0[1]); w.y = pk2(g0[2] * sigmoidf_(g0[2]) * u0[2], g0[3] * sigmoidf_(g0[3]) * u0[3]);
                w.z = pk2(g1[0] * sigmoidf_(g1[0]) * u1[0], g1[1] * sigmoidf_(g1[1]) * u1[1]); w.w = pk2(g1[2] * sigmoidf_(g1[2]) * u1[2], g1[3] * sigmoidf_(g1[3]) * u1[3]);
                *(v4u*)(H + (size_t)(row0 + ai * 128 + m * 16) * ldc + col0) = w; }
    }
};
struct EpiSwiGLU8 {
    static constexpr bool PERM = true, AFTER_DRAIN = false, CHAIN = false;
    unsigned char* H; int ldc;
    __device__ __forceinline__ void operator()(const pg8::f32x4 (&acc)[2][2][4][2], const pg8::Unit& u, int wr, int wc, int fr, int fq) const {
        const int row0 = u.pm * 256 + wr * 64 + fr, colw = u.pn * 128 + wc * 32; constexpr float ds = 1.0f / (SC_X8 * SC_W8);
        const bool odd = (fq & 1) != 0;
        unsigned char* p = H + (size_t)(row0 + (odd ? 16 : 0)) * ldc + colw + 8 * (fq & ~1);
#pragma unroll
        for (int ai = 0; ai < 2; ++ai)
#pragma unroll
            for (int mp = 0; mp < 2; ++mp) {
                v2u x[2];
#pragma unroll
                for (int h = 0; h < 2; ++h) { const int m = 2 * mp + h;
                    const f32x4 g0 = acc[ai][0][m][0] * ds, g1 = acc[ai][0][m][1] * ds, u0 = acc[ai][1][m][0] * (ds * SC_H8), u1 = acc[ai][1][m][1] * (ds * SC_H8);
                    x[h].x = pk4_fp8(g0[0] * sigmoidf_(g0[0]) * u0[0], g0[1] * sigmoidf_(g0[1]) * u0[1], g0[2] * sigmoidf_(g0[2]) * u0[2], g0[3] * sigmoidf_(g0[3]) * u0[3]);
                    x[h].y = pk4_fp8(g1[0] * sigmoidf_(g1[0]) * u1[0], g1[1] * sigmoidf_(g1[1]) * u1[1], g1[2] * sigmoidf_(g1[2]) * u1[2], g1[3] * sigmoidf_(g1[3]) * u1[3]); }
                const auto sx = __builtin_amdgcn_permlane16_swap(x[0].x, x[1].x, false, false), sy = __builtin_amdgcn_permlane16_swap(x[0].y, x[1].y, false, false);
                v4u w; w.x = sx[0]; w.y = sy[0]; w.z = sx[1]; w.w = sy[1];
                *(v4u*)(p + (size_t)(ai * 128 + mp * 32) * ldc) = w; }
    }
};
template <bool OUT_F32>
struct EpiScatter {
    static constexpr bool PERM = true, AFTER_DRAIN = false, CHAIN = false;
    const int* rowtok; const float* roww; const bf16* XB; void* out; float ds;
    __device__ __forceinline__ void operator()(const pg8::f32x4 (&acc)[2][2][4][2], const pg8::Unit& u, int wr, int wc, int fr, int fq) const {
        const int row0 = u.pm * 256 + wr * 64 + fr, col0 = u.pn * 256 + wc * 32 + 8 * fq;
#pragma unroll
        for (int ai = 0; ai < 2; ++ai) {
            int tok[4]; float w[4]; v4u bw[4][2];
#pragma unroll
            for (int m = 0; m < 4; ++m) { const int gr = row0 + ai * 128 + m * 16; tok[m] = rowtok[gr]; w[m] = roww[gr] * ds; }
#pragma unroll
            for (int m = 0; m < 4; ++m)
#pragma unroll
                for (int bj = 0; bj < 2; ++bj) bw[m][bj] = (tok[m] >= 0) ? *(const v4u*)(XB + (size_t)tok[m] * D + col0 + bj * 128) : (v4u){0u, 0u, 0u, 0u};
#pragma unroll
            for (int m = 0; m < 4; ++m) if (tok[m] >= 0) {
#pragma unroll
                for (int bj = 0; bj < 2; ++bj) { const size_t off = (size_t)tok[m] * D + col0 + bj * 128; const v4u b = bw[m][bj];
                    const f32x4 r0 = (f32x4){bflo(b.x), bfhi(b.x), bflo(b.y), bfhi(b.y)} + acc[ai][bj][m][0] * w[m], r1 = (f32x4){bflo(b.z), bfhi(b.z), bflo(b.w), bfhi(b.w)} + acc[ai][bj][m][1] * w[m];
                    if (OUT_F32) { *(f32x4*)((float*)out + off) = r0; *(f32x4*)((float*)out + off + 4) = r1; }
                    else { v4u o; o.x = pk2(r0[0], r0[1]); o.y = pk2(r0[2], r0[3]); o.z = pk2(r1[0], r1[1]); o.w = pk2(r1[2], r1[3]); *(v4u*)((bf16*)out + off) = o; } } }
            asm volatile("" ::: "memory");
        }
    }
};
__device__ __forceinline__ void moe_gather(const Ctx& C, unsigned char* ws, const bf16* XN, int list) {
    const unsigned* cnt = (const unsigned*)(ws + WS_CTL) + CW_CNT + list * 8;
    MoeTiles mt; mt.init(cnt);
    const int* tokl = (const int*)(ws + WS_TOK) + (size_t)list * 8 * M; const float* wl = (const float*)(ws + WS_WL) + (size_t)list * 8 * M;
    int* rowtok = (int*)(ws + WS_ROWTOK + list * ROWTAB_LIST); float* roww = (float*)(ws + WS_ROWW + list * ROWTAB_LIST);
    unsigned char* XG = ws + WS_XG + list * XG_LIST; const unsigned char* XN8 = (const unsigned char*)XN;
    const int gw = C.bid * NWAVES + C.wave, NGW = C.G * NWAVES, nrows = mt.ntiles * 256;
    for (int g0 = gw; g0 < nrows; g0 += 4 * NGW) {
        int tok[4]; float w[4]; v4u a[4];
#pragma unroll
        for (int i = 0; i < 4; ++i) { const int gr = g0 + i * NGW; tok[i] = -1; w[i] = 0.f;
            if (gr < nrows) { int e, base; mt.locate(gr >> 8, e, base); const int local = ((gr >> 8) - base) * 256 + (gr & 255);
                if (local < (int)cnt[e]) { tok[i] = tokl[(size_t)e * M + local]; w[i] = wl[(size_t)e * M + local]; } } }
#pragma unroll
        for (int i = 0; i < 4; ++i) { a[i] = (v4u){0u, 0u, 0u, 0u};
            if (tok[i] >= 0) a[i] = ((const v4u*)(XN8 + (size_t)tok[i] * D))[C.lane]; }
#pragma unroll
        for (int i = 0; i < 4; ++i) { const int gr = g0 + i * NGW;
            if (gr < nrows) { if (C.lane == 0) { rowtok[gr] = tok[i]; roww[gr] = w[i]; }
                ((v4u*)(XG + (size_t)gr * D))[C.lane] = a[i]; } }
    }
}

__global__ void __launch_bounds__(NTHR, 2) fwd(Args args) {
    extern __shared__ __attribute__((aligned(16))) unsigned char lds_raw[];
    Ctx C; C.lds = (LAS unsigned char*)lds_raw; C.tid = threadIdx.x; C.lane = C.tid & 63; C.wave = __builtin_amdgcn_readfirstlane(C.tid >> 6); C.bid = blockIdx.x; C.G = gridDim.x;
    unsigned char* ws = args.ws;
    volatile LAS unsigned* MISC = (volatile LAS unsigned*)(C.lds + MISC_OFF);
    for (int u = C.tid; u < (LDS_BYTES - RING_BYTES) / 4; u += NTHR) ((LAS unsigned*)(C.lds + RING_BYTES))[u] = 0u;
    __syncthreads();
    const int lo = args.ph_lo, hi = args.ph_hi;
    const int wave_s = C.wave;
    XcdBarrier bar; bar.bar = (unsigned*)(ws + WS_CTL) + CW_BAR; bar.x = 0; bar.st = nullptr;
    if (MK_ONE_LAUNCH || hi - lo > 1) bar = xcd_barrier_post((unsigned*)(ws + WS_CTL) + CW_BAR, MISC + 8, C.tid == 0);
#if MK_ONE_LAUNCH
#define IN(k) true
#else
#define IN(k) (lo <= (k) && (k) < hi)
#endif
#define FRESH() do { unsigned z_ = 0u; asm volatile("" : "+v"(z_)); int t_ = wave_s * 64 + (int)__builtin_amdgcn_mbcnt_hi(~0u, __builtin_amdgcn_mbcnt_lo(~0u, z_)); asm volatile("" : "+v"(t_)); C.tid = t_; C.lane = t_ & 63; C.wave = wave_s; } while (0)
#if MK_ONE_LAUNCH
#define SEAM(k) xcd_barrier(bar, C.tid == 0)
#else
#define SEAM(k) do { if (IN(k) && IN((k) + 1)) xcd_barrier(bar, C.tid == 0); } while (0)
#endif
    bf16* XN = (bf16*)args.out; bf16* P = (bf16*)(ws + WS_P); bf16* XB = (bf16*)(ws + WS_XB);
    unsigned char* XN8 = (unsigned char*)args.out + (size_t)64 * MiB;

    if (IN(0)) { FRESH(); convert_layer_weights(C, args, 0); rope_table(C, ws); norm_rows<false, true>(C, args.in[0], args.in[1], XN, nullptr, ws, XN8); SEAM(0); }

#pragma unroll
    for (int l = 0; l < 2; ++l) {
        const int pb = 1 + 9 * l;
        if (IN(pb + 0)) { FRESH();
            {
                PlainSched S; S.T.init(M / 256, C_G / 256, C.G, C.bid); S.A = (const char*)XN; S.B = (const char*)(ws + WS_WIN); S.tA = (size_t)256 * D * 2; S.tB = (size_t)256 * D * 2;
                pg8::EpiBf16 E{P, NCOL, 1 << 30, 1.0f};
                pg8::gemm_phase<pg8::EpiBf16, PlainSched, true, true>(C.tid, C.lds, pg8::Gemm{D, D, D}, S, E); }
            FRESH();
            {
                PlainSched S; S.T.init(M / 256, (NCOL - C_G) / 256, C.G, C.bid); S.A = (const char*)XN8; S.B = (const char*)(ws + WS_WIN + (size_t)8 * MiB); S.tA = (size_t)256 * D; S.tB = (size_t)256 * D;
                pg8::EpiBf16 E{P + C_G, NCOL, 0, 1.0f / (SC_X8 * SC_W8)};
                pg8::gemm_phase<pg8::EpiBf16, PlainSched, true, true, true>(C.tid, C.lds, pg8::Gemm{D, D, D}, S, E); }
            SEAM(pb + 0);
        }
        if (IN(pb + 1)) { FRESH();
            lru_pass1_phase(C, args, l);
            __syncthreads(); FRESH();
            for (int it = C.bid; it < (M / 256) * NH; it += C.G) qk_item(C, args, l, it);
            FRESH();
            conva_tasks(C, args, l);
            SEAM(pb + 1);
        }
        if (IN(pb + 2)) { FRESH();
            {
                static_assert(moba::LDS_BYTES <= RING_BYTES, "attention scratch fits the ring region");
                const int v0 = (C.G % 8 == 0) ? (C.bid % 8) * (C.G / 8) + C.bid / 8 : C.bid;
                for (int v = v0; v < BATCH * NH * 4; v += C.G) { const int s = v & 3, bh = v >> 2;
#pragma unroll 1
                    for (int i = 0; i < 4; ++i) { const int qb = (i == 0) ? s : (i == 1) ? 7 - s : (i == 2) ? 8 + s : 15 - s;
                        moba::moba_unit(C.tid, bh >> 3, bh & 7, qb, (moba::bf16raw*)P, (const float*)(ws + WS_KMEAN), (char*)lds_raw); } }
            }
            FRESH();
            for (int it = C.bid; it < BATCH * NCH; it += C.G) lru_pass2_item(C, args, it);
            SEAM(pb + 2);
        }
        if (IN(pb + 3)) { FRESH();
            MergeSched S; S.T.init(M / 256, D / 256, C.G, C.bid); S.P = (const char*)P; S.W = (const char*)(ws + WS_WOABC);
            EpiMerge E{XN, P};
            pg8::gemm_phase<EpiMerge, MergeSched, true, true>(C.tid, C.lds, pg8::Gemm{512, NCOL, 512}, S, E);
            SEAM(pb + 3);
        }
        if (IN(pb + 4)) { FRESH();
            PlainSched S; S.T.init(M / 256, D / 256, C.G, C.bid); S.A = (const char*)XN; S.B = (const char*)(ws + WS_WO); S.tA = (size_t)256 * D * 2; S.tB = (size_t)256 * D * 2;
            if (l == 0) { EpiRes<true> E{args.in[0], XB}; pg8::gemm_phase<EpiRes<true>, PlainSched, true, true>(C.tid, C.lds, pg8::Gemm{D, D, D}, S, E); }
            else { EpiRes<false> E{XB, XB}; pg8::gemm_phase<EpiRes<false>, PlainSched, true, true>(C.tid, C.lds, pg8::Gemm{D, D, D}, S, E); }
            SEAM(pb + 4);
        }
        if (l == 0) {
            if (IN(pb + 5)) { FRESH(); norm_rows_b<false>(C, XB, args.in[17], XN, nullptr, ws); SEAM(pb + 5); }
            if (IN(pb + 6)) { FRESH();
                PlainSched S; S.T.init(M / 256, 2 * DFF / 256, C.G, C.bid); S.A = (const char*)XN; S.B = (const char*)(ws + WS_FGU); S.tA = (size_t)256 * D * 2; S.tB = (size_t)256 * D * 2;
                EpiSwiGLU E{(bf16*)(ws + WS_HID0), DFF};
                pg8::gemm_phase<EpiSwiGLU, PlainSched, true, true>(C.tid, C.lds, pg8::Gemm{D, D, D}, S, E);
                SEAM(pb + 6);
            }
            if (IN(pb + 7)) { FRESH();
                PlainSched S; S.T.init(M / 256, D / 256, C.G, C.bid); S.A = (const char*)(ws + WS_HID0); S.B = (const char*)(ws + WS_FDN); S.tA = (size_t)256 * DFF * 2; S.tB = (size_t)256 * DFF * 2;
                EpiRes<false> E{XB, XB};
                pg8::gemm_phase<EpiRes<false>, PlainSched, true, true>(C.tid, C.lds, pg8::Gemm{DFF, DFF, DFF}, S, E);
                SEAM(pb + 7);
            }
            if (IN(pb + 8)) { FRESH(); convert_layer_weights(C, args, 1); norm_rows_b<false, true>(C, XB, args.in[1] + D, XN, nullptr, ws, XN8); SEAM(pb + 8); }
        } else {
            if (IN(15)) { FRESH(); norm_rows_b<true>(C, XB, args.in[17] + D, XN, args.in[21], ws); convert_moe_weights(C, args); SEAM(15); }
            if (IN(16)) { FRESH(); moe_gather(C, ws, XN, 0); FRESH(); moe_gather(C, ws, XN, 1); SEAM(16); }
            const unsigned* cnt0 = (const unsigned*)(ws + WS_CTL) + CW_CNT; const unsigned* cnt1 = cnt0 + 8;
            constexpr float dsc = 1.0f / (SC_H8 * SC_W8);
            if (IN(17)) { FRESH();
                MoeSched S; S.mt.init(cnt0); S.T.init(S.mt.ntiles, 2 * EFF / 256, C.G, C.bid); S.skipE = 0; S.skipR = 0;
                S.A = (const char*)(ws + WS_XG); S.tA = (size_t)256 * D; S.W = (const char*)(ws + WS_MGU); S.eStride = (size_t)7168 * D; S.tB = (size_t)256 * D;
                EpiSwiGLU8 E{ws + WS_MH, EFF};
                pg8::gemm_phase<EpiSwiGLU8, MoeSched, true, true, true>(C.tid, C.lds, pg8::Gemm{D, D, D}, S, E);
                SEAM(17);
            }
            if (IN(18)) { FRESH();
                int extra;
                {   MoeSched S; S.mt.init(cnt0); S.T.init(S.mt.ntiles, D / 256, C.G, C.bid); S.skipE = 0; S.skipR = 0; extra = (S.mt.ntiles * (D / 256)) % C.G;
                    S.A = (const char*)(ws + WS_MH); S.tA = (size_t)256 * EFF; S.W = (const char*)(ws + WS_MDN); S.eStride = (size_t)D * EFF; S.tB = (size_t)256 * EFF;
                    EpiScatter<false> E{(const int*)(ws + WS_ROWTOK), (const float*)(ws + WS_ROWW), XB, XB, dsc};
                    pg8::gemm_phase<EpiScatter<false>, MoeSched, true, true, true>(C.tid, C.lds, pg8::Gemm{EFF, EFF, EFF}, S, E); }
                __syncthreads(); FRESH();
                {   MoeSched S; S.mt.init(cnt1); S.T.init(S.mt.ntiles, 2 * EFF / 256, C.G, C.bid); S.skipE = extra; S.skipR = MOE_DOWN_COST;
                    S.A = (const char*)(ws + WS_XG + XG_LIST); S.tA = (size_t)256 * D; S.W = (const char*)(ws + WS_MGU); S.eStride = (size_t)7168 * D; S.tB = (size_t)256 * D;
                    EpiSwiGLU8 E{ws + WS_MH + MH_LIST, EFF};
                    pg8::gemm_phase<EpiSwiGLU8, MoeSched, true, true, true>(C.tid, C.lds, pg8::Gemm{D, D, D}, S, E); }
                SEAM(18);
            }
            if (IN(19)) { FRESH();
                MoeSched S; S.mt.init(cnt1); S.T.init(S.mt.ntiles, D / 256, C.G, C.bid); S.skipE = 0; S.skipR = 0;
                S.A = (const char*)(ws + WS_MH + MH_LIST); S.tA = (size_t)256 * EFF; S.W = (const char*)(ws + WS_MDN); S.eStride = (size_t)D * EFF; S.tB = (size_t)256 * EFF;
                EpiScatter<true> E{(const int*)(ws + WS_ROWTOK + ROWTAB_LIST), (const float*)(ws + WS_ROWW + ROWTAB_LIST), XB, args.out, dsc};
                pg8::gemm_phase<EpiScatter<true>, MoeSched, true, true, true>(C.tid, C.lds, pg8::Gemm{EFF, EFF, EFF}, S, E);
            }
        }
    }
#undef IN
#undef SEAM
}

extern "C" void kernel_launch(void* const* d_in, const int* in_sizes, int n_in, void* d_out, int out_size, void* d_ws, size_t ws_size, hipStream_t stream) {
    static int grid = 0;
    if (grid == 0) {
        if (n_in != 25 || in_sizes[0] != M * D || out_size != M * D || ws_size < WS_END) { fprintf(stderr, "kernel_launch: unexpected shapes (n_in %d, in0 %d, out %d, ws %zu); nothing launched\n", n_in, n_in > 0 ? in_sizes[0] : -1, out_size, ws_size); grid = -1; return; }
        int dev = 0, cus = 0, per_cu = 0;
        if (hipGetDevice(&dev) != hipSuccess || hipDeviceGetAttribute(&cus, hipDeviceAttributeMultiprocessorCount, dev) != hipSuccess) { grid = -1; return; }
        if (hipFuncSetAttribute((const void*)fwd, hipFuncAttributeMaxDynamicSharedMemorySize, LDS_BYTES) != hipSuccess) { fprintf(stderr, "kernel_launch: hipFuncSetAttribute failed\n"); grid = -1; return; }
        if (hipOccupancyMaxActiveBlocksPerMultiprocessor(&per_cu, (const void*)fwd, NTHR, LDS_BYTES) != hipSuccess || per_cu < 1) { fprintf(stderr, "kernel_launch: occupancy query reports %d workgroups per CU\n", per_cu); }
        (void)hipGetLastError();
        grid = cus;
    }
    if (grid < 0) return;
    if (hipMemsetAsync((char*)d_ws + WS_CTL, 0, CTL_ZERO_BYTES, stream) != hipSuccess) return;
    Args a{};
    for (int i = 0; i < 25; ++i) a.in[i] = (const float*)d_in[i];
    a.out = (float*)d_out; a.ws = (unsigned char*)d_ws;
#if MK_ONE_LAUNCH
    a.ph_lo = 0; a.ph_hi = N_PHASES;
    hipLaunchKernelGGL(fwd, dim3(grid), dim3(NTHR), LDS_BYTES, stream, a);
#else
    for (int p = 0; p < N_PHASES; ++p) { a.ph_lo = p; a.ph_hi = p + 1; hipLaunchKernelGGL(fwd, dim3(grid), dim3(NTHR), LDS_BYTES, stream, a); }
#endif
}
```

```cpp
#include <hip/hip_runtime.h>
#include <cstdio>
#include <cstdint>

namespace pg8 {
#define PG8_LAS __attribute__((address_space(3)))
typedef unsigned short bf16_t;
typedef short bf16x8 __attribute__((ext_vector_type(8)));
typedef float f32x4 __attribute__((ext_vector_type(4)));
typedef unsigned u32x4 __attribute__((ext_vector_type(4)));
constexpr int BM = 256, BK = 64, HALF = 128, HTB = HALF * BK * 2  , STAGE_BYTES = 8 * HTB, NXCD = 8, WGM = 8;

__host__ __device__ __forceinline__ int lds_byte(int r, int c) { const int st = (r >> 4) * 2 + (c >> 5), rr = r & 15, cc = c & 31, ob = rr * 64 + cc * 2; return st * 1024 + (ob ^ (((ob >> 9) & 1) << 5)); }
__host__ __device__ __forceinline__ void stage_rc(int b, int& R, int& C) { const int st = b / 1024, sb = b % 1024, swz = sb ^ (((sb >> 9) & 1) << 5); R = (st >> 1) * 16 + swz / 64; C = (st & 1) * 32 + (swz % 64) / 2; }
__host__ __device__ __forceinline__ int perm32(int rho) { const int n = rho >> 4, i = rho & 15; return 8 * (i >> 2) + 4 * n + (i & 3); }

struct Unit { int pm, pn; const char* a; const char* b; int x; };
struct Gemm { int K, lda, ldb; };

struct TileOrder {
    int nM, nN, nwg, G, c;
    __device__ __forceinline__ void init(int nM_, int nN_, int G_, int c_) { nM = nM_; nN = nN_; nwg = nM * nN; G = G_; c = c_; }
    __device__ __forceinline__ bool map(long L, int& pm, int& pn) const {
        if (L >= nwg) return false;
        int wgid = (int)L; { const int q = nwg / NXCD, r = nwg % NXCD, xcd = wgid % NXCD, off = wgid / NXCD; wgid = (xcd < r ? xcd * (q + 1) : r * (q + 1) + (xcd - r) * q) + off; }
        const int nig = WGM * nN, gid = wgid / nig, fm = gid * WGM, gsz = (nM - fm) < WGM ? (nM - fm) : WGM;
        pm = fm + ((wgid % nig) % gsz); pn = (wgid % nig) / gsz; return true;
    }
};

typedef float f32x2_cv __attribute__((ext_vector_type(2))); typedef __bf16 bf16x2_cv __attribute__((ext_vector_type(2)));
__device__ __forceinline__ unsigned cvt_pk_bf16(float lo, float hi) { const f32x2_cv v = {lo, hi}; const bf16x2_cv b = __builtin_convertvector(v, bf16x2_cv); return __builtin_bit_cast(unsigned, b); }

struct EpiBf16 {
    static constexpr bool PERM = true, AFTER_DRAIN = false, CHAIN = false;
    bf16_t* O; int ldc; int sig_from; float ds;
    __device__ __forceinline__ void operator()(const f32x4 (&acc)[2][2][4][2], const Unit& u, int wr, int wc, int fr, int fq) const {
        const int row0 = u.pm * BM + wr * 64 + fr; const int col0 = u.pn * BM + wc * 32 + 8 * fq;
#pragma unroll
        for (int ai = 0; ai < 2; ++ai)
#pragma unroll
            for (int m = 0; m < 4; ++m) { bf16_t* rowp = O + (size_t)(row0 + ai * HALF + m * 16) * ldc + col0;
#pragma unroll
                for (int bj = 0; bj < 2; ++bj) { f32x4 v0 = acc[ai][bj][m][0] * ds, v1 = acc[ai][bj][m][1] * ds;
                    if (u.pn >= sig_from) {
#pragma unroll
                        for (int k = 0; k < 4; ++k) { v0[k] = __builtin_amdgcn_rcpf(1.0f + __expf(-v0[k])); v1[k] = __builtin_amdgcn_rcpf(1.0f + __expf(-v1[k])); } }
                    u32x4 w; w.x = cvt_pk_bf16(v0[0], v0[1]); w.y = cvt_pk_bf16(v0[2], v0[3]); w.z = cvt_pk_bf16(v1[0], v1[1]); w.w = cvt_pk_bf16(v1[2], v1[3]);
                    *(u32x4*)(rowp + bj * HALF) = w; } }
    }
};

typedef int pg8_v4i __attribute__((ext_vector_type(4))); typedef int pg8_v8i __attribute__((ext_vector_type(8)));
__device__ __forceinline__ pg8_v8i f8cat(bf16x8 lo, bf16x8 hi) { const pg8_v4i a = __builtin_bit_cast(pg8_v4i, lo), b = __builtin_bit_cast(pg8_v4i, hi); return __builtin_shufflevector(a, b, 0, 1, 2, 3, 4, 5, 6, 7); }
template <class Epi, class Sched, bool ALIGN_EPI = false, bool SP2 = false, bool F8 = false>
__device__ __forceinline__ void gemm_phase(int tid_, PG8_LAS unsigned char* lds, const Gemm g, const Sched& S, const Epi& E) {
    const int tid = tid_, wid = __builtin_amdgcn_readfirstlane(tid >> 6), lane = tid & 63, wr = wid >> 2, wc = wid & 3, fr = lane & 15, fq = lane >> 4;
    const int K = g.K, nt = F8 ? K / 128 : K / BK; constexpr int ESZ = F8 ? 1 : 2;
    unsigned voffA[2], voffB[2];
#pragma unroll
    for (int i = 0; i < 2; ++i) { int R, C; stage_rc(tid * 16 + i * 8192, R, C); const int Rb = Epi::PERM ? ((R & ~31) + perm32(R & 31)) : R;
        voffA[i] = (unsigned)(R * g.lda * ESZ + C * 2); voffB[i] = (unsigned)(Rb * g.ldb * ESZ + C * 2); }
    const size_t kstep = (size_t)(BK * 2);
    const size_t hstepA = (size_t)HALF * g.lda * ESZ, hstepB = (size_t)HALF * g.ldb * ESZ;
    const unsigned ldsw = (unsigned)wid * 1024u;
    const int aoff = lds_byte(wr * 64 + fr, fq * 8), boff = lds_byte(wc * 32 + fr, fq * 8);
#define PG8_SA(b, h) (((b) * 2 + (h)) * HTB)
#define PG8_SB(b, h) ((4 + (b) * 2 + (h)) * HTB)
#define PG8_STAGE(bufoff, gbase, voff) do { _Pragma("unroll") for (int _i = 0; _i < 2; ++_i) \
        __builtin_amdgcn_global_load_lds((const unsigned*)((const char*)(gbase) + (voff)[_i]), (PG8_LAS unsigned*)(lds + (bufoff) + ldsw + _i * 8192), 16, 0, 0); } while (0)
#define PG8_LDA(dst, b, h) do { _Pragma("unroll") for (int m = 0; m < 4; ++m) { const bf16x8 lo_ = *(const PG8_LAS bf16x8*)(lds + PG8_SA(b, h) + aoff + m * 2048), hi_ = *(const PG8_LAS bf16x8*)(lds + PG8_SA(b, h) + aoff + m * 2048 + 1024); \
        if constexpr (F8) dst##8[m] = f8cat(lo_, hi_); else { dst[m][0] = lo_; dst[m][1] = hi_; } } } while (0)
#define PG8_LDB(dst, b, h) do { _Pragma("unroll") for (int n = 0; n < 2; ++n) { const bf16x8 lo_ = *(const PG8_LAS bf16x8*)(lds + PG8_SB(b, h) + boff + n * 2048), hi_ = *(const PG8_LAS bf16x8*)(lds + PG8_SB(b, h) + boff + n * 2048 + 1024); \
        if constexpr (F8) dst##8[n] = f8cat(lo_, hi_); else { dst[n][0] = lo_; dst[n][1] = hi_; } } } while (0)
#define PG8_MMA(ai, bj, At, Bt) do { __builtin_amdgcn_s_setprio(1); _Pragma("unroll") for (int m = 0; m < 4; ++m) _Pragma("unroll") for (int n = 0; n < 2; ++n) { \
        if constexpr (F8) asm volatile("v_mfma_scale_f32_16x16x128_f8f6f4 %0, %1, %2, %0, %3, %3 op_sel_hi:[0,0,0]" : "+v"(acc[ai][bj][m][n]) : "v"(Bt##8[n]), "v"(At##8[m]), "v"(f8scale));   \
        else { _Pragma("unroll") for (int k = 0; k < 2; ++k) acc[ai][bj][m][n] = __builtin_amdgcn_mfma_f32_16x16x32_bf16(Bt[n][k], At[m][k], acc[ai][bj][m][n], 0, 0, 0); } } __builtin_amdgcn_s_setprio(0); } while (0)
#define PG8_WAIT_V(n) asm volatile("s_waitcnt vmcnt(" #n ")" ::: "memory")
#define PG8_WAIT_L(n) asm volatile("s_waitcnt lgkmcnt(" #n ")" ::: "memory")
#define PG8_BAR __builtin_amdgcn_s_barrier()
#define PG8_SCHED __builtin_amdgcn_sched_barrier(0)
    Unit cur, nxt; int ui = 0;
    if (!S.next(0, cur)) return;
    f32x4 acc[2][2][4][2];
#pragma unroll
    for (int a = 0; a < 2; ++a)
#pragma unroll
        for (int b = 0; b < 2; ++b)
#pragma unroll
            for (int m = 0; m < 4; ++m)
#pragma unroll
                for (int n = 0; n < 2; ++n) acc[a][b][m][n] = (f32x4){0.f, 0.f, 0.f, 0.f};
    bf16x8 At[4][2], B0[2][2], B1[2][2]; pg8_v8i At8[4], B08[2], B18[2]; const int f8scale = 0x7f7f7f7f;
    const char* cA = cur.a; const char* cB = cur.b;
    S.a_ready(cur);
    if constexpr (SP2) {
        PG8_STAGE(PG8_SB(0, 0), cB, voffB); PG8_STAGE(PG8_SB(0, 1), cB + hstepB, voffB); PG8_STAGE(PG8_SA(0, 0), cA, voffA); PG8_STAGE(PG8_SA(0, 1), cA + hstepA, voffA);
        if (wr == 1) PG8_BAR;
        PG8_WAIT_V(2); PG8_BAR;
        PG8_STAGE(PG8_SB(1, 0), cB + kstep, voffB); PG8_STAGE(PG8_SA(1, 0), cA + kstep, voffA); PG8_STAGE(PG8_SB(1, 1), cB + hstepB + kstep, voffB);
        PG8_WAIT_V(6); PG8_BAR;
    } else {
        PG8_STAGE(PG8_SB(0, 0), cB, voffB); PG8_STAGE(PG8_SA(0, 0), cA, voffA); PG8_STAGE(PG8_SB(0, 1), cB + hstepB, voffB); PG8_STAGE(PG8_SA(0, 1), cA + hstepA, voffA);
        if (wr == 1) PG8_BAR;
        PG8_WAIT_V(4); PG8_BAR;
        PG8_STAGE(PG8_SB(1, 0), cB + kstep, voffB); PG8_STAGE(PG8_SA(1, 0), cA + kstep, voffA); PG8_STAGE(PG8_SB(1, 1), cB + hstepB + kstep, voffB);
        PG8_WAIT_V(6); PG8_BAR;
    }
    for (;;) {
        const bool has_next = S.next(ui + 1, nxt);
        const char* nA = has_next ? nxt.a : cA; const char* nB = has_next ? nxt.b : cB;
#pragma unroll 1
        for (int t = 0; t < nt; t += 2) {
            const bool last = (t == nt - 2);
            const char* a1 = cA + (size_t)(t + 1) * kstep;
            const char* a2 = last ? nA : cA + (size_t)(t + 2) * kstep; const char* b2 = last ? nB : cB + (size_t)(t + 2) * kstep;
            const char* a3 = a2 + kstep; const char* b3 = b2 + kstep;
            if (last && has_next) S.a_ready(nxt);
            if constexpr (SP2) {
            PG8_LDB(B0, 0, 0); PG8_LDB(B1, 0, 1); PG8_SCHED; PG8_LDA(At, 0, 0); PG8_STAGE(PG8_SA(1, 1), a1 + hstepA, voffA);
            PG8_WAIT_V(8); PG8_WAIT_L(0); PG8_BAR; PG8_MMA(0, 0, At, B0); PG8_MMA(0, 1, At, B1); PG8_BAR; PG8_SCHED;
            PG8_LDA(At, 0, 1); PG8_STAGE(PG8_SB(0, 0), b2, voffB); PG8_STAGE(PG8_SB(0, 1), b2 + hstepB, voffB); PG8_STAGE(PG8_SA(0, 0), a2, voffA);
            PG8_WAIT_V(8); PG8_WAIT_L(0); PG8_BAR; PG8_MMA(1, 0, At, B0); PG8_MMA(1, 1, At, B1); PG8_BAR; PG8_SCHED;
            PG8_LDB(B0, 1, 0); PG8_LDB(B1, 1, 1); PG8_SCHED; PG8_LDA(At, 1, 0); PG8_STAGE(PG8_SA(0, 1), a2 + hstepA, voffA);
            PG8_WAIT_V(8); PG8_WAIT_L(0); PG8_BAR; PG8_MMA(0, 0, At, B0); PG8_MMA(0, 1, At, B1); PG8_BAR; PG8_SCHED;
            PG8_LDA(At, 1, 1); PG8_STAGE(PG8_SB(1, 0), b3, voffB); PG8_STAGE(PG8_SB(1, 1), b3 + hstepB, voffB); PG8_STAGE(PG8_SA(1, 0), a3, voffA);
            PG8_WAIT_V(8); PG8_WAIT_L(0); PG8_BAR; PG8_MMA(1, 0, At, B0); PG8_MMA(1, 1, At, B1); PG8_BAR; PG8_SCHED;
            } else {
            PG8_LDB(B0, 0, 0); PG8_SCHED; PG8_LDA(At, 0, 0); PG8_STAGE(PG8_SA(1, 1), a1 + hstepA, voffA);
            PG8_WAIT_L(8); PG8_BAR; PG8_WAIT_L(0); PG8_MMA(0, 0, At, B0); PG8_BAR; PG8_SCHED;
            PG8_LDB(B1, 0, 1); PG8_STAGE(PG8_SB(0, 0), b2, voffB);
            PG8_BAR; PG8_WAIT_L(0); PG8_MMA(0, 1, At, B1); PG8_BAR;
            PG8_LDA(At, 0, 1); PG8_STAGE(PG8_SA(0, 0), a2, voffA);
            PG8_BAR; PG8_WAIT_L(0); PG8_MMA(1, 0, At, B0); PG8_BAR; PG8_SCHED;
            PG8_STAGE(PG8_SB(0, 1), b2 + hstepB, voffB);
            PG8_WAIT_V(6); PG8_BAR; PG8_MMA(1, 1, At, B1); PG8_BAR;
            PG8_LDB(B0, 1, 0); PG8_SCHED; PG8_LDA(At, 1, 0); PG8_STAGE(PG8_SA(0, 1), a2 + hstepA, voffA);
            PG8_WAIT_L(8); PG8_BAR; PG8_WAIT_L(0); PG8_MMA(0, 0, At, B0); PG8_BAR; PG8_SCHED;
            PG8_LDB(B1, 1, 1); PG8_STAGE(PG8_SB(1, 0), b3, voffB);
            PG8_BAR; PG8_WAIT_L(0); PG8_MMA(0, 1, At, B1); PG8_BAR;
            PG8_LDA(At, 1, 1); PG8_STAGE(PG8_SA(1, 0), a3, voffA);
            PG8_BAR; PG8_WAIT_L(0); PG8_MMA(1, 0, At, B0); PG8_BAR; PG8_SCHED;
            PG8_STAGE(PG8_SB(1, 1), b3 + hstepB, voffB);
            PG8_WAIT_V(6); PG8_BAR; PG8_MMA(1, 1, At, B1); PG8_BAR;
            }
        }
        if constexpr (ALIGN_EPI) { if (wr == 0) PG8_BAR; }
        if constexpr (F8) asm volatile("s_nop 15\n\ts_nop 7" ::: "memory");
        bool keep = false;
        if constexpr (!Epi::AFTER_DRAIN) { if constexpr (Epi::CHAIN) keep = E.chain(acc, cur, wr, wc, fr, fq); else E(acc, cur, wr, wc, fr, fq); S.done(cur); }
        if (!has_next) break;
        if (!keep) {
#pragma unroll
        for (int a = 0; a < 2; ++a)
#pragma unroll
            for (int b = 0; b < 2; ++b)
#pragma unroll
                for (int m = 0; m < 4; ++m)
#pragma unroll
                    for (int n = 0; n < 2; ++n) acc[a][b][m][n] = (f32x4){0.f, 0.f, 0.f, 0.f};
        }
        cur = nxt; cA = nA; cB = nB; ++ui;
        if constexpr (ALIGN_EPI) { if (wr == 1) PG8_BAR; }
    }
    PG8_WAIT_V(0);
    if constexpr (!ALIGN_EPI) { if (wr == 0) PG8_BAR; }
    PG8_BAR;
    if constexpr (Epi::AFTER_DRAIN) { E.fused(acc, cur, wr, wc, fr, fq, lds, wid, lane); S.done(cur); }
#undef PG8_SA
#undef PG8_SB
#undef PG8_STAGE
#undef PG8_LDA
#undef PG8_LDB
#undef PG8_MMA
#undef PG8_WAIT_V
#undef PG8_WAIT_L
#undef PG8_BAR
#undef PG8_SCHED
}
}

#define GAS __attribute__((address_space(1)))
#define LAS __attribute__((address_space(3)))
typedef unsigned short bf16;
typedef unsigned v4u __attribute__((ext_vector_type(4)));
typedef unsigned v2u __attribute__((ext_vector_type(2)));
typedef float f32x4 __attribute__((ext_vector_type(4)));
typedef float f32x2 __attribute__((ext_vector_type(2)));
typedef GAS unsigned gu32;
#define RLX_AGENT __ATOMIC_RELAXED, __HIP_MEMORY_SCOPE_AGENT
#define LDS_WAIT() asm volatile("s_waitcnt lgkmcnt(0)" ::: "memory")
#define VM_WAIT() asm volatile("s_waitcnt vmcnt(0)" ::: "memory")
__device__ __forceinline__ unsigned pk2(float lo, float hi) { return pg8::cvt_pk_bf16(lo, hi); }
__device__ __forceinline__ float bflo(unsigned w) { return __uint_as_float(w << 16); }
__device__ __forceinline__ float bfhi(unsigned w) { return __uint_as_float(w & 0xffff0000u); }
__device__ __forceinline__ float bf2f(bf16 b) { return __uint_as_float((unsigned)b << 16); }
__device__ __forceinline__ bf16 f2bf(float f) { return (bf16)(pk2(f, 0.f) & 0xffffu); }
__device__ __forceinline__ float bfround(float f) { return bflo(pk2(f, 0.f)); }
__device__ __forceinline__ unsigned pk4_fp8(float a, float b, float c, float d) {
    a = fminf(fmaxf(a, -448.f), 448.f); b = fminf(fmaxf(b, -448.f), 448.f); c = fminf(fmaxf(c, -448.f), 448.f); d = fminf(fmaxf(d, -448.f), 448.f);
    int p = 0; p = __builtin_amdgcn_cvt_pk_fp8_f32(a, b, p, false); p = __builtin_amdgcn_cvt_pk_fp8_f32(c, d, p, true); return (unsigned)p; }
__device__ __forceinline__ float rcp_(float x) { return __builtin_amdgcn_rcpf(x); }
__device__ __forceinline__ float sigmoidf_(float x) { return rcp_(1.0f + __expf(-x)); }

#define XB_TMO      128
#define XB_XCNT(j)  (256  + 64 * (j))
#define XB_XSUB(j)  (1280 + 64 * (j))
#define XB_XGEN(j)  (2304 + 64 * (j))
#define XB_TOP      3328
#define XB_TOPGEN   3392
#define XCD_BAR_WORDS 3456
#define XB_SPIN_CAP (1u << 18)

__device__ __forceinline__ unsigned xb_ld(unsigned* p)              { return __hip_atomic_load(p, __ATOMIC_RELAXED, __HIP_MEMORY_SCOPE_AGENT); }
__device__ __forceinline__ unsigned xb_add(unsigned* p, unsigned v) { return __hip_atomic_fetch_add(p, v, __ATOMIC_RELAXED, __HIP_MEMORY_SCOPE_AGENT); }
__device__ __forceinline__ unsigned xb_xcc_id() { return (unsigned)__builtin_amdgcn_s_getreg((3 << 11) | 20) & 0xFu; }
#define XB_SPIN(cond, bar) do { unsigned _sp = 0; while (cond) { __builtin_amdgcn_s_sleep(1); \
    if ((++_sp & 255u) == 0u) { if (xb_ld(&(bar)[XB_TMO])) break; if (_sp > XB_SPIN_CAP) { atomicAdd(&(bar)[XB_TMO], 1u); break; } } } } while (0)

struct XcdBarrier {
    unsigned* bar; unsigned x;
    volatile LAS unsigned* st;
};

__device__ __forceinline__ XcdBarrier xcd_barrier_post(unsigned* bar, volatile LAS unsigned* st, bool leader) {
    XcdBarrier b; b.bar = bar; b.x = xb_xcc_id(); b.st = st;
    if (leader) (void)xb_add(&bar[XB_XCNT(b.x)], 1u);
    return b;
}
__device__ __forceinline__ void xcd_barrier_complete(unsigned* bar, unsigned x, unsigned& nloc, unsigned& nx) {
    const unsigned G = gridDim.x * gridDim.y * gridDim.z;
    unsigned sum, cnt, mine, sp = 0u;
    for (;;) {
        sum = 0u; cnt = 0u; mine = 0u;
#pragma unroll
        for (unsigned j = 0; j < 16; ++j) { const unsigned c = xb_ld(&bar[XB_XCNT(j)]); sum += c; cnt += (c > 0u) ? 1u : 0u; mine = (j == x) ? c : mine; }
        if (sum == G) break;
        __builtin_amdgcn_s_sleep(1);
        if ((++sp & 255u) == 0u) { if (xb_ld(&bar[XB_TMO])) break; if (sp > XB_SPIN_CAP) { atomicAdd(&bar[XB_TMO], 1u); break; } }
    }
    nloc = mine > 0u ? mine : 1u; nx = cnt > 0u ? cnt : 1u;
}

__device__ __forceinline__ void xcd_barrier(const XcdBarrier& b_, bool leader) {
    XcdBarrier b = b_; asm volatile("" : "+s"(b.x));
    asm volatile("s_waitcnt vmcnt(0)" ::: "memory");
    __syncthreads();
    if (leader) {
        unsigned* bar = b.bar;
        __builtin_amdgcn_s_waitcnt(0);
        unsigned nloc = b.st[0], nx = b.st[1];
        if (nloc == 0u) { xcd_barrier_complete(bar, b.x, nloc, nx); b.st[0] = nloc; b.st[1] = nx; }
        const unsigned old = xb_add(&bar[XB_XSUB(b.x)], 1u);
        const unsigned gen = old / nloc;
        if (old + 1u == (gen + 1u) * nloc) {
            __builtin_amdgcn_fence(__ATOMIC_RELEASE, "agent");
            asm volatile("s_waitcnt vmcnt(0)" ::: "memory");
            const unsigned og = xb_add(&bar[XB_TOP], 1u);
            const unsigned tg = og / nx;
            if (og + 1u == (tg + 1u) * nx) xb_add(&bar[XB_TOPGEN], 1u);
            else XB_SPIN(xb_ld(&bar[XB_TOPGEN]) == tg, bar);
            __builtin_amdgcn_fence(__ATOMIC_ACQUIRE, "agent");
            xb_add(&bar[XB_XGEN(b.x)], 1u);
            asm volatile("s_waitcnt vmcnt(0)" ::: "memory");
        } else {
            XB_SPIN(xb_ld(&bar[XB_XGEN(b.x)]) == gen, bar);
            __builtin_amdgcn_fence(__ATOMIC_ACQUIRE, "agent");
            asm volatile("s_waitcnt vmcnt(0)" ::: "memory");
        }
    }
    __syncthreads();
}

namespace moba {
using bf16x8=__attribute__((ext_vector_type(8)))short;
using s16x4=__attribute__((ext_vector_type(4)))short;
using f32x16=__attribute__((ext_vector_type(16)))float;
using u32x4=__attribute__((ext_vector_type(4)))unsigned;
typedef unsigned short bf16raw;
constexpr int SEQL=4096,NHEAD=8,HDIM=64,DM=7168;
constexpr int COLQ=1536,COLK=2048,COLV=2560;
constexpr int NW=8,QBLK=32,QB=QBLK*NW,KVBLK=64;
__device__ __forceinline__ int crow(int r,int hi){return (r&3)+8*(r>>2)+4*hi;}
#define SBAR() __builtin_amdgcn_sched_barrier(0)
__device__ __forceinline__ void cmask(f32x16&p0,f32x16&p1,int jb,int qrel,int hi){
  const float NEG=-INFINITY; int kb=64*jb+4*hi;
  #pragma unroll
  for(int r=0;r<16;++r){int kv=kb+(r&3)+8*(r>>2); if(kv>qrel)p0[r]=NEG; if(kv+32>qrel)p1[r]=NEG;}
}
constexpr int NSLOT=3, SLOTB=8192;
constexpr int LDS_K=0, LDS_V=NSLOT*SLOTB, LDS_WS=2*NSLOT*SLOTB, LDS_OST=LDS_WS+NW*64*4, LDS_KM=LDS_OST+NW*4096, LDS_BYTES=LDS_KM+4096;
__device__ __forceinline__ void glds16(const void*gsrc,unsigned lds_dst){unsigned keep;
  asm volatile("s_mov_b32 %0, m0\n\ts_mov_b32 m0, %2\n\ts_nop 0\n\tglobal_load_lds_dwordx4 %1, off\n\ts_mov_b32 m0, %0":"=&s"(keep):"v"(gsrc),"s"(lds_dst):"memory");}
typedef float f32x2_t __attribute__((ext_vector_type(2))); typedef __bf16 bf16x2_t __attribute__((ext_vector_type(2)));
__device__ __forceinline__ unsigned cvtpk_s(float lo,float hi){f32x2_t v={lo,hi};bf16x2_t b=__builtin_convertvector(v,bf16x2_t);return __builtin_bit_cast(unsigned,b);}
#define WAIT_BAR(N) asm volatile("s_waitcnt vmcnt(" #N ") lgkmcnt(0)\n\ts_barrier":::"memory")

__device__ __forceinline__ void qkt(f32x16&p0,f32x16&p1,const char*Kslot,const bf16x8*qr,int r32,int hi){
  const char*kb=Kslot+hi*1024+r32*16; const f32x16 zf=f32x16{};
  #pragma unroll
  for(int d0=0;d0<4;++d0){
    const bf16x8 b0=*reinterpret_cast<const bf16x8*>(kb+d0*2048);
    const bf16x8 b1=*reinterpret_cast<const bf16x8*>(kb+d0*2048+512);
    if(d0==0){p0=__builtin_amdgcn_mfma_f32_32x32x16_bf16(b0,qr[0],zf,0,0,0);p1=__builtin_amdgcn_mfma_f32_32x32x16_bf16(b1,qr[0],zf,0,0,0);}
    else{p0=__builtin_amdgcn_mfma_f32_32x32x16_bf16(b0,qr[d0],p0,0,0,0);p1=__builtin_amdgcn_mfma_f32_32x32x16_bf16(b1,qr[d0],p1,0,0,0);}}
}
typedef __attribute__((address_space(3))) const char* lds_cptr;
typedef short v4i16_t __attribute__((ext_vector_type(4)));
__device__ __forceinline__ void kload8(bf16x8*kf,lds_cptr kp){
  kf[0]=*(const __attribute__((address_space(3))) bf16x8*)(kp);      kf[1]=*(const __attribute__((address_space(3))) bf16x8*)(kp+512);
  kf[2]=*(const __attribute__((address_space(3))) bf16x8*)(kp+2048); kf[3]=*(const __attribute__((address_space(3))) bf16x8*)(kp+2560);
  kf[4]=*(const __attribute__((address_space(3))) bf16x8*)(kp+4096); kf[5]=*(const __attribute__((address_space(3))) bf16x8*)(kp+4608);
  kf[6]=*(const __attribute__((address_space(3))) bf16x8*)(kp+6144); kf[7]=*(const __attribute__((address_space(3))) bf16x8*)(kp+6656);
}
__device__ __forceinline__ void kload2(bf16x8*kf,lds_cptr kp,int j){ kf[2*j]=*(const __attribute__((address_space(3))) bf16x8*)(kp+j*2048); kf[2*j+1]=*(const __attribute__((address_space(3))) bf16x8*)(kp+j*2048+512); }
__device__ __forceinline__ s16x4 vtr(lds_cptr p){ return __builtin_bit_cast(s16x4,__builtin_amdgcn_ds_read_tr16_b64_v4i16((__attribute__((address_space(3))) v4i16_t*)p)); }
__device__ __forceinline__ void pv(f32x16*o,int vb,bf16x8 pa0,bf16x8 pa1,bf16x8 pa2,bf16x8 pa3){
  #pragma unroll
  for(int d0=0;d0<2;++d0){s16x4 lo[4],hi[4];
    #pragma unroll
    for(int ks=0;ks<4;++ks){
      asm volatile("ds_read_b64_tr_b16 %0,%1 offset:%c2":"=&v"(lo[ks]):"v"(vb),"i"(d0*4096+ks*1024):"memory");
      asm volatile("ds_read_b64_tr_b16 %0,%1 offset:%c2":"=&v"(hi[ks]):"v"(vb),"i"(d0*4096+ks*1024+512):"memory");}
    asm volatile("s_waitcnt lgkmcnt(0)":::"memory");SBAR();
    #define PK(k) (bf16x8){lo[k][0],lo[k][1],lo[k][2],lo[k][3],hi[k][0],hi[k][1],hi[k][2],hi[k][3]}
    o[d0]=__builtin_amdgcn_mfma_f32_32x32x16_bf16(pa0,PK(0),o[d0],0,0,0);
    o[d0]=__builtin_amdgcn_mfma_f32_32x32x16_bf16(pa1,PK(1),o[d0],0,0,0);
    o[d0]=__builtin_amdgcn_mfma_f32_32x32x16_bf16(pa2,PK(2),o[d0],0,0,0);
    o[d0]=__builtin_amdgcn_mfma_f32_32x32x16_bf16(pa3,PK(3),o[d0],0,0,0);
    #undef PK
  }
}
__device__ __forceinline__ float bfl(short s){return __uint_as_float(((unsigned)(unsigned short)s)<<16);}

__device__ __forceinline__ void moba_unit(int tid_in,int b,int h,int qb,bf16raw*P,const float*KM,char*shm,int ocol=COLQ){
  int tid=tid_in; asm volatile("":"+v"(tid));
  const int lane=tid&63,r32=lane&31,hi=lane>>5; const int wid=__builtin_amdgcn_readfirstlane(tid>>6);
  const long rowbase=(long)b*SEQL; const int q0=qb*QB;
  bf16raw*Qw=P+(rowbase+q0+wid*QBLK)*DM+COLQ+h*HDIM;
  const bf16raw*Kh=P+rowbase*DM+COLK+h*HDIM,*Vh=P+rowbase*DM+COLV+h*HDIM;
  const unsigned lds0=(unsigned)(uintptr_t)shm;
  float*wsf=(float*)(shm+LDS_WS)+wid*64;
  bf16x8 qr[4];
  #pragma unroll
  for(int d0=0;d0<4;++d0)qr[d0]=*reinterpret_cast<const bf16x8*>(&Qw[(long)r32*DM+d0*16+hi*8]);
  unsigned selbits=(1u<<qb)-1u;
  if(qb>3){
    float*kml=(float*)(shm+LDS_KM);
    { const float*src=KM+(long)((b*NHEAD+h)*16)*HDIM; const f32x2_t v=*(const f32x2_t*)(src+2*tid); *(f32x2_t*)(kml+2*tid)=v; }
    asm volatile("s_waitcnt vmcnt(0) lgkmcnt(0)\n\ts_barrier":::"memory");
    float qf[32];
    #pragma unroll
    for(int d0=0;d0<4;++d0)
      #pragma unroll
      for(int e=0;e<8;++e)qf[d0*8+e]=bfl(qr[d0][e]);
    float g0=-INFINITY,g1=-INFINITY,g2=-INFINITY; int s0=0,s1=0,s2=0;
    for(int jb=0;jb<qb;++jb){
      const float*kr=kml+jb*64+hi*8; float g=0.f;
      #pragma unroll
      for(int d0=0;d0<4;++d0){ const f32x2_t*k2=(const f32x2_t*)(kr+d0*16);
        #pragma unroll
        for(int e=0;e<4;++e){ const f32x2_t kv=k2[e]; g+=qf[d0*8+2*e]*kv.x; g+=qf[d0*8+2*e+1]*kv.y; } }
      {auto rr=__builtin_amdgcn_permlane32_swap(__float_as_uint(g),__float_as_uint(g),false,false);g=__uint_as_float(rr[0])+__uint_as_float(rr[1]);}
      if(g>g0){g2=g1;s2=s1;g1=g0;s1=s0;g0=g;s0=jb;} else if(g>g1){g2=g1;s2=s1;g1=g;s1=jb;} else if(g>g2){g2=g;s2=jb;}
    }
    selbits=(1u<<s0)|(1u<<s1)|(1u<<s2);
  }
  #define TMASK(t) (((t)<4)?0xffffffffu:(0u-((selbits>>(((t)-4)>>2))&1u)))
  const bf16raw*ksrc=Kh+(long)lane*DM+wid*8;
  const bf16raw*vsrc=Vh+(long)(16*(wid&3)+(lane>>2))*DM+(wid>>2)*32+(lane&3)*8;
  const unsigned kdst=lds0+LDS_K+wid*1024, vdst=lds0+LDS_V+wid*1024;
  #define KT(t) (((t)<4)?(4*qb+(t)):((t)-4))
  #define DMA_K(t,slot) glds16(ksrc+(long)KT(t)*KVBLK*DM,(unsigned)__builtin_amdgcn_readfirstlane(kdst+(slot)))
  #define DMA_V(t,slot) glds16(vsrc+(long)KT(t)*KVBLK*DM,(unsigned)__builtin_amdgcn_readfirstlane(vdst+(slot)))
  const char*Kbase=shm+LDS_K; bf16x8 kf[8];
  const lds_cptr shm3=(lds_cptr)shm; const lds_cptr kp0=shm3+LDS_K+hi*1024+r32*16; const lds_cptr vp0=shm3+LDS_V+((lane>>4)&1)*32+(lane&3)*8+(4*hi+((lane&15)>>2))*64;
  const int vb0=(int)(lds0+LDS_V)+((lane>>4)&1)*32+(lane&3)*8+(4*hi+((lane&15)>>2))*64;
  const int NT=4*qb+4;
  DMA_K(0,0);DMA_V(0,0);DMA_K(1,SLOTB);
  float l_reg=0.f;f32x16 o[2];o[0]=f32x16{};o[1]=f32x16{};
  const int qrel=wid*QBLK+r32;
  f32x16 pA0,pA1,pB0,pB1;
  int sl_prev=0,sl_cur=0,sl_next=SLOTB;
  #define ROT() do{sl_prev=sl_cur;sl_cur=sl_next;sl_next=(sl_next==(NSLOT-1)*SLOTB)?0:sl_next+SLOTB;}while(0)
  DMA_K(2,2*SLOTB);
  WAIT_BAR(3);
  qkt(pA0,pA1,Kbase,qr,r32,hi);asm volatile("s_nop 15\n\ts_nop 7":"+v"(pA0),"+v"(pA1));cmask(pA0,pA1,0,qrel,hi);
  _Pragma("unroll") for(int r=0;r<16;++r){pA0[r]=__builtin_amdgcn_exp2f(pA0[r]);pA1[r]=__builtin_amdgcn_exp2f(pA1[r]);}
  WAIT_BAR(0);
  DMA_K(3,0);DMA_V(1,SLOTB);
  ROT();
  kload8(kf,kp0+sl_cur);
  WAIT_BAR(2);
  s16x4 vlo[8],vhi[8]; u32x4 pw0,pw1,pw2,pw3;
  const f32x16 zf=f32x16{};
  #define PKW(P,B) (cvtpk_s(P[B],P[B+1])&mprev_)
  #define PAF(k) __builtin_bit_cast(bf16x8,pw##k)
  #define VFR(i) (bf16x8){vlo[i][0],vlo[i][1],vlo[i][2],vlo[i][3],vhi[i][0],vhi[i][1],vhi[i][2],vhi[i][3]}
  #define PIN(x) asm volatile("":"+v"(x))
  #define GAPA(MF,A0,A1,A2,A3,W0,W1,PW) do{ MF; sacc+=A0; sacc+=A1; sacc+=A2; sacc+=A3; PIN(sacc); W0; W1; PIN(PW); SBAR(); }while(0)
  #define EX(v) __builtin_amdgcn_exp2f(v)
  #define GAPB(MF,X,B) do{ MF; X[B]=EX(X[B]); X[B+1]=EX(X[B+1]); X[B+2]=EX(X[B+2]); X[B+3]=EX(X[B+3]); PIN(X); SBAR(); }while(0)
  #define VRD(i) do{ vlo[i]=vtr(vp_+(((i)>>2)*4096+((i)&3)*1024)); vhi[i]=vtr(vp_+(((i)>>2)*4096+((i)&3)*1024+512)); }while(0)
  #define KRD(G,j) do{ if(G){ kload2(kf,kp0+sl_next,j); SBAR(); } }while(0)
  #define STEP(C0,C1,P0,P1,t,GK,GV,GL,CM) do{ SBAR(); \
    const unsigned mprev_=TMASK((t)-1); \
    const lds_cptr vp_=vp0+sl_prev; \
    VRD(0); SBAR(); float sacc=(P0[0]+P0[1]); \
    GAPA(C0=__builtin_amdgcn_mfma_f32_32x32x16_bf16(kf[0],qr[0],zf,0,0,0), P0[2],P0[3],P0[4],P0[5],     pw0[0]=PKW(P0,0), pw0[1]=PKW(P0,2), pw0); \
    VRD(4); SBAR(); GAPA(C1=__builtin_amdgcn_mfma_f32_32x32x16_bf16(kf[1],qr[0],zf,0,0,0), P0[6],P0[7],P0[8],P0[9],     pw0[2]=PKW(P0,4), pw0[3]=PKW(P0,6), pw0); \
    VRD(1); SBAR(); GAPA(C0=__builtin_amdgcn_mfma_f32_32x32x16_bf16(kf[2],qr[1],C0,0,0,0),   P0[10],P0[11],P0[12],P0[13], pw1[0]=PKW(P0,8), pw1[1]=PKW(P0,10), pw1); \
    VRD(5); SBAR(); GAPA(C1=__builtin_amdgcn_mfma_f32_32x32x16_bf16(kf[3],qr[1],C1,0,0,0),   P0[14],P0[15],P1[0],P1[1],   pw1[2]=PKW(P0,12),pw1[3]=PKW(P0,14), pw1); \
    VRD(2); SBAR(); GAPA(C0=__builtin_amdgcn_mfma_f32_32x32x16_bf16(kf[4],qr[2],C0,0,0,0),   P1[2],P1[3],P1[4],P1[5],     pw2[0]=PKW(P1,0), pw2[1]=PKW(P1,2), pw2); \
    VRD(6); SBAR(); GAPA(C1=__builtin_amdgcn_mfma_f32_32x32x16_bf16(kf[5],qr[2],C1,0,0,0),   P1[6],P1[7],P1[8],P1[9],     pw2[2]=PKW(P1,4), pw2[3]=PKW(P1,6), pw2); \
    VRD(3); SBAR(); GAPA(C0=__builtin_amdgcn_mfma_f32_32x32x16_bf16(kf[6],qr[3],C0,0,0,0),   P1[10],P1[11],P1[12],P1[13], pw3[0]=PKW(P1,8), pw3[1]=PKW(P1,10), pw3); \
    VRD(7); SBAR(); GAPA(C1=__builtin_amdgcn_mfma_f32_32x32x16_bf16(kf[7],qr[3],C1,0,0,0),   P1[14],P1[15],0.f,0.f,       pw3[2]=PKW(P1,12),pw3[3]=PKW(P1,14), pw3); \
    l_reg+=__uint_as_float(__float_as_uint(sacc)&mprev_); \
    if(GK){DMA_K((t)+3,sl_cur);} if(GV){DMA_V((t)+1,sl_next);} \
    if(CM){cmask(C0,C1,(t),qrel,hi);} \
    SBAR(); \
    GAPB(o[0]=__builtin_amdgcn_mfma_f32_32x32x16_bf16(PAF(0),VFR(0),o[0],0,0,0), C0,0); \
    GAPB(o[1]=__builtin_amdgcn_mfma_f32_32x32x16_bf16(PAF(0),VFR(4),o[1],0,0,0), C0,4); \
    KRD(GL,0); GAPB(o[0]=__builtin_amdgcn_mfma_f32_32x32x16_bf16(PAF(1),VFR(1),o[0],0,0,0), C0,8); \
    KRD(GL,1); GAPB(o[1]=__builtin_amdgcn_mfma_f32_32x32x16_bf16(PAF(1),VFR(5),o[1],0,0,0), C0,12); \
    KRD(GL,2); GAPB(o[0]=__builtin_amdgcn_mfma_f32_32x32x16_bf16(PAF(2),VFR(2),o[0],0,0,0), C1,0); \
    KRD(GL,3); GAPB(o[1]=__builtin_amdgcn_mfma_f32_32x32x16_bf16(PAF(2),VFR(6),o[1],0,0,0), C1,4); \
    GAPB(o[0]=__builtin_amdgcn_mfma_f32_32x32x16_bf16(PAF(3),VFR(3),o[0],0,0,0), C1,8); \
    GAPB(o[1]=__builtin_amdgcn_mfma_f32_32x32x16_bf16(PAF(3),VFR(7),o[1],0,0,0), C1,12); \
    }while(0)
  #define ENDW(tt) do{ if((tt)+3<NT){WAIT_BAR(2);} else if((tt)+2<NT){WAIT_BAR(1);} else {WAIT_BAR(0);} }while(0)
  STEP(pB0,pB1,pA0,pA1,1,(4<NT),true,true,true);          ENDW(1); ROT();
  STEP(pA0,pA1,pB0,pB1,2,(5<NT),true,true,true);          ENDW(2); ROT();
  STEP(pB0,pB1,pA0,pA1,3,(6<NT),(4<NT),(4<NT),true);
  if(NT>4){
    ENDW(3); ROT();
    int t=4;
    for(;t+5<NT;t+=2){
      STEP(pA0,pA1,pB0,pB1,t,true,true,true,false);     WAIT_BAR(2); ROT();
      STEP(pB0,pB1,pA0,pA1,t+1,true,true,true,false);   WAIT_BAR(2); ROT();
    }
    for(;t+2<NT;t+=2){
      STEP(pA0,pA1,pB0,pB1,t,(t+3<NT),(t+1<NT),(t+1<NT),false);       ENDW(t);   ROT();
      STEP(pB0,pB1,pA0,pA1,t+1,(t+4<NT),(t+2<NT),(t+2<NT),false);     ENDW(t+1); ROT();
    }
    STEP(pA0,pA1,pB0,pB1,t,false,true,true,false);      ENDW(t); ROT();
    STEP(pB0,pB1,pA0,pA1,t+1,false,false,false,false);
  }
  { const unsigned mprev_=TMASK(NT-1);
    float sacc=pB0[0]+pB0[1]; _Pragma("unroll") for(int r=2;r<16;++r)sacc+=pB0[r]; _Pragma("unroll") for(int r=0;r<16;++r)sacc+=pB1[r]; l_reg+=__uint_as_float(__float_as_uint(sacc)&mprev_);
    pw0=(u32x4){PKW(pB0,0),PKW(pB0,2),PKW(pB0,4),PKW(pB0,6)};pw1=(u32x4){PKW(pB0,8),PKW(pB0,10),PKW(pB0,12),PKW(pB0,14)};pw2=(u32x4){PKW(pB1,0),PKW(pB1,2),PKW(pB1,4),PKW(pB1,6)};pw3=(u32x4){PKW(pB1,8),PKW(pB1,10),PKW(pB1,12),PKW(pB1,14)};
    SBAR(); pv(o,vb0+sl_cur,PAF(0),PAF(1),PAF(2),PAF(3)); }
  #undef PKW
  #undef PAF
  #undef VFR
  #undef PIN
  #undef GAPA
  #undef GAPB
  #undef EX
  #undef VRD
  #undef KRD
  #undef STEP
  #undef ENDW
  {auto rr=__builtin_amdgcn_permlane32_swap(__float_as_uint(l_reg),__float_as_uint(l_reg),false,false);l_reg=__uint_as_float(rr[0])+__uint_as_float(rr[1]);}
  if(hi==0)wsf[32+r32]=l_reg;asm volatile("s_waitcnt lgkmcnt(0)":::"memory");
  float rli[16];
  #pragma unroll
  for(int r=0;r<16;++r)rli[r]=__builtin_amdgcn_rcpf(wsf[32+crow(r,hi)]);
  { bf16raw*stg=(bf16raw*)(shm+LDS_OST)+wid*2048;
    #pragma unroll
    for(int r=0;r<16;++r){const int orow=crow(r,hi);
      #pragma unroll
      for(int d0=0;d0<2;++d0)stg[orow*64+d0*32+r32]=(bf16raw)(cvtpk_s(o[d0][r]*rli[r],0.f)&0xffffu);}
    asm volatile("s_waitcnt lgkmcnt(0)":::"memory");
    #pragma unroll
    for(int i=0;i<4;++i){const int row=i*8+(lane>>3),ch=lane&7; const u32x4 v=*(const u32x4*)(stg+row*64+ch*8); *(u32x4*)(Qw+(ocol-COLQ)+(long)row*DM+ch*8)=v;} }
  asm volatile("s_waitcnt lgkmcnt(0)\n\ts_barrier":::"memory");
  #undef DMA_K
  #undef DMA_V
  #undef KT
  #undef TMASK
  #undef ROT
}
#undef SBAR
#undef WAIT_BAR
}

constexpr int NWAVES = 8, NTHR = NWAVES * 64;
#ifndef MK_ONE_LAUNCH
#define MK_ONE_LAUNCH 1
#endif
constexpr int BATCH = 8, SEQ = 4096, D = 1024, M = BATCH * SEQ;
constexpr int NCOL = 7168;
constexpr int C_XA = 0, C_BA = 512, C_CA = 1024, C_Q = 1536, C_K = 2048, C_V = 2560, C_XC = 3072, C_GC = 3584, C_G = 4096;
constexpr int NH = 8, HD = 64, BLK = 256, NBLK = SEQ / BLK;
constexpr int DFF = 2816, EFF = 3584, NEXP = 8;
constexpr int LCH = 64, NCH = SEQ / LCH;
constexpr float EPS = 1e-6f;
constexpr float QSCALE = 0.18033688011112042f;
constexpr int MOE_DOWN_COST = 3;
constexpr int MOE_TILES = 136, MOE_ROWS = MOE_TILES * 256;
constexpr int N_PHASES = 20;

constexpr size_t MiB = 1u << 20;
constexpr size_t WS_CTL = 0, CTL_ZERO_BYTES = 1 * MiB;
constexpr size_t WS_ROPE = 1 * MiB;
constexpr size_t WS_KMEAN = 1 * MiB + 256 * 1024;
constexpr size_t WS_SUM = 2 * MiB;
constexpr size_t WS_TOK = 4 * MiB;
constexpr size_t WS_WL = 6 * MiB;
constexpr size_t WS_ROWTOK = 8 * MiB;
constexpr size_t WS_ROWW = 8 * MiB + 512 * 1024;
constexpr size_t WS_XB = 9 * MiB;
constexpr size_t WS_WIN = 73 * MiB;
constexpr size_t WS_WOABC = 87 * MiB;
constexpr size_t WS_WO = 90 * MiB;
constexpr size_t WS_FGU = 92 * MiB;
constexpr size_t WS_FDN = 103 * MiB;
constexpr size_t WS_P = 109 * MiB;
constexpr size_t WS_HID0 = WS_P;
constexpr float SC_X8 = 8.f, SC_W8 = 64.f, SC_H8 = 8.f;
constexpr size_t WS_MGU = 73 * MiB;
constexpr size_t WS_MDN = 129 * MiB;
constexpr size_t WS_MH = 157 * MiB;
constexpr size_t MH_LIST = (size_t)MOE_ROWS * EFF, XG_LIST = (size_t)MOE_ROWS * D;
constexpr size_t WS_XG = 395 * MiB;
constexpr size_t WS_END = 557 * MiB;
static_assert(WS_P + (size_t)M * NCOL * 2 <= WS_END && WS_XG + 2 * XG_LIST <= WS_END && WS_MH + 2 * MH_LIST <= WS_XG && (size_t)2 * MOE_ROWS * 4 <= 512 * 1024 && WS_MGU + (size_t)8 * 7168 * D <= WS_MDN && WS_MDN + (size_t)8 * D * EFF <= WS_MH && WS_FDN + (size_t)D * DFF * 2 <= WS_P, "d_ws map");
constexpr int CW_BAR = 4096;
constexpr int CW_CNT = 16384;

constexpr int RING_BYTES = 131072;
constexpr int MISC_OFF = 147456 - 256;
constexpr int LDS_BYTES = 147456;

struct Args { const float* in[25]; float* out; unsigned char* ws; int ph_lo, ph_hi; };
struct Ctx { LAS unsigned char* lds; int tid, lane, wave, bid, G; };

__device__ __forceinline__ float shx(float v, int o, int lane) { return __int_as_float(__builtin_amdgcn_ds_bpermute((lane ^ o) << 2, __float_as_int(v))); }
__device__ __forceinline__ float wave_sum(float v, int lane) {
#pragma unroll
    for (int o = 1; o < 64; o <<= 1) v += shx(v, o, lane);
    return v;
}

struct ConvJob { const float* W; int ldw; bf16* WT; int ldk, k0, n0, dst; bool f8; };
__device__ __forceinline__ void conv_load(const ConvJob& j, float (&tv)[32], int lane) {
#pragma unroll
    for (int i = 0; i < 32; ++i) tv[i] = j.W[(size_t)(j.k0 + 2 * i + (lane >> 5)) * j.ldw + j.n0 + (lane & 31)];
}
__device__ __forceinline__ void conv_store(const ConvJob& j, const float (&tv)[32], LAS float* scr, int lane) {
#pragma unroll
    for (int i = 0; i < 32; ++i) scr[(2 * i + (lane >> 5)) * 33 + (lane & 31)] = tv[i];
    LDS_WAIT(); asm volatile("" ::: "memory");
    const int c = lane & 7;
#pragma unroll
    for (int q = 0; q < 4; ++q) { const int n = (lane >> 3) + 8 * q; const LAS float* s = scr + (8 * c) * 33 + n;
        v4u o; o.x = pk2(s[0 * 33], s[1 * 33]); o.y = pk2(s[2 * 33], s[3 * 33]); o.z = pk2(s[4 * 33], s[5 * 33]); o.w = pk2(s[6 * 33], s[7 * 33]);
        *(GAS v4u*)(j.WT + (size_t)(j.dst + n) * j.ldk + j.k0 + 8 * c) = o; }
    LDS_WAIT(); asm volatile("" ::: "memory");
}
__device__ __forceinline__ void conv_store8(const ConvJob& j, const float (&tv)[32], LAS float* scr, int lane) {
#pragma unroll
    for (int i = 0; i < 32; ++i) scr[(2 * i + (lane >> 5)) * 33 + (lane & 31)] = tv[i];
    LDS_WAIT(); asm volatile("" ::: "memory");
    const int c = lane & 3; unsigned char* WT8 = (unsigned char*)j.WT;
#pragma unroll
    for (int q = 0; q < 2; ++q) { const int n = (lane >> 2) + 16 * q; const LAS float* s = scr + (16 * c) * 33 + n;
        v4u o; o.x = pk4_fp8(s[0 * 33] * SC_W8, s[1 * 33] * SC_W8, s[2 * 33] * SC_W8, s[3 * 33] * SC_W8); o.y = pk4_fp8(s[4 * 33] * SC_W8, s[5 * 33] * SC_W8, s[6 * 33] * SC_W8, s[7 * 33] * SC_W8);
        o.z = pk4_fp8(s[8 * 33] * SC_W8, s[9 * 33] * SC_W8, s[10 * 33] * SC_W8, s[11 * 33] * SC_W8); o.w = pk4_fp8(s[12 * 33] * SC_W8, s[13 * 33] * SC_W8, s[14 * 33] * SC_W8, s[15 * 33] * SC_W8);
        *(GAS v4u*)(WT8 + (size_t)(j.dst + n) * j.ldk + j.k0 + 16 * c) = o; }
    LDS_WAIT(); asm volatile("" ::: "memory");
}
__device__ __forceinline__ ConvJob conv_job(const float* W, int K, int N, bf16* WT, int mode, int item, bool f8 = false) {
    const int nblk = N / 32, kb = item / nblk, nb = item - kb * nblk, k0 = 64 * kb, n0 = 32 * nb;
    const int dst = mode == 0 ? n0 : (n0 >> 7) * 256 + (n0 & 127) + (mode == 2 ? 128 : 0);
    return ConvJob{W, N, WT, K, k0, n0, dst, f8};
}
__device__ __forceinline__ ConvJob layer_job(const Args& A, int l, int it) {
    constexpr int I_IN = 16 * 224, I_A = 8 * 32, I_O = 16 * 32, I_G = 16 * 88;
    unsigned char* ws = A.ws; int r = it;
    if (r < I_IN) { const bool gate = (r % 224) >= 128;
        return gate ? conv_job(A.in[2] + (size_t)l * D * NCOL, D, NCOL, (bf16*)(ws + WS_WIN + (size_t)4096 * D), 0, r, true) : conv_job(A.in[2] + (size_t)l * D * NCOL, D, NCOL, (bf16*)(ws + WS_WIN), 0, r); } r -= I_IN;
    if (r < I_A) return conv_job(A.in[4] + (size_t)l * 512 * D, 512, D, (bf16*)(ws + WS_WOABC), 0, r); r -= I_A;
    if (r < I_A) return conv_job(A.in[7] + (size_t)l * 512 * D, 512, D, (bf16*)(ws + WS_WOABC) + 1024 * 512, 0, r); r -= I_A;
    if (r < I_A) return conv_job(A.in[15] + (size_t)l * 512 * D, 512, D, (bf16*)(ws + WS_WOABC) + 2 * 1024 * 512, 0, r); r -= I_A;
    if (r < I_O) return conv_job(A.in[16] + (size_t)l * D * D, D, D, (bf16*)(ws + WS_WO), 0, r); r -= I_O;
    if (r < I_G) return conv_job(A.in[18], D, DFF, (bf16*)(ws + WS_FGU), 1, r); r -= I_G;
    if (r < I_G) return conv_job(A.in[19], D, DFF, (bf16*)(ws + WS_FGU), 2, r); r -= I_G;
    return conv_job(A.in[20], DFF, D, (bf16*)(ws + WS_FDN), 0, r);
}
__device__ __forceinline__ void convert_layer_weights(const Ctx& C, const Args& A, int l) {
    LAS float* scr = (LAS float*)(C.lds + C.wave * 16896);
    const int gw = C.bid * NWAVES + C.wave, NGW = C.G * NWAVES;
    constexpr int I_IN = 16 * 224, I_A = 8 * 32, I_O = 16 * 32, I_G = 16 * 88, I_D = 44 * 32;
    const int nitems = I_IN + 3 * I_A + I_O + (l == 0 ? 2 * I_G + I_D : 0);
    for (int it = gw; it < nitems; it += 2 * NGW) {
        const bool two = it + NGW < nitems;
        const ConvJob j0 = layer_job(A, l, it), j1 = layer_job(A, l, two ? it + NGW : it);
        float t0[32], t1[32];
        conv_load(j0, t0, C.lane); if (two) conv_load(j1, t1, C.lane);
        if (j0.f8) conv_store8(j0, t0, scr, C.lane); else conv_store(j0, t0, scr, C.lane);
        if (two) { if (j1.f8) conv_store8(j1, t1, scr + 64 * 33, C.lane); else conv_store(j1, t1, scr + 64 * 33, C.lane); }
    }
}
__device__ __forceinline__ ConvJob moe_job(const Args& A, int it) {
    constexpr int I_G = 16 * 112, I_D = 56 * 32, PER_E = 2 * I_G + I_D;
    unsigned char* ws = A.ws; const int e = it / PER_E; int r = it - e * PER_E;
    if (r < I_G) return conv_job(A.in[22] + (size_t)e * D * EFF, D, EFF, (bf16*)(ws + WS_MGU + (size_t)e * 7168 * D), 1, r); r -= I_G;
    if (r < I_G) return conv_job(A.in[23] + (size_t)e * D * EFF, D, EFF, (bf16*)(ws + WS_MGU + (size_t)e * 7168 * D), 2, r); r -= I_G;
    return conv_job(A.in[24] + (size_t)e * EFF * D, EFF, D, (bf16*)(ws + WS_MDN + (size_t)e * D * EFF), 0, r);
}
__device__ __forceinline__ void convert_moe_weights(const Ctx& C, const Args& A) {
    LAS float* scr = (LAS float*)(C.lds + C.wave * 16896);
    const int gw = C.bid * NWAVES + C.wave, NGW = C.G * NWAVES;
    constexpr int NIT = NEXP * (2 * 16 * 112 + 56 * 32);
    for (int it = gw; it < NIT; it += 2 * NGW) {
        const bool two = it + NGW < NIT;
        const ConvJob j0 = moe_job(A, it), j1 = moe_job(A, two ? it + NGW : it);
        float t0[32], t1[32];
        conv_load(j0, t0, C.lane); if (two) conv_load(j1, t1, C.lane);
        conv_store8(j0, t0, scr, C.lane); if (two) conv_store8(j1, t1, scr + 64 * 33, C.lane);
    }
}
__device__ __forceinline__ void rope_table(const Ctx& C, unsigned char* ws) {
    const double invf_rev[8] = {0.15915494309189535, 0.03086376340470123, 0.005985185712713705, 0.001160663641240061,
                                0.00022507907903927653, 4.364795279280289e-05, 8.464330808241401e-06, 1.6414262627950345e-06};
    float* ct = (float*)(ws + WS_ROPE); float* st = ct + SEQ * 8;
    for (int g = C.bid * NTHR + C.tid; g < SEQ * 8; g += C.G * NTHR) {
        const int pos = g >> 3, i = g & 7;
        double f = invf_rev[0];
#pragma unroll
        for (int k = 1; k < 8; ++k) f = (i == k) ? invf_rev[k] : f;
        double t = (double)pos * f; t -= floor(t);
        ct[g] = __builtin_amdgcn_cosf((float)t); st[g] = __builtin_amdgcn_sinf((float)t);
    }
}

template <bool ROUTE, bool ALSO8>
__device__ __forceinline__ void norm_rows(const Ctx& C, const float* xin, const float* gain, bf16* XN, const float* router, unsigned char* ws, unsigned char* X8 = nullptr) {
    constexpr int RB = 4;
    const int gw = C.bid * NWAVES + C.wave, NGW = C.G * NWAVES;
    LAS float* R = (LAS float*)C.lds;
    LAS int* rt_tok = (LAS int*)(C.lds + 32768); LAS int* rt_e = rt_tok + 256; LAS float* rt_w = (LAS float*)(rt_e + 256);
    if (ROUTE) { for (int i = C.tid; i < D * NEXP / 4; i += NTHR) ((LAS f32x4*)R)[i] = ((const f32x4*)router)[i];
                 for (int i = C.tid; i < 256; i += NTHR) rt_tok[i] = -1;
                 __syncthreads(); }
    f32x4 g[4];
#pragma unroll
    for (int j = 0; j < 4; ++j) g[j] = ((const f32x4*)gain)[C.lane + 64 * j];
    int slot = C.wave;
    for (int m0 = gw; m0 < M; m0 += RB * NGW) {
        f32x4 v[RB][4];
#pragma unroll
        for (int i = 0; i < RB; ++i) { const int m = m0 + i * NGW; if (m < M) { const GAS f32x4* xr = (const GAS f32x4*)(xin + (size_t)m * D) + C.lane;
#pragma unroll
            for (int j = 0; j < 4; ++j) v[i][j] = xr[64 * j]; } }
#pragma unroll
        for (int i = 0; i < RB; ++i) { const int m = m0 + i * NGW; if (m < M) {
            float s = 0.f;
#pragma unroll
            for (int j = 0; j < 4; ++j) s += (v[i][j].x * v[i][j].x + v[i][j].y * v[i][j].y) + (v[i][j].z * v[i][j].z + v[i][j].w * v[i][j].w);
            const float rstd = 1.0f / sqrtf(wave_sum(s, C.lane) * (1.f / D) + EPS);
            GAS unsigned long long* o8 = (GAS unsigned long long*)(XN + (size_t)m * D) + C.lane;
#pragma unroll
            for (int j = 0; j < 4; ++j) { v[i][j] = v[i][j] * rstd * g[j]; o8[64 * j] = (unsigned long long)pk2(v[i][j].x, v[i][j].y) | ((unsigned long long)pk2(v[i][j].z, v[i][j].w) << 32);
                if (ALSO8) ((unsigned*)(X8 + (size_t)m * D))[C.lane + 64 * j] = pk4_fp8(v[i][j].x * SC_X8, v[i][j].y * SC_X8, v[i][j].z * SC_X8, v[i][j].w * SC_X8); }
            if (ROUTE) {
                float lg[8];
#pragma unroll
                for (int e = 0; e < 8; ++e) lg[e] = 0.f;
#pragma unroll
                for (int j = 0; j < 4; ++j)
#pragma unroll
                    for (int k = 0; k < 4; ++k) { const int d = 4 * C.lane + k + 256 * j; const f32x4 r0 = *(LAS f32x4*)(R + d * 8), r1 = *(LAS f32x4*)(R + d * 8 + 4); const float h = v[i][j][k];
                        lg[0] += h * r0.x; lg[1] += h * r0.y; lg[2] += h * r0.z; lg[3] += h * r0.w; lg[4] += h * r1.x; lg[5] += h * r1.y; lg[6] += h * r1.z; lg[7] += h * r1.w; }
#pragma unroll
                for (int e = 0; e < 8; ++e) lg[e] = wave_sum(lg[e], C.lane);
                float l1 = -INFINITY, l2 = -INFINITY; int e1 = 0, e2 = 0;
#pragma unroll
                for (int e = 0; e < 8; ++e) if (lg[e] > l1) { l1 = lg[e]; e1 = e; }
#pragma unroll
                for (int e = 0; e < 8; ++e) if (e != e1 && lg[e] > l2) { l2 = lg[e]; e2 = e; }
                if (C.lane == 0 && slot < 256) { rt_tok[slot] = m; rt_e[slot] = e1 | (e2 << 8); rt_w[slot] = 1.0f / (1.0f + expf(l2 - l1)); }
                slot += NWAVES;
            } } }
    }
    if (ROUTE) {
        __syncthreads();
        if (C.tid < 16) {
            const int list = C.tid >> 3, e = C.tid & 7; int n = 0;
            for (int sidx = 0; sidx < 256; ++sidx) { const int t = rt_tok[sidx]; const int ee = (rt_e[sidx] >> (8 * list)) & 0xff; n += (t >= 0 && ee == e) ? 1 : 0; }
            gu32* cnt = (gu32*)(ws + WS_CTL) + CW_CNT; int* tokl = (int*)(ws + WS_TOK); float* wl = (float*)(ws + WS_WL);
            unsigned pos = n ? __hip_atomic_fetch_add(cnt + C.tid, (unsigned)n, RLX_AGENT) : 0u;
            for (int sidx = 0; sidx < 256; ++sidx) { const int t = rt_tok[sidx]; const int ee = (rt_e[sidx] >> (8 * list)) & 0xff;
                if (t >= 0 && ee == e) { const float w1 = rt_w[sidx]; tokl[(size_t)C.tid * M + pos] = t; wl[(size_t)C.tid * M + pos] = list == 0 ? w1 : 1.0f - w1; ++pos; } }
        }
        __syncthreads();
    }
}

template <bool ROUTE, bool ALSO8 = false>
__device__ __forceinline__ void norm_rows_b(const Ctx& C, const bf16* xin, const float* gain, bf16* XN, const float* router, unsigned char* ws, unsigned char* X8 = nullptr) {
    constexpr int RB = 4;
    const int gw = C.bid * NWAVES + C.wave, NGW = C.G * NWAVES;
    LAS float* R = (LAS float*)C.lds;
    LAS int* rt_tok = (LAS int*)(C.lds + 32768); LAS int* rt_e = rt_tok + 256; LAS float* rt_w = (LAS float*)(rt_e + 256);
    if (ROUTE) { for (int i = C.tid; i < D * NEXP / 4; i += NTHR) ((LAS f32x4*)R)[i] = ((const f32x4*)router)[i];
                 for (int i = C.tid; i < 256; i += NTHR) rt_tok[i] = -1;
                 __syncthreads(); }
    float g[16];
#pragma unroll
    for (int c = 0; c < 2; ++c) { const f32x4 a = *(const f32x4*)(gain + 512 * c + 8 * C.lane), b = *(const f32x4*)(gain + 512 * c + 8 * C.lane + 4);
        g[8 * c] = a.x; g[8 * c + 1] = a.y; g[8 * c + 2] = a.z; g[8 * c + 3] = a.w; g[8 * c + 4] = b.x; g[8 * c + 5] = b.y; g[8 * c + 6] = b.z; g[8 * c + 7] = b.w; }
    int slot = C.wave;
    for (int m0 = gw; m0 < M; m0 += RB * NGW) {
        v4u raw[RB][2];
#pragma unroll
        for (int i = 0; i < RB; ++i) { const int m = m0 + i * NGW; if (m < M) { const v4u* xr = (const v4u*)(xin + (size_t)m * D) + C.lane; raw[i][0] = xr[0]; raw[i][1] = xr[64]; } }
#pragma unroll
        for (int i = 0; i < RB; ++i) { const int m = m0 + i * NGW; if (m < M) {
            float v[16];
#pragma unroll
            for (int c = 0; c < 2; ++c) { const v4u w = raw[i][c]; v[8 * c] = bflo(w.x); v[8 * c + 1] = bfhi(w.x); v[8 * c + 2] = bflo(w.y); v[8 * c + 3] = bfhi(w.y); v[8 * c + 4] = bflo(w.z); v[8 * c + 5] = bfhi(w.z); v[8 * c + 6] = bflo(w.w); v[8 * c + 7] = bfhi(w.w); }
            float s = 0.f;
#pragma unroll
            for (int k = 0; k < 16; ++k) s += v[k] * v[k];
            const float rstd = 1.0f / sqrtf(wave_sum(s, C.lane) * (1.f / D) + EPS);
#pragma unroll
            for (int k = 0; k < 16; ++k) v[k] = v[k] * rstd * g[k];
            if (ROUTE) {
                v2u* o8 = (v2u*)((unsigned char*)XN + (size_t)m * D) + C.lane;
#pragma unroll
                for (int c = 0; c < 2; ++c) { v2u w; w.x = pk4_fp8(v[8 * c] * SC_X8, v[8 * c + 1] * SC_X8, v[8 * c + 2] * SC_X8, v[8 * c + 3] * SC_X8); w.y = pk4_fp8(v[8 * c + 4] * SC_X8, v[8 * c + 5] * SC_X8, v[8 * c + 6] * SC_X8, v[8 * c + 7] * SC_X8); o8[64 * c] = w; }
            } else {
            v4u* o = (v4u*)(XN + (size_t)m * D) + C.lane;
#pragma unroll
            for (int c = 0; c < 2; ++c) { v4u w; w.x = pk2(v[8 * c], v[8 * c + 1]); w.y = pk2(v[8 * c + 2], v[8 * c + 3]); w.z = pk2(v[8 * c + 4], v[8 * c + 5]); w.w = pk2(v[8 * c + 6], v[8 * c + 7]); o[64 * c] = w; }
            if (ALSO8) { v2u* o8 = (v2u*)(X8 + (size_t)m * D) + C.lane;
#pragma unroll
                for (int c = 0; c < 2; ++c) { v2u w; w.x = pk4_fp8(v[8 * c] * SC_X8, v[8 * c + 1] * SC_X8, v[8 * c + 2] * SC_X8, v[8 * c + 3] * SC_X8); w.y = pk4_fp8(v[8 * c + 4] * SC_X8, v[8 * c + 5] * SC_X8, v[8 * c + 6] * SC_X8, v[8 * c + 7] * SC_X8); o8[64 * c] = w; } }
            }
            if (ROUTE) {
                float lg[8];
#pragma unroll
                for (int e = 0; e < 8; ++e) lg[e] = 0.f;
#pragma unroll
                for (int c = 0; c < 2; ++c)
#pragma unroll
                    for (int k = 0; k < 8; ++k) { const int d = 512 * c + 8 * C.lane + k; const f32x4 r0 = *(LAS f32x4*)(R + d * 8), r1 = *(LAS f32x4*)(R + d * 8 + 4); const float h = v[8 * c + k];
                        lg[0] += h * r0.x; lg[1] += h * r0.y; lg[2] += h * r0.z; lg[3] += h * r0.w; lg[4] += h * r1.x; lg[5] += h * r1.y; lg[6] += h * r1.z; lg[7] += h * r1.w; }
#pragma unroll
                for (int e = 0; e < 8; ++e) lg[e] = wave_sum(lg[e], C.lane);
                float l1 = -INFINITY, l2 = -INFINITY; int e1 = 0, e2 = 0;
#pragma unroll
                for (int e = 0; e < 8; ++e) if (lg[e] > l1) { l1 = lg[e]; e1 = e; }
#pragma unroll
                for (int e = 0; e < 8; ++e) if (e != e1 && lg[e] > l2) { l2 = lg[e]; e2 = e; }
                if (C.lane == 0 && slot < 256) { rt_tok[slot] = m; rt_e[slot] = e1 | (e2 << 8); rt_w[slot] = 1.0f / (1.0f + expf(l2 - l1)); }
                slot += NWAVES;
            } } }
    }
    if (ROUTE) {
        __syncthreads();
        if (C.tid < 16) {
            const int list = C.tid >> 3, e = C.tid & 7; int n = 0;
            for (int sidx = 0; sidx < 256; ++sidx) { const int t = rt_tok[sidx]; const int ee = (rt_e[sidx] >> (8 * list)) & 0xff; n += (t >= 0 && ee == e) ? 1 : 0; }
            gu32* cnt = (gu32*)(ws + WS_CTL) + CW_CNT; int* tokl = (int*)(ws + WS_TOK); float* wl = (float*)(ws + WS_WL);
            unsigned pos = n ? __hip_atomic_fetch_add(cnt + C.tid, (unsigned)n, RLX_AGENT) : 0u;
            for (int sidx = 0; sidx < 256; ++sidx) { const int t = rt_tok[sidx]; const int ee = (rt_e[sidx] >> (8 * list)) & 0xff;
                if (t >= 0 && ee == e) { const float w1 = rt_w[sidx]; tokl[(size_t)C.tid * M + pos] = t; wl[(size_t)C.tid * M + pos] = list == 0 ? w1 : 1.0f - w1; ++pos; } }
        }
        __syncthreads();
    }
}

__device__ __forceinline__ void qk_item(const Ctx& C, const Args& A, int l, int item) {
    unsigned char* ws = A.ws; bf16* P = (bf16*)(ws + WS_P);
    const float* ct = (const float*)(ws + WS_ROPE); const float* st = ct + SEQ * 8;
    const int rb = item >> 3, h = item & 7, ch = C.tid & 7, rg = C.tid >> 3;
    LAS float* part = (LAS float*)C.lds;
    for (int which = 0; which < 2; ++which) {
        const float* gn = A.in[which == 0 ? 5 : 6] + l * HD + ch * 8;
        const f32x4 ga = *(const f32x4*)gn, gb = *(const f32x4*)(gn + 4);
        const float gv[8] = {ga.x, ga.y, ga.z, ga.w, gb.x, gb.y, gb.z, gb.w};
        float ks[8];
#pragma unroll
        for (int j = 0; j < 8; ++j) ks[j] = 0.f;
        v4u wv[4]; f32x4 c0[4], c1[4], s0[4], s1[4];
#pragma unroll
        for (int pass = 0; pass < 4; ++pass) { const int row = rb * 256 + pass * 64 + rg, pos = row & (SEQ - 1);
            wv[pass] = *(const v4u*)(P + (size_t)row * NCOL + (which == 0 ? C_Q : C_K) + h * HD + ch * 8);
            c0[pass] = *(const f32x4*)(ct + pos * 8); c1[pass] = *(const f32x4*)(ct + pos * 8 + 4); s0[pass] = *(const f32x4*)(st + pos * 8); s1[pass] = *(const f32x4*)(st + pos * 8 + 4); }
#pragma unroll
        for (int pass = 0; pass < 4; ++pass) {
            const int row = rb * 256 + pass * 64 + rg;
            bf16* p = P + (size_t)row * NCOL + (which == 0 ? C_Q : C_K) + h * HD + ch * 8;
            const v4u w = wv[pass];
            float v[8] = {bflo(w.x), bfhi(w.x), bflo(w.y), bfhi(w.y), bflo(w.z), bfhi(w.z), bflo(w.w), bfhi(w.w)};
            const float cs8[8] = {c0[pass].x, c0[pass].y, c0[pass].z, c0[pass].w, c1[pass].x, c1[pass].y, c1[pass].z, c1[pass].w};
            const float sn8[8] = {s0[pass].x, s0[pass].y, s0[pass].z, s0[pass].w, s1[pass].x, s1[pass].y, s1[pass].z, s1[pass].w};
            float ss = 0.f;
#pragma unroll
            for (int j = 0; j < 8; ++j) ss += v[j] * v[j];
            ss += shx(ss, 1, C.lane); ss += shx(ss, 2, C.lane); ss += shx(ss, 4, C.lane);
            const float rstd = 1.0f / sqrtf(ss * (1.f / HD) + EPS);
#pragma unroll
            for (int j = 0; j < 8; ++j) v[j] = v[j] * rstd * gv[j];
#pragma unroll
            for (int j = 0; j < 8; ++j) {
                const float other = shx(v[j], 1, C.lane);
                const float rot = (ch == 0) ? (v[j] * cs8[j] - other * sn8[j]) : (v[j] * cs8[j] + other * sn8[j]);
                v[j] = (ch < 2) ? rot : v[j];
            }
            if (which == 0) {
#pragma unroll
                for (int j = 0; j < 8; ++j) v[j] *= QSCALE;
            } else {
#pragma unroll
                for (int j = 0; j < 8; ++j) ks[j] += v[j];
            }
            v4u o; o.x = pk2(v[0], v[1]); o.y = pk2(v[2], v[3]); o.z = pk2(v[4], v[5]); o.w = pk2(v[6], v[7]);
            *(v4u*)p = o;
        }
        if (which == 1) {
#pragma unroll
            for (int j = 0; j < 8; ++j) part[rg * 64 + ch * 8 + j] = ks[j];
            __syncthreads();
            if (C.tid < 64) { float s = 0.f;
#pragma unroll 16
                for (int r = 0; r < 64; ++r) s += part[r * 64 + C.tid];
                const int b = rb >> 4, blk = rb & 15;
                ((float*)(ws + WS_KMEAN))[(size_t)((b * NH + h) * NBLK + blk) * HD + C.tid] = s * (1.f / 256.f); }
            __syncthreads();
        }
    }
}
__device__ __forceinline__ void conva_tasks(const Ctx& C, const Args& A, int l) {
    bf16* P = (bf16*)(A.ws + WS_P); const float* cw = A.in[3] + l * 3 * 512;
    const int stride = C.G * NTHR;
    for (int g0 = C.bid * NTHR + C.tid; g0 < M * 64; g0 += 4 * stride) {
        v4u xa[4][3], ca[4][3], ba[4];
#pragma unroll
        for (int i = 0; i < 4; ++i) { const int g = g0 + i * stride; if (g < M * 64) { const int row = g >> 6, c = (g & 63) * 8, t = row & (SEQ - 1);
            const bf16* base = P + (size_t)row * NCOL + c;
#pragma unroll
            for (int k = 0; k < 3; ++k) { const int dt = 2 - k; if (t >= dt) { xa[i][k] = *(const v4u*)(base - (size_t)dt * NCOL + C_XA); ca[i][k] = *(const v4u*)(base - (size_t)dt * NCOL + C_CA); } else { xa[i][k] = (v4u){0u, 0u, 0u, 0u}; ca[i][k] = xa[i][k]; } }
            ba[i] = *(const v4u*)(base + C_BA); } }
#pragma unroll
        for (int i = 0; i < 4; ++i) { const int g = g0 + i * stride; if (g < M * 64) { const int row = g >> 6, c = (g & 63) * 8;
            float acc[8];
#pragma unroll
            for (int j = 0; j < 8; ++j) acc[j] = 0.f;
#pragma unroll
            for (int k = 0; k < 3; ++k) {
                const v4u x = xa[i][k], cc = ca[i][k];
                const f32x4 w0 = *(const f32x4*)(cw + k * 512 + c), w1 = *(const f32x4*)(cw + k * 512 + c + 4);
                acc[0] += w0.x * (bflo(x.x) * bflo(cc.x)); acc[1] += w0.y * (bfhi(x.x) * bfhi(cc.x)); acc[2] += w0.z * (bflo(x.y) * bflo(cc.y)); acc[3] += w0.w * (bfhi(x.y) * bfhi(cc.y));
                acc[4] += w1.x * (bflo(x.z) * bflo(cc.z)); acc[5] += w1.y * (bfhi(x.z) * bfhi(cc.z)); acc[6] += w1.z * (bflo(x.w) * bflo(cc.w)); acc[7] += w1.w * (bfhi(x.w) * bfhi(cc.w));
            }
            const v4u b = ba[i];
            v4u o; o.x = pk2(bflo(b.x) * acc[0], bfhi(b.x) * acc[1]); o.y = pk2(bflo(b.y) * acc[2], bfhi(b.y) * acc[3]);
            o.z = pk2(bflo(b.z) * acc[4], bfhi(b.z) * acc[5]); o.w = pk2(bflo(b.w) * acc[6], bfhi(b.w) * acc[7]);
            *(v4u*)(P + (size_t)row * NCOL + c + C_BA) = o; } }
    }
}
__device__ __forceinline__ void lru_pass1_phase(const Ctx& C, const Args& A, int l) {
    typedef pg8::bf16x8 bx8;
    unsigned char* ws = A.ws; const bf16* P = (const bf16*)(ws + WS_P);
    bf16* LA = (bf16*)A.out + (size_t)M * D; bf16* UU = LA + (size_t)M * 512;
    const int hb = C.wave, lane = C.lane, fr = lane & 15, fq = lane >> 4, c = hb * 64 + lane;
    bx8 wR[2][4], wI[2][4]; float bR[4], bI[4];
    { const float* wrp = A.in[10] + (size_t)l * 32768 + hb * 4096; const float* wip = A.in[12] + (size_t)l * 32768 + hb * 4096;
#pragma unroll
      for (int ks = 0; ks < 2; ++ks)
#pragma unroll
        for (int ct = 0; ct < 4; ++ct) { const int k0 = 32 * ks + 8 * fq, col = 16 * ct + fr; v4u a, b2;
            a.x = pk2(wrp[(k0 + 0) * 64 + col], wrp[(k0 + 1) * 64 + col]); a.y = pk2(wrp[(k0 + 2) * 64 + col], wrp[(k0 + 3) * 64 + col]);
            a.z = pk2(wrp[(k0 + 4) * 64 + col], wrp[(k0 + 5) * 64 + col]); a.w = pk2(wrp[(k0 + 6) * 64 + col], wrp[(k0 + 7) * 64 + col]);
            b2.x = pk2(wip[(k0 + 0) * 64 + col], wip[(k0 + 1) * 64 + col]); b2.y = pk2(wip[(k0 + 2) * 64 + col], wip[(k0 + 3) * 64 + col]);
            b2.z = pk2(wip[(k0 + 4) * 64 + col], wip[(k0 + 5) * 64 + col]); b2.w = pk2(wip[(k0 + 6) * 64 + col], wip[(k0 + 7) * 64 + col]);
            wR[ks][ct] = __builtin_bit_cast(bx8, a); wI[ks][ct] = __builtin_bit_cast(bx8, b2); }
#pragma unroll
      for (int ct = 0; ct < 4; ++ct) { bR[ct] = A.in[11][l * 512 + hb * 64 + 16 * ct + fr]; bI[ct] = A.in[13][l * 512 + hb * 64 + 16 * ct + fr]; } }
    const float lam = A.in[14][l * 512 + c];
    const float sp = log1pf(expf(-lam));
    const float* cw = A.in[8] + l * 4 * 512 + c; const float w0 = cw[0], w1 = cw[512], w2 = cw[1024], w3 = cw[1536], bc = A.in[9][l * 512 + c];
    LAS unsigned char* wl = C.lds + hb * 13312;
    LAS unsigned short* Xs = (LAS unsigned short*)wl; LAS unsigned* Gs = (LAS unsigned*)(wl + 4608);
    for (int item = C.bid; item < BATCH * NCH; item += C.G) {
        const int b = item >> 6, ci = item & 63;
        const size_t row0 = (size_t)b * SEQ + ci * LCH;
        const bf16* xcp = P + row0 * NCOL + C_XC + c;
        float x3 = 0.f, x2 = 0.f, x1 = 0.f;
        if (ci > 0) { x3 = bf2f(*(xcp - 3 * (size_t)NCOL)); x2 = bf2f(*(xcp - 2 * (size_t)NCOL)); x1 = bf2f(*(xcp - (size_t)NCOL)); }
        float Ap = 1.f, h = 0.f;
#pragma unroll 1
        for (int sub = 0; sub < 2; ++sub) {
            { bf16 xin[32];
#pragma unroll
              for (int r = 0; r < 32; ++r) xin[r] = xcp[(size_t)(sub * 32 + r) * NCOL];
#pragma unroll
              for (int r = 0; r < 32; ++r) { const float x0 = bf2f(xin[r]); const float xv = w0 * x3 + w1 * x2 + w2 * x1 + w3 * x0 + bc; x3 = x2; x2 = x1; x1 = x0; Xs[r * 72 + lane] = f2bf(xv); } }
            LDS_WAIT();
            pg8::f32x4 aR[2][4], aI[2][4];
#pragma unroll
            for (int rt = 0; rt < 2; ++rt)
#pragma unroll
                for (int ct = 0; ct < 4; ++ct) { aR[rt][ct] = (pg8::f32x4){0.f, 0.f, 0.f, 0.f}; aI[rt][ct] = (pg8::f32x4){0.f, 0.f, 0.f, 0.f}; }
#pragma unroll
            for (int rt = 0; rt < 2; ++rt)
#pragma unroll
                for (int ks = 0; ks < 2; ++ks) { const bx8 af = *(const LAS bx8*)(wl + (16 * rt + fr) * 144 + (32 * ks + 8 * fq) * 2);
#pragma unroll
                    for (int ct = 0; ct < 4; ++ct) { aR[rt][ct] = __builtin_amdgcn_mfma_f32_16x16x32_bf16(af, wR[ks][ct], aR[rt][ct], 0, 0, 0); aI[rt][ct] = __builtin_amdgcn_mfma_f32_16x16x32_bf16(af, wI[ks][ct], aI[rt][ct], 0, 0, 0); } }
#pragma unroll
            for (int rt = 0; rt < 2; ++rt)
#pragma unroll
                for (int ct = 0; ct < 4; ++ct)
#pragma unroll
                    for (int jj = 0; jj < 4; ++jj) Gs[(16 * rt + 4 * fq + jj) * 68 + 16 * ct + fr] = pk2(sigmoidf_(aR[rt][ct][jj] + bR[ct]), sigmoidf_(aI[rt][ct][jj] + bI[ct]));
            LDS_WAIT();
#pragma unroll 4
            for (int r = 0; r < 32; ++r) {
                const unsigned g = Gs[r * 68 + lane]; const float xv = bf2f(Xs[r * 72 + lane]);
                const float la = bfround(-8.0f * bflo(g) * sp), a = __expf(la), x2l = 2.0f * la;
                const float em = (x2l > -0.25f) ? -(x2l * (1.f + x2l * (0.5f + x2l * (0.16666667f + x2l * (0.041666668f + x2l * (0.0083333338f + x2l * 0.0013888889f)))))) : (1.0f - __expf(x2l));
                const float u = bfround(sqrtf(em) * (bfhi(g) * xv));
                Ap *= a; h = a * h + u;
                Gs[r * 68 + lane] = pk2(la, u);
            }
            LDS_WAIT();
#pragma unroll
            for (int q = 0; q < 4; ++q) { const int rr = (lane >> 3) + 8 * q, ch = lane & 7;
                const v4u w0 = *(const LAS v4u*)(Gs + rr * 68 + ch * 8), w1 = *(const LAS v4u*)(Gs + rr * 68 + ch * 8 + 4);
                v4u lo, hi;
                lo.x = (w0.x & 0xffffu) | (w0.y << 16); lo.y = (w0.z & 0xffffu) | (w0.w << 16); lo.z = (w1.x & 0xffffu) | (w1.y << 16); lo.w = (w1.z & 0xffffu) | (w1.w << 16);
                hi.x = (w0.x >> 16) | (w0.y & 0xffff0000u); hi.y = (w0.z >> 16) | (w0.w & 0xffff0000u); hi.z = (w1.x >> 16) | (w1.y & 0xffff0000u); hi.w = (w1.z >> 16) | (w1.w & 0xffff0000u);
                const size_t o = (row0 + sub * 32 + rr) * 512 + hb * 64 + ch * 8;
                *(v4u*)(LA + o) = lo; *(v4u*)(UU + o) = hi; }
            LDS_WAIT();
        }
        ((f32x2*)(ws + WS_SUM))[(size_t)(b * NCH + ci) * 512 + c] = (f32x2){Ap, h};
    }
}
__device__ __forceinline__ void lru_pass2_item(const Ctx& C, const Args& A, int item) {
    unsigned char* ws = A.ws; bf16* P = (bf16*)(ws + WS_P);
    const bf16* LA = (const bf16*)A.out + (size_t)M * D; const bf16* UU = LA + (size_t)M * 512;
    const int b = item >> 6, ci = item & 63, w = C.wave, lane = C.lane, c8 = lane * 8;
    LAS f32x4* comp = (LAS f32x4*)C.lds;
    LAS f32x4* loc = comp + 8 * 64 * 4;
    const size_t row0 = (size_t)b * SEQ + ci * LCH + w * 8;
    v4u la4[8], u4[8];
#pragma unroll
    for (int r = 0; r < 8; ++r) { la4[r] = *(const v4u*)(LA + (row0 + r) * 512 + c8); u4[r] = *(const v4u*)(UU + (row0 + r) * 512 + c8); }
    float fa[8], fh[8];
#pragma unroll
    for (int k = 0; k < 8; ++k) { fa[k] = 1.f; fh[k] = 0.f; }
    { const int clo = (ci * w) >> 3, chi = (ci * (w + 1)) >> 3;
      const f32x4* sm = (const f32x4*)(ws + WS_SUM) + ((size_t)(b * NCH) * 512 + c8) / 2;
      for (int cc = clo; cc < chi; ++cc) { const f32x4* s = sm + (size_t)cc * 256;
#pragma unroll
        for (int q = 0; q < 4; ++q) { const f32x4 v = s[q]; fh[2 * q] = v.x * fh[2 * q] + v.y; fa[2 * q] *= v.x; fh[2 * q + 1] = v.z * fh[2 * q + 1] + v.w; fa[2 * q + 1] *= v.z; } } }
#pragma unroll
    for (int q = 0; q < 4; ++q) comp[(w * 64 + lane) * 4 + q] = (f32x4){fa[2 * q], fh[2 * q], fa[2 * q + 1], fh[2 * q + 1]};
    float ta[8], th[8];
#pragma unroll
    for (int k = 0; k < 8; ++k) { ta[k] = 1.f; th[k] = 0.f; }
#pragma unroll
    for (int r = 0; r < 8; ++r) { const v4u lw = la4[r], uw = u4[r];
        const float l8[8] = {bflo(lw.x), bfhi(lw.x), bflo(lw.y), bfhi(lw.y), bflo(lw.z), bfhi(lw.z), bflo(lw.w), bfhi(lw.w)};
        const float u8[8] = {bflo(uw.x), bfhi(uw.x), bflo(uw.y), bfhi(uw.y), bflo(uw.z), bfhi(uw.z), bflo(uw.w), bfhi(uw.w)};
#pragma unroll
        for (int k = 0; k < 8; ++k) { const float a = __expf(l8[k]); ta[k] *= a; th[k] = a * th[k] + u8[k]; } }
#pragma unroll
    for (int q = 0; q < 4; ++q) loc[(w * 64 + lane) * 4 + q] = (f32x4){ta[2 * q], th[2 * q], ta[2 * q + 1], th[2 * q + 1]};
    __syncthreads();
#pragma unroll
    for (int r = 0; r < 8; ++r) asm volatile("" : "+v"(la4[r]), "+v"(u4[r]));
    v4u g4[8];
#pragma unroll
    for (int r = 0; r < 8; ++r) g4[r] = *(const v4u*)(P + (row0 + r) * NCOL + C_GC + c8);
    float h[8];
#pragma unroll
    for (int k = 0; k < 8; ++k) h[k] = 0.f;
#pragma unroll
    for (int ww = 0; ww < 8; ++ww)
#pragma unroll
        for (int q = 0; q < 4; ++q) { const f32x4 v = comp[(ww * 64 + lane) * 4 + q]; h[2 * q] = v.x * h[2 * q] + v.y; h[2 * q + 1] = v.z * h[2 * q + 1] + v.w; }
    for (int ww = 0; ww < w; ++ww)
#pragma unroll
        for (int q = 0; q < 4; ++q) { const f32x4 v = loc[(ww * 64 + lane) * 4 + q]; h[2 * q] = v.x * h[2 * q] + v.y; h[2 * q + 1] = v.z * h[2 * q + 1] + v.w; }
#pragma unroll
    for (int r = 0; r < 8; ++r) { const v4u lw = la4[r], uw = u4[r], gw = g4[r];
        const float l8[8] = {bflo(lw.x), bfhi(lw.x), bflo(lw.y), bfhi(lw.y), bflo(lw.z), bfhi(lw.z), bflo(lw.w), bfhi(lw.w)};
        const float u8[8] = {bflo(uw.x), bfhi(uw.x), bflo(uw.y), bfhi(uw.y), bflo(uw.z), bfhi(uw.z), bflo(uw.w), bfhi(uw.w)};
        const float g8[8] = {bflo(gw.x), bfhi(gw.x), bflo(gw.y), bfhi(gw.y), bflo(gw.z), bfhi(gw.z), bflo(gw.w), bfhi(gw.w)};
        float y[8];
#pragma unroll
        for (int k = 0; k < 8; ++k) { h[k] = __expf(l8[k]) * h[k] + u8[k]; const float x = g8[k]; y[k] = x * rcp_(1.0f + __expf(-1.5957691216f * (x + 0.044715f * x * x * x))) * h[k]; }
        v4u o; o.x = pk2(y[0], y[1]); o.y = pk2(y[2], y[3]); o.z = pk2(y[4], y[5]); o.w = pk2(y[6], y[7]);
        *(v4u*)(P + (row0 + r) * NCOL + C_GC + c8) = o; }
    __syncthreads();
}

struct PlainSched {
    pg8::TileOrder T; const char* A; const char* B; size_t tA, tB;
    __device__ __forceinline__ bool next(int i, pg8::Unit& u) const { int pm, pn; if (!T.map((long)i * T.G + T.c, pm, pn)) return false;
        u.pm = pm; u.pn = pn; u.a = A + (size_t)pm * tA; u.b = B + (size_t)pn * tB; u.x = 0; return true; }
    __device__ __forceinline__ void a_ready(const pg8::Unit&) const {}
    __device__ __forceinline__ void done(const pg8::Unit&) const {}
};
struct MergeSched {
    pg8::TileOrder T; const char* P; const char* W;
    __device__ __forceinline__ bool next(int i, pg8::Unit& u) const { const int ti = i / 3, br = i - 3 * ti; int pm, pn; if (!T.map((long)ti * T.G + T.c, pm, pn)) return false;
        const int colA = br == 0 ? C_BA : (br == 1 ? C_Q : C_GC);
        u.pm = pm; u.pn = pn; u.a = P + ((size_t)pm * 256 * NCOL + colA) * 2; u.b = W + ((size_t)br * 1024 * 512 + (size_t)pn * 256 * 512) * 2; u.x = br; return true; }
    __device__ __forceinline__ void a_ready(const pg8::Unit&) const {}
    __device__ __forceinline__ void done(const pg8::Unit&) const {}
};
struct MoeTiles {
    int nt[8]; int ntiles;
    __device__ __forceinline__ void init(const unsigned* cnt) { ntiles = 0;
#pragma unroll
        for (int e = 0; e < 8; ++e) { nt[e] = (int)((cnt[e] + 255u) >> 8); ntiles += nt[e]; } }
    __device__ __forceinline__ void locate(int pm, int& e, int& base) const { e = 0; base = 0; int cum = 0;
#pragma unroll
        for (int k = 0; k < 7; ++k) { cum += nt[k]; if (pm >= cum) { e = k + 1; base = cum; } } }
};
struct MoeSched {
    pg8::TileOrder T0, T1; const unsigned* cnt; int l0, first0, l1, first1;
    const char* A; size_t tA; const char* W; size_t eStride, tB; int skipE, skipR;
    __device__ __forceinline__ void init(const unsigned* cnt_, int nN, int G, int c, int l0_, int f0, int n0, int l1_, int f1, int n1) {
        cnt = cnt_; l0 = l0_; first0 = f0; l1 = l1_; first1 = f1; T0.init(n0, nN, G, c); T1.init(n1, nN, G, c); skipE = 0; skipR = 0; }
    __device__ __forceinline__ int nunits() const { return T0.nwg + T1.nwg; }
    __device__ __forceinline__ bool next(int i, pg8::Unit& u) const { int pm, pn, list;
        const int G = T0.G, c = T0.c, ge = G - skipE;
        const long L = (c < skipE) ? (long)skipR * ge + (long)i * G + c : (i < skipR ? (long)i * ge + (c - skipE) : (long)skipR * ge + (long)(i - skipR) * G + c);
        if (L < T0.nwg) { T0.map(L, pm, pn); pm += first0; list = l0; } else { if (!T1.map(L - T0.nwg, pm, pn)) return false; pm += first1; list = l1; }
        MoeTiles mt; mt.init(cnt + 8 * list); int e, base; mt.locate(pm, e, base);
        u.pm = list * MOE_TILES + pm; u.pn = pn; u.a = A + (size_t)u.pm * tA; u.b = W + (size_t)e * eStride + (size_t)pn * tB; u.x = e; return true; }
    __device__ __forceinline__ void a_ready(const pg8::Unit&) const {}
    __device__ __forceinline__ void done(const pg8::Unit&) const {}
};

struct EpiMerge {
    static constexpr bool PERM = true, AFTER_DRAIN = false, CHAIN = true;
    bf16* MG; const bf16* P;
    __device__ __forceinline__ void operator()(const pg8::f32x4 (&)[2][2][4][2], const pg8::Unit&, int, int, int, int) const {}
    __device__ __forceinline__ bool chain(pg8::f32x4 (&acc)[2][2][4][2], const pg8::Unit& u, int wr, int wc, int fr, int fq) const {
        const int br = u.x, row0 = u.pm * 256 + wr * 64 + fr, col0 = u.pn * 256 + wc * 32 + 8 * fq;
#pragma unroll
        for (int ai = 0; ai < 2; ++ai) {
            v4u gn[4][2], gd[4][2];
#pragma unroll
            for (int m = 0; m < 4; ++m)
#pragma unroll
                for (int bj = 0; bj < 2; ++bj) { const size_t row = (size_t)(row0 + ai * 128 + m * 16); const int col = col0 + bj * 128;
                    gn[m][bj] = *(const v4u*)(P + row * NCOL + C_G + br * 1024 + col);
                    gd[m][bj] = (br < 2) ? *(const v4u*)(P + row * NCOL + C_G + (br + 1) * 1024 + col) : (v4u){0u, 0u, 0u, 0u}; }
#pragma unroll
            for (int m = 0; m < 4; ++m)
#pragma unroll
                for (int bj = 0; bj < 2; ++bj) { const size_t row = (size_t)(row0 + ai * 128 + m * 16); const int col = col0 + bj * 128;
                    const v4u a = gn[m][bj], d = gd[m][bj];
                    const float an[8] = {bflo(a.x), bfhi(a.x), bflo(a.y), bfhi(a.y), bflo(a.z), bfhi(a.z), bflo(a.w), bfhi(a.w)};
                    const float dn[8] = {bflo(d.x), bfhi(d.x), bflo(d.y), bfhi(d.y), bflo(d.z), bfhi(d.z), bflo(d.w), bfhi(d.w)};
                    float f[8];
#pragma unroll
                    for (int k = 0; k < 8; ++k) f[k] = (br < 2) ? an[k] * rcp_(fmaxf(dn[k], 1e-30f)) : an[k];
                    pg8::f32x4& v0 = acc[ai][bj][m][0]; pg8::f32x4& v1 = acc[ai][bj][m][1];
                    v0[0] *= f[0]; v0[1] *= f[1]; v0[2] *= f[2]; v0[3] *= f[3]; v1[0] *= f[4]; v1[1] *= f[5]; v1[2] *= f[6]; v1[3] *= f[7];
                    if (br == 2) { v4u w; w.x = pk2(v0[0], v0[1]); w.y = pk2(v0[2], v0[3]); w.z = pk2(v1[0], v1[1]); w.w = pk2(v1[2], v1[3]); *(v4u*)(MG + row * D + col) = w; } }
            asm volatile("" ::: "memory");
        }
        return br < 2;
    }
};
template <bool BASE_F32>
struct EpiRes {
    static constexpr bool PERM = true, AFTER_DRAIN = false, CHAIN = false;
    const void* base; bf16* out;
    __device__ __forceinline__ void operator()(const pg8::f32x4 (&acc)[2][2][4][2], const pg8::Unit& u, int wr, int wc, int fr, int fq) const {
        const int row0 = u.pm * 256 + wr * 64 + fr, col0 = u.pn * 256 + wc * 32 + 8 * fq;
#pragma unroll
        for (int ai = 0; ai < 2; ++ai) {
            f32x4 b0[4][2], b1[4][2];
#pragma unroll
            for (int m = 0; m < 4; ++m)
#pragma unroll
                for (int bj = 0; bj < 2; ++bj) { const size_t off = (size_t)(row0 + ai * 128 + m * 16) * D + col0 + bj * 128;
                    if (BASE_F32) { b0[m][bj] = *(const f32x4*)((const float*)base + off); b1[m][bj] = *(const f32x4*)((const float*)base + off + 4); }
                    else { const v4u w = *(const v4u*)((const bf16*)base + off); b0[m][bj] = (f32x4){bflo(w.x), bfhi(w.x), bflo(w.y), bfhi(w.y)}; b1[m][bj] = (f32x4){bflo(w.z), bfhi(w.z), bflo(w.w), bfhi(w.w)}; } }
#pragma unroll
            for (int m = 0; m < 4; ++m)
#pragma unroll
                for (int bj = 0; bj < 2; ++bj) { const size_t off = (size_t)(row0 + ai * 128 + m * 16) * D + col0 + bj * 128;
                    const f32x4 r0 = b0[m][bj] + acc[ai][bj][m][0], r1 = b1[m][bj] + acc[ai][bj][m][1];
                    v4u w; w.x = pk2(r0[0], r0[1]); w.y = pk2(r0[2], r0[3]); w.z = pk2(r1[0], r1[1]); w.w = pk2(r1[2], r1[3]);
                    *(v4u*)(out + off) = w; }
            asm volatile("" ::: "memory");
        }
    }
};
struct EpiSwiGLU {
    static constexpr bool PERM = true, AFTER_DRAIN = false, CHAIN = false;
    bf16* H; int ldc;
    __device__ __forceinline__ void operator()(const pg8::f32x4 (&acc)[2][2][4][2], const pg8::Unit& u, int wr, int wc, int fr, int fq) const {
        const int row0 = u.pm * 256 + wr * 64 + fr, col0 = u.pn * 128 + wc * 32 + 8 * fq;
#pragma unroll
        for (int ai = 0; ai < 2; ++ai)
#pragma unroll
            for (int m = 0; m < 4; ++m) { const f32x4 g0 = acc[ai][0][m][0], g1 = acc[ai][0][m][1], u0 = acc[ai][1][m][0], u1 = acc[ai][1][m][1];
                v4u w; w.x = pk2(g0[0] * sigmoidf_(g0[0]) * u0[0], g0[1] * sigmoidf_(g0[1]) * u0[1]); w.y = pk2(g0[2] * sigmoidf_(g0[2]) * u0[2], g0[3] * sigmoidf_(g0[3]) * u0[3]);
                w.z = pk2(g1[0] * sigmoidf_(g1[0]) * u1[0], g1[1] * sigmoidf_(g1[1]) * u1[1]); w.w = pk2(g1[2] * sigmoidf_(g1[2]) * u1[2], g1[3] * sigmoidf_(g1[3]) * u1[3]);
                *(v4u*)(H + (size_t)(row0 + ai * 128 + m * 16) * ldc + col0) = w; }
    }
};
struct EpiSwiGLU8 {
    static constexpr bool PERM = true, AFTER_DRAIN = false, CHAIN = false;
    unsigned char* H; int ldc;
    __device__ __forceinline__ void operator()(const pg8::f32x4 (&acc)[2][2][4][2], const pg8::Unit& u, int wr, int wc, int fr, int fq) const {
        const int row0 = u.pm * 256 + wr * 64 + fr, colw = u.pn * 128 + wc * 32; constexpr float ds = 1.0f / (SC_X8 * SC_W8);
        const bool odd = (fq & 1) != 0;
        unsigned char* p = H + (size_t)(row0 + (odd ? 16 : 0)) * ldc + colw + 8 * (fq & ~1);
#pragma unroll
        for (int ai = 0; ai < 2; ++ai)
#pragma unroll
            for (int mp = 0; mp < 2; ++mp) {
                v2u x[2];
#pragma unroll
                for (int h = 0; h < 2; ++h) { const int m = 2 * mp + h;
                    const f32x4 g0 = acc[ai][0][m][0] * ds, g1 = acc[ai][0][m][1] * ds, u0 = acc[ai][1][m][0] * (ds * SC_H8), u1 = acc[ai][1][m][1] * (ds * SC_H8);
                    x[h].x = pk4_fp8(g0[0] * sigmoidf_(g0[0]) * u0[0], g0[1] * sigmoidf_(g0[1]) * u0[1], g0[2] * sigmoidf_(g0[2]) * u0[2], g0[3] * sigmoidf_(g0[3]) * u0[3]);
                    x[h].y = pk4_fp8(g1[0] * sigmoidf_(g1[0]) * u1[0], g1[1] * sigmoidf_(g1[1]) * u1[1], g1[2] * sigmoidf_(g1[2]) * u1[2], g1[3] * sigmoidf_(g1[3]) * u1[3]); }
                const auto sx = __builtin_amdgcn_permlane16_swap(x[0].x, x[1].x, false, false), sy = __builtin_amdgcn_permlane16_swap(x[0].y, x[1].y, false, false);
                v4u w; w.x = sx[0]; w.y = sy[0]; w.z = sx[1]; w.w = sy[1];
                *(v4u*)(p + (size_t)(ai * 128 + mp * 32) * ldc) = w; }
    }
};
template <bool OUT_F32, bool SIDE>
struct EpiScatter {
    static constexpr bool PERM = true, AFTER_DRAIN = false, CHAIN = false;
    const int* rowtok; const float* roww; const bf16* XB; void* out; float ds; float* side;
    __device__ __forceinline__ void operator()(const pg8::f32x4 (&acc)[2][2][4][2], const pg8::Unit& u, int wr, int wc, int fr, int fq) const {
        const int row0 = u.pm * 256 + wr * 64 + fr, col0 = u.pn * 256 + wc * 32 + 8 * fq;
        const bool sd = SIDE && u.pm >= MOE_TILES;
#pragma unroll
        for (int ai = 0; ai < 2; ++ai) {
            int tok[4]; float w[4]; v4u bw[4][2];
#pragma unroll
            for (int m = 0; m < 4; ++m) { const int gr = row0 + ai * 128 + m * 16; tok[m] = rowtok[gr]; w[m] = roww[gr] * ds; }
#pragma unroll
            for (int m = 0; m < 4; ++m)
#pragma unroll
                for (int bj = 0; bj < 2; ++bj) bw[m][bj] = (tok[m] >= 0 && !sd) ? *(const v4u*)(XB + (size_t)tok[m] * D + col0 + bj * 128) : (v4u){0u, 0u, 0u, 0u};
#pragma unroll
            for (int m = 0; m < 4; ++m) if (tok[m] >= 0) {
#pragma unroll
                for (int bj = 0; bj < 2; ++bj) { const size_t off = (size_t)tok[m] * D + col0 + bj * 128; const v4u b = bw[m][bj];
                    const f32x4 r0 = (f32x4){bflo(b.x), bfhi(b.x), bflo(b.y), bfhi(b.y)} + acc[ai][bj][m][0] * w[m], r1 = (f32x4){bflo(b.z), bfhi(b.z), bflo(b.w), bfhi(b.w)} + acc[ai][bj][m][1] * w[m];
                    if (OUT_F32) { *(f32x4*)((float*)out + off) = r0; *(f32x4*)((float*)out + off + 4) = r1; }
                    else if (sd) { *(f32x4*)(side + off) = r0; *(f32x4*)(side + off + 4) = r1; }
                    else { v4u o; o.x = pk2(r0[0], r0[1]); o.y = pk2(r0[2], r0[3]); o.z = pk2(r1[0], r1[1]); o.w = pk2(r1[2], r1[3]); *(v4u*)((bf16*)out + off) = o; } } }
            asm volatile("" ::: "memory");
        }
    }
};
__device__ __forceinline__ void moe_side_combine(const Ctx& C, const unsigned char* ws, const bf16* XB, float* out, int row_lo, int row_hi) {
    const int* rowtok = (const int*)(ws + WS_ROWTOK);
    const int gw = C.bid * NWAVES + C.wave, NGW = C.G * NWAVES;
    for (int r = row_lo + gw; r < row_hi; r += NGW) { const int tok = rowtok[r];
        if (tok >= 0) { const size_t off = (size_t)tok * D + 16 * C.lane;
            const v4u b0 = *(const v4u*)(XB + off), b1 = *(const v4u*)(XB + off + 8);
            f32x4 o0 = *(const f32x4*)(out + off), o1 = *(const f32x4*)(out + off + 4), o2 = *(const f32x4*)(out + off + 8), o3 = *(const f32x4*)(out + off + 12);
            o0 += (f32x4){bflo(b0.x), bfhi(b0.x), bflo(b0.y), bfhi(b0.y)}; o1 += (f32x4){bflo(b0.z), bfhi(b0.z), bflo(b0.w), bfhi(b0.w)};
            o2 += (f32x4){bflo(b1.x), bfhi(b1.x), bflo(b1.y), bfhi(b1.y)}; o3 += (f32x4){bflo(b1.z), bfhi(b1.z), bflo(b1.w), bfhi(b1.w)};
            *(f32x4*)(out + off) = o0; *(f32x4*)(out + off + 4) = o1; *(f32x4*)(out + off + 8) = o2; *(f32x4*)(out + off + 12) = o3; } }
}
__device__ __forceinline__ void moe_gather(const Ctx& C, unsigned char* ws, const bf16* XN, int list) {
    const unsigned* cnt = (const unsigned*)(ws + WS_CTL) + CW_CNT + list * 8;
    MoeTiles mt; mt.init(cnt);
    const int* tokl = (const int*)(ws + WS_TOK) + (size_t)list * 8 * M; const float* wl = (const float*)(ws + WS_WL) + (size_t)list * 8 * M;
    int* rowtok = (int*)(ws + WS_ROWTOK) + list * MOE_ROWS; float* roww = (float*)(ws + WS_ROWW) + list * MOE_ROWS;
    unsigned char* XG = ws + WS_XG + list * XG_LIST; const unsigned char* XN8 = (const unsigned char*)XN;
    const int gw = C.bid * NWAVES + C.wave, NGW = C.G * NWAVES, nrows = mt.ntiles * 256;
    for (int g0 = gw; g0 < nrows; g0 += 4 * NGW) {
        int tok[4]; float w[4]; v4u a[4];
#pragma unroll
        for (int i = 0; i < 4; ++i) { const int gr = g0 + i * NGW; tok[i] = -1; w[i] = 0.f;
            if (gr < nrows) { int e, base; mt.locate(gr >> 8, e, base); const int local = ((gr >> 8) - base) * 256 + (gr & 255);
                if (local < (int)cnt[e]) { tok[i] = tokl[(size_t)e * M + local]; w[i] = wl[(size_t)e * M + local]; } } }
#pragma unroll
        for (int i = 0; i < 4; ++i) { a[i] = (v4u){0u, 0u, 0u, 0u};
            if (tok[i] >= 0) a[i] = ((const v4u*)(XN8 + (size_t)tok[i] * D))[C.lane]; }
#pragma unroll
        for (int i = 0; i < 4; ++i) { const int gr = g0 + i * NGW;
            if (gr < nrows) { if (C.lane == 0) { rowtok[gr] = tok[i]; roww[gr] = w[i]; }
                ((v4u*)(XG + (size_t)gr * D))[C.lane] = a[i]; } }
    }
}

__global__ void __launch_bounds__(NTHR, 2) fwd(Args args) {
    extern __shared__ __attribute__((aligned(16))) unsigned char lds_raw[];
    Ctx C; C.lds = (LAS unsigned char*)lds_raw; C.tid = threadIdx.x; C.lane = C.tid & 63; C.wave = __builtin_amdgcn_readfirstlane(C.tid >> 6); C.bid = blockIdx.x; C.G = gridDim.x;
    unsigned char* ws = args.ws;
    volatile LAS unsigned* MISC = (volatile LAS unsigned*)(C.lds + MISC_OFF);
    for (int u = C.tid; u < (LDS_BYTES - RING_BYTES) / 4; u += NTHR) ((LAS unsigned*)(C.lds + RING_BYTES))[u] = 0u;
    __syncthreads();
    const int lo = args.ph_lo, hi = args.ph_hi;
    const int wave_s = C.wave;
    XcdBarrier bar; bar.bar = (unsigned*)(ws + WS_CTL) + CW_BAR; bar.x = 0; bar.st = nullptr;
    if (MK_ONE_LAUNCH || hi - lo > 1) bar = xcd_barrier_post((unsigned*)(ws + WS_CTL) + CW_BAR, MISC + 8, C.tid == 0);
#if MK_ONE_LAUNCH
#define IN(k) true
#else
#define IN(k) (lo <= (k) && (k) < hi)
#endif
#define FRESH() do { unsigned z_ = 0u; asm volatile("" : "+v"(z_)); int t_ = wave_s * 64 + (int)__builtin_amdgcn_mbcnt_hi(~0u, __builtin_amdgcn_mbcnt_lo(~0u, z_)); asm volatile("" : "+v"(t_)); C.tid = t_; C.lane = t_ & 63; C.wave = wave_s; } while (0)
#if MK_ONE_LAUNCH
#define SEAM(k) xcd_barrier(bar, C.tid == 0)
#else
#define SEAM(k) do { if (IN(k) && IN((k) + 1)) xcd_barrier(bar, C.tid == 0); } while (0)
#endif
    bf16* XN = (bf16*)args.out; bf16* P = (bf16*)(ws + WS_P); bf16* XB = (bf16*)(ws + WS_XB);
    unsigned char* XN8 = (unsigned char*)args.out + (size_t)64 * MiB;

    if (IN(0)) { FRESH(); convert_layer_weights(C, args, 0); rope_table(C, ws); norm_rows<false, true>(C, args.in[0], args.in[1], XN, nullptr, ws, XN8); SEAM(0); }

#pragma unroll
    for (int l = 0; l < 2; ++l) {
        const int pb = 1 + 9 * l;
        if (IN(pb + 0)) { FRESH();
            {
                PlainSched S; S.T.init(M / 256, C_G / 256, C.G, C.bid); S.A = (const char*)XN; S.B = (const char*)(ws + WS_WIN); S.tA = (size_t)256 * D * 2; S.tB = (size_t)256 * D * 2;
                pg8::EpiBf16 E{P, NCOL, 1 << 30, 1.0f};
                pg8::gemm_phase<pg8::EpiBf16, PlainSched, true, true>(C.tid, C.lds, pg8::Gemm{D, D, D}, S, E); }
            FRESH();
            {
                PlainSched S; S.T.init(M / 256, (NCOL - C_G) / 256, C.G, C.bid); S.A = (const char*)XN8; S.B = (const char*)(ws + WS_WIN + (size_t)8 * MiB); S.tA = (size_t)256 * D; S.tB = (size_t)256 * D;
                pg8::EpiBf16 E{P + C_G, NCOL, 0, 1.0f / (SC_X8 * SC_W8)};
                pg8::gemm_phase<pg8::EpiBf16, PlainSched, true, true, true>(C.tid, C.lds, pg8::Gemm{D, D, D}, S, E); }
            SEAM(pb + 0);
        }
        if (IN(pb + 1)) { FRESH();
            lru_pass1_phase(C, args, l);
            __syncthreads(); FRESH();
            for (int it = C.bid; it < (M / 256) * NH; it += C.G) qk_item(C, args, l, it);
            FRESH();
            conva_tasks(C, args, l);
            SEAM(pb + 1);
        }
        if (IN(pb + 2)) { FRESH();
            {
                static_assert(moba::LDS_BYTES <= RING_BYTES, "attention scratch fits the ring region");
                const int v0 = (C.G % 8 == 0) ? (C.bid % 8) * (C.G / 8) + C.bid / 8 : C.bid;
                for (int v = v0; v < BATCH * NH * 4; v += C.G) { const int s = v & 3, bh = v >> 2;
#pragma unroll 1
                    for (int i = 0; i < 4; ++i) { const int qb = (i == 0) ? s : (i == 1) ? 7 - s : (i == 2) ? 8 + s : 15 - s;
                        moba::moba_unit(C.tid, bh >> 3, bh & 7, qb, (moba::bf16raw*)P, (const float*)(ws + WS_KMEAN), (char*)lds_raw); } }
            }
            FRESH();
            for (int it = C.bid; it < BATCH * NCH; it += C.G) lru_pass2_item(C, args, it);
            SEAM(pb + 2);
        }
        if (IN(pb + 3)) { FRESH();
            MergeSched S; S.T.init(M / 256, D / 256, C.G, C.bid); S.P = (const char*)P; S.W = (const char*)(ws + WS_WOABC);
            EpiMerge E{XN, P};
            pg8::gemm_phase<EpiMerge, MergeSched, true, true>(C.tid, C.lds, pg8::Gemm{512, NCOL, 512}, S, E);
            SEAM(pb + 3);
        }
        if (IN(pb + 4)) { FRESH();
            PlainSched S; S.T.init(M / 256, D / 256, C.G, C.bid); S.A = (const char*)XN; S.B = (const char*)(ws + WS_WO); S.tA = (size_t)256 * D * 2; S.tB = (size_t)256 * D * 2;
            if (l == 0) { EpiRes<true> E{args.in[0], XB}; pg8::gemm_phase<EpiRes<true>, PlainSched, true, true>(C.tid, C.lds, pg8::Gemm{D, D, D}, S, E); }
            else { EpiRes<false> E{XB, XB}; pg8::gemm_phase<EpiRes<false>, PlainSched, true, true>(C.tid, C.lds, pg8::Gemm{D, D, D}, S, E); }
            SEAM(pb + 4);
        }
        if (l == 0) {
            if (IN(pb + 5)) { FRESH(); norm_rows_b<false>(C, XB, args.in[17], XN, nullptr, ws); SEAM(pb + 5); }
            if (IN(pb + 6)) { FRESH();
                PlainSched S; S.T.init(M / 256, 2 * DFF / 256, C.G, C.bid); S.A = (const char*)XN; S.B = (const char*)(ws + WS_FGU); S.tA = (size_t)256 * D * 2; S.tB = (size_t)256 * D * 2;
                EpiSwiGLU E{(bf16*)(ws + WS_HID0), DFF};
                pg8::gemm_phase<EpiSwiGLU, PlainSched, true, true>(C.tid, C.lds, pg8::Gemm{D, D, D}, S, E);
                SEAM(pb + 6);
            }
            if (IN(pb + 7)) { FRESH();
                PlainSched S; S.T.init(M / 256, D / 256, C.G, C.bid); S.A = (const char*)(ws + WS_HID0); S.B = (const char*)(ws + WS_FDN); S.tA = (size_t)256 * DFF * 2; S.tB = (size_t)256 * DFF * 2;
                EpiRes<false> E{XB, XB};
                pg8::gemm_phase<EpiRes<false>, PlainSched, true, true>(C.tid, C.lds, pg8::Gemm{DFF, DFF, DFF}, S, E);
                SEAM(pb + 7);
            }
            if (IN(pb + 8)) { FRESH(); convert_layer_weights(C, args, 1); norm_rows_b<false, true>(C, XB, args.in[1] + D, XN, nullptr, ws, XN8); SEAM(pb + 8); }
        } else {
            if (IN(15)) { FRESH(); norm_rows_b<true>(C, XB, args.in[17] + D, XN, args.in[21], ws); convert_moe_weights(C, args); SEAM(15); }
            if (IN(16)) { FRESH(); moe_gather(C, ws, XN, 0); FRESH(); moe_gather(C, ws, XN, 1); SEAM(16); }
            const unsigned* cnt = (const unsigned*)(ws + WS_CTL) + CW_CNT;
            int nt0, nt1; { MoeTiles t; t.init(cnt); nt0 = t.ntiles; t.init(cnt + 8); nt1 = t.ntiles; }
            const int reg1 = ((nt1 * (D / 256)) / C.G) * C.G / (D / 256);
            constexpr float dsc = 1.0f / (SC_H8 * SC_W8);
            if (IN(17)) { FRESH();
                MoeSched S; S.init(cnt, 2 * EFF / 256, C.G, C.bid, 0, 0, nt0, 1, reg1, nt1 - reg1);
                S.A = (const char*)(ws + WS_XG); S.tA = (size_t)256 * D; S.W = (const char*)(ws + WS_MGU); S.eStride = (size_t)7168 * D; S.tB = (size_t)256 * D;
                EpiSwiGLU8 E{ws + WS_MH, EFF};
                pg8::gemm_phase<EpiSwiGLU8, MoeSched, true, true, true>(C.tid, C.lds, pg8::Gemm{D, D, D}, S, E);
                SEAM(17);
            }
            if (IN(18)) { FRESH();
                int extra;
                {   MoeSched S; S.init(cnt, D / 256, C.G, C.bid, 0, 0, nt0, 1, reg1, nt1 - reg1); extra = S.nunits() % C.G;
                    S.A = (const char*)(ws + WS_MH); S.tA = (size_t)256 * EFF; S.W = (const char*)(ws + WS_MDN); S.eStride = (size_t)D * EFF; S.tB = (size_t)256 * EFF;
                    EpiScatter<false, true> E{(const int*)(ws + WS_ROWTOK), (const float*)(ws + WS_ROWW), XB, XB, dsc, args.out};
                    pg8::gemm_phase<EpiScatter<false, true>, MoeSched, true, true, true>(C.tid, C.lds, pg8::Gemm{EFF, EFF, EFF}, S, E); }
                FRESH();
                {   MoeSched S; S.init(cnt, 2 * EFF / 256, C.G, C.bid, 1, 0, reg1, 1, 0, 0); S.skipE = extra; S.skipR = MOE_DOWN_COST;
                    S.A = (const char*)(ws + WS_XG); S.tA = (size_t)256 * D; S.W = (const char*)(ws + WS_MGU); S.eStride = (size_t)7168 * D; S.tB = (size_t)256 * D;
                    EpiSwiGLU8 E{ws + WS_MH, EFF};
                    pg8::gemm_phase<EpiSwiGLU8, MoeSched, true, true, true>(C.tid, C.lds, pg8::Gemm{D, D, D}, S, E); }
                SEAM(18);
            }
            if (IN(19)) { FRESH();
                moe_side_combine(C, ws, XB, args.out, (MOE_TILES + reg1) * 256, (MOE_TILES + nt1) * 256);
                FRESH();
                MoeSched S; S.init(cnt, D / 256, C.G, C.bid, 1, 0, reg1, 1, 0, 0);
                S.A = (const char*)(ws + WS_MH); S.tA = (size_t)256 * EFF; S.W = (const char*)(ws + WS_MDN); S.eStride = (size_t)D * EFF; S.tB = (size_t)256 * EFF;
                EpiScatter<true, false> E{(const int*)(ws + WS_ROWTOK), (const float*)(ws + WS_ROWW), XB, args.out, dsc, nullptr};
                pg8::gemm_phase<EpiScatter<true, false>, MoeSched, true, true, true>(C.tid, C.lds, pg8::Gemm{EFF, EFF, EFF}, S, E);
            }
        }
    }
#undef IN
#undef SEAM
}

extern "C" void kernel_launch(void* const* d_in, const int* in_sizes, int n_in, void* d_out, int out_size, void* d_ws, size_t ws_size, hipStream_t stream) {
    static int grid = 0;
    if (grid == 0) {
        if (n_in != 25 || in_sizes[0] != M * D || out_size != M * D || ws_size < WS_END) { fprintf(stderr, "kernel_launch: unexpected shapes (n_in %d, in0 %d, out %d, ws %zu); nothing launched\n", n_in, n_in > 0 ? in_sizes[0] : -1, out_size, ws_size); grid = -1; return; }
        int dev = 0, cus = 0, per_cu = 0;
        if (hipGetDevice(&dev) != hipSuccess || hipDeviceGetAttribute(&cus, hipDeviceAttributeMultiprocessorCount, dev) != hipSuccess) { grid = -1; return; }
        if (hipFuncSetAttribute((const void*)fwd, hipFuncAttributeMaxDynamicSharedMemorySize, LDS_BYTES) != hipSuccess) { fprintf(stderr, "kernel_launch: hipFuncSetAttribute failed\n"); grid = -1; return; }
        if (hipOccupancyMaxActiveBlocksPerMultiprocessor(&per_cu, (const void*)fwd, NTHR, LDS_BYTES) != hipSuccess || per_cu < 1) { fprintf(stderr, "kernel_launch: occupancy query reports %d workgroups per CU\n", per_cu); }
        (void)hipGetLastError();
        grid = cus;
    }
    if (grid < 0) return;
    if (hipMemsetAsync((char*)d_ws + WS_CTL, 0, CTL_ZERO_BYTES, stream) != hipSuccess) return;
    Args a{};
    for (int i = 0; i < 25; ++i) a.in[i] = (const float*)d_in[i];
    a.out = (float*)d_out; a.ws = (unsigned char*)d_ws;
#if MK_ONE_LAUNCH
    a.ph_lo = 0; a.ph_hi = N_PHASES;
    hipLaunchKernelGGL(fwd, dim3(grid), dim3(NTHR), LDS_BYTES, stream, a);
#else
    for (int p = 0; p < N_PHASES; ++p) { a.ph_lo = p; a.ph_hi = p + 1; hipLaunchKernelGGL(fwd, dim3(grid), dim3(NTHR), LDS_BYTES, stream, a); }
#endif
}
```

```cpp
#include <hip/hip_runtime.h>
#include <cstdio>
#include <cstdint>

namespace pg8 {
#define PG8_LAS __attribute__((address_space(3)))
typedef unsigned short bf16_t;
typedef short bf16x8 __attribute__((ext_vector_type(8)));
typedef float f32x4 __attribute__((ext_vector_type(4)));
typedef unsigned u32x4 __attribute__((ext_vector_type(4)));
constexpr int BM = 256, BK = 64, HALF = 128, HTB = HALF * BK * 2  , STAGE_BYTES = 8 * HTB, NXCD = 8, WGM = 8;

__host__ __device__ __forceinline__ int lds_byte(int r, int c) { const int st = (r >> 4) * 2 + (c >> 5), rr = r & 15, cc = c & 31, ob = rr * 64 + cc * 2; return st * 1024 + (ob ^ (((ob >> 9) & 1) << 5)); }
__host__ __device__ __forceinline__ void stage_rc(int b, int& R, int& C) { const int st = b / 1024, sb = b % 1024, swz = sb ^ (((sb >> 9) & 1) << 5); R = (st >> 1) * 16 + swz / 64; C = (st & 1) * 32 + (swz % 64) / 2; }
__host__ __device__ __forceinline__ int perm32(int rho) { const int n = rho >> 4, i = rho & 15; return 8 * (i >> 2) + 4 * n + (i & 3); }

struct Unit { int pm, pn; const char* a; const char* b; int x; };
struct Gemm { int K, lda, ldb; };

struct TileOrder {
    int nM, nN, nwg, G, c;
    __device__ __forceinline__ void init(int nM_, int nN_, int G_, int c_) { nM = nM_; nN = nN_; nwg = nM * nN; G = G_; c = c_; }
    __device__ __forceinline__ bool map(long L, int& pm, int& pn) const {
        if (L >= nwg) return false;
        int wgid = (int)L; { const int q = nwg / NXCD, r = nwg % NXCD, xcd = wgid % NXCD, off = wgid / NXCD; wgid = (xcd < r ? xcd * (q + 1) : r * (q + 1) + (xcd - r) * q) + off; }
        const int nig = WGM * nN, gid = wgid / nig, fm = gid * WGM, gsz = (nM - fm) < WGM ? (nM - fm) : WGM;
        pm = fm + ((wgid % nig) % gsz); pn = (wgid % nig) / gsz; return true;
    }
};

typedef float f32x2_cv __attribute__((ext_vector_type(2))); typedef __bf16 bf16x2_cv __attribute__((ext_vector_type(2)));
__device__ __forceinline__ unsigned cvt_pk_bf16(float lo, float hi) { const f32x2_cv v = {lo, hi}; const bf16x2_cv b = __builtin_convertvector(v, bf16x2_cv); return __builtin_bit_cast(unsigned, b); }

struct EpiBf16 {
    static constexpr bool PERM = true, AFTER_DRAIN = false, CHAIN = false;
    bf16_t* O; int ldc; int sig_from; float ds;
    __device__ __forceinline__ void operator()(const f32x4 (&acc)[2][2][4][2], const Unit& u, int wr, int wc, int fr, int fq) const {
        const int row0 = u.pm * BM + wr * 64 + fr; const int col0 = u.pn * BM + wc * 32 + 8 * fq;
#pragma unroll
        for (int ai = 0; ai < 2; ++ai)
#pragma unroll
            for (int m = 0; m < 4; ++m) { bf16_t* rowp = O + (size_t)(row0 + ai * HALF + m * 16) * ldc + col0;
#pragma unroll
                for (int bj = 0; bj < 2; ++bj) { f32x4 v0 = acc[ai][bj][m][0] * ds, v1 = acc[ai][bj][m][1] * ds;
                    if (u.pn >= sig_from) {
#pragma unroll
                        for (int k = 0; k < 4; ++k) { v0[k] = __builtin_amdgcn_rcpf(1.0f + __expf(-v0[k])); v1[k] = __builtin_amdgcn_rcpf(1.0f + __expf(-v1[k])); } }
                    u32x4 w; w.x = cvt_pk_bf16(v0[0], v0[1]); w.y = cvt_pk_bf16(v0[2], v0[3]); w.z = cvt_pk_bf16(v1[0], v1[1]); w.w = cvt_pk_bf16(v1[2], v1[3]);
                    *(u32x4*)(rowp + bj * HALF) = w; } }
    }
};

typedef int pg8_v4i __attribute__((ext_vector_type(4))); typedef int pg8_v8i __attribute__((ext_vector_type(8)));
__device__ __forceinline__ pg8_v8i f8cat(bf16x8 lo, bf16x8 hi) { const pg8_v4i a = __builtin_bit_cast(pg8_v4i, lo), b = __builtin_bit_cast(pg8_v4i, hi); return __builtin_shufflevector(a, b, 0, 1, 2, 3, 4, 5, 6, 7); }
template <class Epi, class Sched, bool ALIGN_EPI = false, bool SP2 = false, bool F8 = false>
__device__ __forceinline__ void gemm_phase(int tid_, PG8_LAS unsigned char* lds, const Gemm g, const Sched& S, const Epi& E) {
    const int tid = tid_, wid = __builtin_amdgcn_readfirstlane(tid >> 6), lane = tid & 63, wr = wid >> 2, wc = wid & 3, fr = lane & 15, fq = lane >> 4;
    const int K = g.K, nt = F8 ? K / 128 : K / BK; constexpr int ESZ = F8 ? 1 : 2;
    unsigned voffA[2], voffB[2];
#pragma unroll
    for (int i = 0; i < 2; ++i) { int R, C; stage_rc(tid * 16 + i * 8192, R, C); const int Rb = Epi::PERM ? ((R & ~31) + perm32(R & 31)) : R;
        voffA[i] = (unsigned)(R * g.lda * ESZ + C * 2); voffB[i] = (unsigned)(Rb * g.ldb * ESZ + C * 2); }
    const size_t kstep = (size_t)(BK * 2);
    const size_t hstepA = (size_t)HALF * g.lda * ESZ, hstepB = (size_t)HALF * g.ldb * ESZ;
    const unsigned ldsw = (unsigned)wid * 1024u;
    const int aoff = lds_byte(wr * 64 + fr, fq * 8), boff = lds_byte(wc * 32 + fr, fq * 8);
#define PG8_SA(b, h) (((b) * 2 + (h)) * HTB)
#define PG8_SB(b, h) ((4 + (b) * 2 + (h)) * HTB)
#define PG8_STAGE(bufoff, gbase, voff) do { _Pragma("unroll") for (int _i = 0; _i < 2; ++_i) \
        __builtin_amdgcn_global_load_lds((const unsigned*)((const char*)(gbase) + (voff)[_i]), (PG8_LAS unsigned*)(lds + (bufoff) + ldsw + _i * 8192), 16, 0, 0); } while (0)
#define PG8_LDA(dst, b, h) do { _Pragma("unroll") for (int m = 0; m < 4; ++m) { const bf16x8 lo_ = *(const PG8_LAS bf16x8*)(lds + PG8_SA(b, h) + aoff + m * 2048), hi_ = *(const PG8_LAS bf16x8*)(lds + PG8_SA(b, h) + aoff + m * 2048 + 1024); \
        if constexpr (F8) dst##8[m] = f8cat(lo_, hi_); else { dst[m][0] = lo_; dst[m][1] = hi_; } } } while (0)
#define PG8_LDB(dst, b, h) do { _Pragma("unroll") for (int n = 0; n < 2; ++n) { const bf16x8 lo_ = *(const PG8_LAS bf16x8*)(lds + PG8_SB(b, h) + boff + n * 2048), hi_ = *(const PG8_LAS bf16x8*)(lds + PG8_SB(b, h) + boff + n * 2048 + 1024); \
        if constexpr (F8) dst##8[n] = f8cat(lo_, hi_); else { dst[n][0] = lo_; dst[n][1] = hi_; } } } while (0)
#define PG8_MMA(ai, bj, At, Bt) do { __builtin_amdgcn_s_setprio(1); _Pragma("unroll") for (int m = 0; m < 4; ++m) _Pragma("unroll") for (int n = 0; n < 2; ++n) { \
        if constexpr (F8) asm volatile("v_mfma_scale_f32_16x16x128_f8f6f4 %0, %1, %2, %0, %3, %3 op_sel_hi:[0,0,0]" : "+v"(acc[ai][bj][m][n]) : "v"(Bt##8[n]), "v"(At##8[m]), "v"(f8scale));   \
        else { _Pragma("unroll") for (int k = 0; k < 2; ++k) acc[ai][bj][m][n] = __builtin_amdgcn_mfma_f32_16x16x32_bf16(Bt[n][k], At[m][k], acc[ai][bj][m][n], 0, 0, 0); } } __builtin_amdgcn_s_setprio(0); } while (0)
#define PG8_WAIT_V(n) asm volatile("s_waitcnt vmcnt(" #n ")" ::: "memory")
#define PG8_WAIT_L(n) asm volatile("s_waitcnt lgkmcnt(" #n ")" ::: "memory")
#define PG8_BAR __builtin_amdgcn_s_barrier()
#define PG8_SCHED __builtin_amdgcn_sched_barrier(0)
    Unit cur, nxt; int ui = 0;
    if (!S.next(0, cur)) return;
    f32x4 acc[2][2][4][2];
#pragma unroll
    for (int a = 0; a < 2; ++a)
#pragma unroll
        for (int b = 0; b < 2; ++b)
#pragma unroll
            for (int m = 0; m < 4; ++m)
#pragma unroll
                for (int n = 0; n < 2; ++n) acc[a][b][m][n] = (f32x4){0.f, 0.f, 0.f, 0.f};
    bf16x8 At[4][2], B0[2][2], B1[2][2]; pg8_v8i At8[4], B08[2], B18[2]; const int f8scale = 0x7f7f7f7f;
    const char* cA = cur.a; const char* cB = cur.b;
    S.a_ready(cur);
    if constexpr (SP2) {
        PG8_STAGE(PG8_SB(0, 0), cB, voffB); PG8_STAGE(PG8_SB(0, 1), cB + hstepB, voffB); PG8_STAGE(PG8_SA(0, 0), cA, voffA); PG8_STAGE(PG8_SA(0, 1), cA + hstepA, voffA);
        if (wr == 1) PG8_BAR;
        PG8_WAIT_V(2); PG8_BAR;
        PG8_STAGE(PG8_SB(1, 0), cB + kstep, voffB); PG8_STAGE(PG8_SA(1, 0), cA + kstep, voffA); PG8_STAGE(PG8_SB(1, 1), cB + hstepB + kstep, voffB);
        PG8_WAIT_V(6); PG8_BAR;
    } else {
        PG8_STAGE(PG8_SB(0, 0), cB, voffB); PG8_STAGE(PG8_SA(0, 0), cA, voffA); PG8_STAGE(PG8_SB(0, 1), cB + hstepB, voffB); PG8_STAGE(PG8_SA(0, 1), cA + hstepA, voffA);
        if (wr == 1) PG8_BAR;
        PG8_WAIT_V(4); PG8_BAR;
        PG8_STAGE(PG8_SB(1, 0), cB + kstep, voffB); PG8_STAGE(PG8_SA(1, 0), cA + kstep, voffA); PG8_STAGE(PG8_SB(1, 1), cB + hstepB + kstep, voffB);
        PG8_WAIT_V(6); PG8_BAR;
    }
    for (;;) {
        const bool has_next = S.next(ui + 1, nxt);
        const char* nA = has_next ? nxt.a : cA; const char* nB = has_next ? nxt.b : cB;
#pragma unroll 1
        for (int t = 0; t < nt; t += 2) {
            const bool last = (t == nt - 2);
            const char* a1 = cA + (size_t)(t + 1) * kstep;
            const char* a2 = last ? nA : cA + (size_t)(t + 2) * kstep; const char* b2 = last ? nB : cB + (size_t)(t + 2) * kstep;
            const char* a3 = a2 + kstep; const char* b3 = b2 + kstep;
            if (last && has_next) S.a_ready(nxt);
            if constexpr (SP2) {
            PG8_LDB(B0, 0, 0); PG8_LDB(B1, 0, 1); PG8_SCHED; PG8_LDA(At, 0, 0); PG8_STAGE(PG8_SA(1, 1), a1 + hstepA, voffA);
            PG8_WAIT_V(8); PG8_WAIT_L(0); PG8_BAR; PG8_MMA(0, 0, At, B0); PG8_MMA(0, 1, At, B1); PG8_BAR; PG8_SCHED;
            PG8_LDA(At, 0, 1); PG8_STAGE(PG8_SB(0, 0), b2, voffB); PG8_STAGE(PG8_SB(0, 1), b2 + hstepB, voffB); PG8_STAGE(PG8_SA(0, 0), a2, voffA);
            PG8_WAIT_V(8); PG8_WAIT_L(0); PG8_BAR; PG8_MMA(1, 0, At, B0); PG8_MMA(1, 1, At, B1); PG8_BAR; PG8_SCHED;
            PG8_LDB(B0, 1, 0); PG8_LDB(B1, 1, 1); PG8_SCHED; PG8_LDA(At, 1, 0); PG8_STAGE(PG8_SA(0, 1), a2 + hstepA, voffA);
            PG8_WAIT_V(8); PG8_WAIT_L(0); PG8_BAR; PG8_MMA(0, 0, At, B0); PG8_MMA(0, 1, At, B1); PG8_BAR; PG8_SCHED;
            PG8_LDA(At, 1, 1); PG8_STAGE(PG8_SB(1, 0), b3, voffB); PG8_STAGE(PG8_SB(1, 1), b3 + hstepB, voffB); PG8_STAGE(PG8_SA(1, 0), a3, voffA);
            PG8_WAIT_V(8); PG8_WAIT_L(0); PG8_BAR; PG8_MMA(1, 0, At, B0); PG8_MMA(1, 1, At, B1); PG8_BAR; PG8_SCHED;
            } else {
            PG8_LDB(B0, 0, 0); PG8_SCHED; PG8_LDA(At, 0, 0); PG8_STAGE(PG8_SA(1, 1), a1 + hstepA, voffA);
            PG8_WAIT_L(8); PG8_BAR; PG8_WAIT_L(0); PG8_MMA(0, 0, At, B0); PG8_BAR; PG8_SCHED;
            PG8_LDB(B1, 0, 1); PG8_STAGE(PG8_SB(0, 0), b2, voffB);
            PG8_BAR; PG8_WAIT_L(0); PG8_MMA(0, 1, At, B1); PG8_BAR;
            PG8_LDA(At, 0, 1); PG8_STAGE(PG8_SA(0, 0), a2, voffA);
            PG8_BAR; PG8_WAIT_L(0); PG8_MMA(1, 0, At, B0); PG8_BAR; PG8_SCHED;
            PG8_STAGE(PG8_SB(0, 1), b2 + hstepB, voffB);
            PG8_WAIT_V(6); PG8_BAR; PG8_MMA(1, 1, At, B1); PG8_BAR;
            PG8_LDB(B0, 1, 0); PG8_SCHED; PG8_LDA(At, 1, 0); PG8_STAGE(PG8_SA(0, 1), a2 + hstepA, voffA);
            PG8_WAIT_L(8); PG8_BAR; PG8_WAIT_L(0); PG8_MMA(0, 0, At, B0); PG8_BAR; PG8_SCHED;
            PG8_LDB(B1, 1, 1); PG8_STAGE(PG8_SB(1, 0), b3, voffB);
            PG8_BAR; PG8_WAIT_L(0); PG8_MMA(0, 1, At, B1); PG8_BAR;
            PG8_LDA(At, 1, 1); PG8_STAGE(PG8_SA(1, 0), a3, voffA);
            PG8_BAR; PG8_WAIT_L(0); PG8_MMA(1, 0, At, B0); PG8_BAR; PG8_SCHED;
            PG8_STAGE(PG8_SB(1, 1), b3 + hstepB, voffB);
            PG8_WAIT_V(6); PG8_BAR; PG8_MMA(1, 1, At, B1); PG8_BAR;
            }
        }
        if constexpr (ALIGN_EPI) { if (wr == 0) PG8_BAR; }
        if constexpr (F8) asm volatile("s_nop 15\n\ts_nop 7" ::: "memory");
        bool keep = false;
        if constexpr (!Epi::AFTER_DRAIN) { if constexpr (Epi::CHAIN) keep = E.chain(acc, cur, wr, wc, fr, fq); else E(acc, cur, wr, wc, fr, fq); S.done(cur); }
        if (!has_next) break;
        if (!keep) {
#pragma unroll
        for (int a = 0; a < 2; ++a)
#pragma unroll
            for (int b = 0; b < 2; ++b)
#pragma unroll
                for (int m = 0; m < 4; ++m)
#pragma unroll
                    for (int n = 0; n < 2; ++n) acc[a][b][m][n] = (f32x4){0.f, 0.f, 0.f, 0.f};
        }
        cur = nxt; cA = nA; cB = nB; ++ui;
        if constexpr (ALIGN_EPI) { if (wr == 1) PG8_BAR; }
    }
    PG8_WAIT_V(0);
    if constexpr (!ALIGN_EPI) { if (wr == 0) PG8_BAR; }
    PG8_BAR;
    if constexpr (Epi::AFTER_DRAIN) { E.fused(acc, cur, wr, wc, fr, fq, lds, wid, lane); S.done(cur); }
#undef PG8_SA
#undef PG8_SB
#undef PG8_STAGE
#undef PG8_LDA
#undef PG8_LDB
#undef PG8_MMA
#undef PG8_WAIT_V
#undef PG8_WAIT_L
#undef PG8_BAR
#undef PG8_SCHED
}
}

#define GAS __attribute__((address_space(1)))
#define LAS __attribute__((address_space(3)))
typedef unsigned short bf16;
typedef unsigned v4u __attribute__((ext_vector_type(4)));
typedef unsigned v2u __attribute__((ext_vector_type(2)));
typedef float f32x4 __attribute__((ext_vector_type(4)));
typedef float f32x2 __attribute__((ext_vector_type(2)));
typedef GAS unsigned gu32;
#define RLX_AGENT __ATOMIC_RELAXED, __HIP_MEMORY_SCOPE_AGENT
#define LDS_WAIT() asm volatile("s_waitcnt lgkmcnt(0)" ::: "memory")
#define VM_WAIT() asm volatile("s_waitcnt vmcnt(0)" ::: "memory")
__device__ __forceinline__ unsigned pk2(float lo, float hi) { return pg8::cvt_pk_bf16(lo, hi); }
__device__ __forceinline__ float bflo(unsigned w) { return __uint_as_float(w << 16); }
__device__ __forceinline__ float bfhi(unsigned w) { return __uint_as_float(w & 0xffff0000u); }
__device__ __forceinline__ float bf2f(bf16 b) { return __uint_as_float((unsigned)b << 16); }
__device__ __forceinline__ bf16 f2bf(float f) { return (bf16)(pk2(f, 0.f) & 0xffffu); }
__device__ __forceinline__ float bfround(float f) { return bflo(pk2(f, 0.f)); }
__device__ __forceinline__ unsigned pk4_fp8(float a, float b, float c, float d) {
    a = fminf(fmaxf(a, -448.f), 448.f); b = fminf(fmaxf(b, -448.f), 448.f); c = fminf(fmaxf(c, -448.f), 448.f); d = fminf(fmaxf(d, -448.f), 448.f);
    int p = 0; p = __builtin_amdgcn_cvt_pk_fp8_f32(a, b, p, false); p = __builtin_amdgcn_cvt_pk_fp8_f32(c, d, p, true); return (unsigned)p; }
__device__ __forceinline__ float rcp_(float x) { return __builtin_amdgcn_rcpf(x); }
__device__ __forceinline__ float sigmoidf_(float x) { return rcp_(1.0f + __expf(-x)); }

#define XB_TMO      128
#define XB_XCNT(j)  (256  + 64 * (j))
#define XB_XSUB(j)  (1280 + 64 * (j))
#define XB_XGEN(j)  (2304 + 64 * (j))
#define XB_TOP      3328
#define XB_TOPGEN   3392
#define XCD_BAR_WORDS 3456
#define XB_SPIN_CAP (1u << 18)

__device__ __forceinline__ unsigned xb_ld(unsigned* p)              { return __hip_atomic_load(p, __ATOMIC_RELAXED, __HIP_MEMORY_SCOPE_AGENT); }
__device__ __forceinline__ unsigned xb_add(unsigned* p, unsigned v) { return __hip_atomic_fetch_add(p, v, __ATOMIC_RELAXED, __HIP_MEMORY_SCOPE_AGENT); }
__device__ __forceinline__ unsigned xb_xcc_id() { return (unsigned)__builtin_amdgcn_s_getreg((3 << 11) | 20) & 0xFu; }
#define XB_SPIN(cond, bar) do { unsigned _sp = 0; while (cond) { __builtin_amdgcn_s_sleep(1); \
    if ((++_sp & 255u) == 0u) { if (xb_ld(&(bar)[XB_TMO])) break; if (_sp > XB_SPIN_CAP) { atomicAdd(&(bar)[XB_TMO], 1u); break; } } } } while (0)

struct XcdBarrier {
    unsigned* bar; unsigned x;
    volatile LAS unsigned* st;
};

__device__ __forceinline__ XcdBarrier xcd_barrier_post(unsigned* bar, volatile LAS unsigned* st, bool leader) {
    XcdBarrier b; b.bar = bar; b.x = xb_xcc_id(); b.st = st;
    if (leader) (void)xb_add(&bar[XB_XCNT(b.x)], 1u);
    return b;
}
__device__ __forceinline__ void xcd_barrier_complete(unsigned* bar, unsigned x, unsigned& nloc, unsigned& nx) {
    const unsigned G = gridDim.x * gridDim.y * gridDim.z;
    unsigned sum, cnt, mine, sp = 0u;
    for (;;) {
        sum = 0u; cnt = 0u; mine = 0u;
#pragma unroll
        for (unsigned j = 0; j < 16; ++j) { const unsigned c = xb_ld(&bar[XB_XCNT(j)]); sum += c; cnt += (c > 0u) ? 1u : 0u; mine = (j == x) ? c : mine; }
        if (sum == G) break;
        __builtin_amdgcn_s_sleep(1);
        if ((++sp & 255u) == 0u) { if (xb_ld(&bar[XB_TMO])) break; if (sp > XB_SPIN_CAP) { atomicAdd(&bar[XB_TMO], 1u); break; } }
    }
    nloc = mine > 0u ? mine : 1u; nx = cnt > 0u ? cnt : 1u;
}

__device__ __forceinline__ void xcd_barrier(const XcdBarrier& b_, bool leader) {
    XcdBarrier b = b_; asm volatile("" : "+s"(b.x));
    asm volatile("s_waitcnt vmcnt(0)" ::: "memory");
    __syncthreads();
    if (leader) {
        unsigned* bar = b.bar;
        __builtin_amdgcn_s_waitcnt(0);
        unsigned nloc = b.st[0], nx = b.st[1];
        if (nloc == 0u) { xcd_barrier_complete(bar, b.x, nloc, nx); b.st[0] = nloc; b.st[1] = nx; }
        const unsigned old = xb_add(&bar[XB_XSUB(b.x)], 1u);
        const unsigned gen = old / nloc;
        if (old + 1u == (gen + 1u) * nloc) {
            __builtin_amdgcn_fence(__ATOMIC_RELEASE, "agent");
            asm volatile("s_waitcnt vmcnt(0)" ::: "memory");
            const unsigned og = xb_add(&bar[XB_TOP], 1u);
            const unsigned tg = og / nx;
            if (og + 1u == (tg + 1u) * nx) xb_add(&bar[XB_TOPGEN], 1u);
            else XB_SPIN(xb_ld(&bar[XB_TOPGEN]) == tg, bar);
            __builtin_amdgcn_fence(__ATOMIC_ACQUIRE, "agent");
            xb_add(&bar[XB_XGEN(b.x)], 1u);
            asm volatile("s_waitcnt vmcnt(0)" ::: "memory");
        } else {
            XB_SPIN(xb_ld(&bar[XB_XGEN(b.x)]) == gen, bar);
            __builtin_amdgcn_fence(__ATOMIC_ACQUIRE, "agent");
            asm volatile("s_waitcnt vmcnt(0)" ::: "memory");
        }
    }
    __syncthreads();
}

namespace moba {
using bf16x8=__attribute__((ext_vector_type(8)))short;
using s16x4=__attribute__((ext_vector_type(4)))short;
using f32x16=__attribute__((ext_vector_type(16)))float;
using u32x4=__attribute__((ext_vector_type(4)))unsigned;
typedef unsigned short bf16raw;
constexpr int SEQL=4096,NHEAD=8,HDIM=64,DM=7168;
constexpr int COLQ=1536,COLK=2048,COLV=2560;
constexpr int NW=8,QBLK=32,QB=QBLK*NW,KVBLK=64;
__device__ __forceinline__ int crow(int r,int hi){return (r&3)+8*(r>>2)+4*hi;}
#define SBAR() __builtin_amdgcn_sched_barrier(0)
__device__ __forceinline__ void cmask(f32x16&p0,f32x16&p1,int jb,int qrel,int hi){
  const float NEG=-INFINITY; int kb=64*jb+4*hi;
  #pragma unroll
  for(int r=0;r<16;++r){int kv=kb+(r&3)+8*(r>>2); if(kv>qrel)p0[r]=NEG; if(kv+32>qrel)p1[r]=NEG;}
}
constexpr int NSLOT=3, SLOTB=8192;
constexpr int LDS_K=0, LDS_V=NSLOT*SLOTB, LDS_WS=2*NSLOT*SLOTB, LDS_OST=LDS_WS+NW*64*4, LDS_KM=LDS_OST+NW*4096, LDS_BYTES=LDS_KM+4096;
__device__ __forceinline__ void glds16(const void*gsrc,unsigned lds_dst){unsigned keep;
  asm volatile("s_mov_b32 %0, m0\n\ts_mov_b32 m0, %2\n\ts_nop 0\n\tglobal_load_lds_dwordx4 %1, off\n\ts_mov_b32 m0, %0":"=&s"(keep):"v"(gsrc),"s"(lds_dst):"memory");}
typedef float f32x2_t __attribute__((ext_vector_type(2))); typedef __bf16 bf16x2_t __attribute__((ext_vector_type(2)));
__device__ __forceinline__ unsigned cvtpk_s(float lo,float hi){f32x2_t v={lo,hi};bf16x2_t b=__builtin_convertvector(v,bf16x2_t);return __builtin_bit_cast(unsigned,b);}
#define WAIT_BAR(N) asm volatile("s_waitcnt vmcnt(" #N ") lgkmcnt(0)\n\ts_barrier":::"memory")

__device__ __forceinline__ void qkt(f32x16&p0,f32x16&p1,const char*Kslot,const bf16x8*qr,int r32,int hi){
  const char*kb=Kslot+hi*1024+r32*16; const f32x16 zf=f32x16{};
  #pragma unroll
  for(int d0=0;d0<4;++d0){
    const bf16x8 b0=*reinterpret_cast<const bf16x8*>(kb+d0*2048);
    const bf16x8 b1=*reinterpret_cast<const bf16x8*>(kb+d0*2048+512);
    if(d0==0){p0=__builtin_amdgcn_mfma_f32_32x32x16_bf16(b0,qr[0],zf,0,0,0);p1=__builtin_amdgcn_mfma_f32_32x32x16_bf16(b1,qr[0],zf,0,0,0);}
    else{p0=__builtin_amdgcn_mfma_f32_32x32x16_bf16(b0,qr[d0],p0,0,0,0);p1=__builtin_amdgcn_mfma_f32_32x32x16_bf16(b1,qr[d0],p1,0,0,0);}}
}
typedef __attribute__((address_space(3))) const char* lds_cptr;
typedef short v4i16_t __attribute__((ext_vector_type(4)));
__device__ __forceinline__ void kload8(bf16x8*kf,lds_cptr kp){
  kf[0]=*(const __attribute__((address_space(3))) bf16x8*)(kp);      kf[1]=*(const __attribute__((address_space(3))) bf16x8*)(kp+512);
  kf[2]=*(const __attribute__((address_space(3))) bf16x8*)(kp+2048); kf[3]=*(const __attribute__((address_space(3))) bf16x8*)(kp+2560);
  kf[4]=*(const __attribute__((address_space(3))) bf16x8*)(kp+4096); kf[5]=*(const __attribute__((address_space(3))) bf16x8*)(kp+4608);
  kf[6]=*(const __attribute__((address_space(3))) bf16x8*)(kp+6144); kf[7]=*(const __attribute__((address_space(3))) bf16x8*)(kp+6656);
}
__device__ __forceinline__ void kload2(bf16x8*kf,lds_cptr kp,int j){ kf[2*j]=*(const __attribute__((address_space(3))) bf16x8*)(kp+j*2048); kf[2*j+1]=*(const __attribute__((address_space(3))) bf16x8*)(kp+j*2048+512); }
__device__ __forceinline__ s16x4 vtr(lds_cptr p){ return __builtin_bit_cast(s16x4,__builtin_amdgcn_ds_read_tr16_b64_v4i16((__attribute__((address_space(3))) v4i16_t*)p)); }
__device__ __forceinline__ void pv(f32x16*o,int vb,bf16x8 pa0,bf16x8 pa1,bf16x8 pa2,bf16x8 pa3){
  #pragma unroll
  for(int d0=0;d0<2;++d0){s16x4 lo[4],hi[4];
    #pragma unroll
    for(int ks=0;ks<4;++ks){
      asm volatile("ds_read_b64_tr_b16 %0,%1 offset:%c2":"=&v"(lo[ks]):"v"(vb),"i"(d0*4096+ks*1024):"memory");
      asm volatile("ds_read_b64_tr_b16 %0,%1 offset:%c2":"=&v"(hi[ks]):"v"(vb),"i"(d0*4096+ks*1024+512):"memory");}
    asm volatile("s_waitcnt lgkmcnt(0)":::"memory");SBAR();
    #define PK(k) (bf16x8){lo[k][0],lo[k][1],lo[k][2],lo[k][3],hi[k][0],hi[k][1],hi[k][2],hi[k][3]}
    o[d0]=__builtin_amdgcn_mfma_f32_32x32x16_bf16(pa0,PK(0),o[d0],0,0,0);
    o[d0]=__builtin_amdgcn_mfma_f32_32x32x16_bf16(pa1,PK(1),o[d0],0,0,0);
    o[d0]=__builtin_amdgcn_mfma_f32_32x32x16_bf16(pa2,PK(2),o[d0],0,0,0);
    o[d0]=__builtin_amdgcn_mfma_f32_32x32x16_bf16(pa3,PK(3),o[d0],0,0,0);
    #undef PK
  }
}
__device__ __forceinline__ float bfl(short s){return __uint_as_float(((unsigned)(unsigned short)s)<<16);}

__device__ __forceinline__ void moba_unit(int tid_in,int b,int h,int qb,bf16raw*P,const float*KM,char*shm,int ocol=COLQ){
  int tid=tid_in; asm volatile("":"+v"(tid));
  const int lane=tid&63,r32=lane&31,hi=lane>>5; const int wid=__builtin_amdgcn_readfirstlane(tid>>6);
  const long rowbase=(long)b*SEQL; const int q0=qb*QB;
  bf16raw*Qw=P+(rowbase+q0+wid*QBLK)*DM+COLQ+h*HDIM;
  const bf16raw*Kh=P+rowbase*DM+COLK+h*HDIM,*Vh=P+rowbase*DM+COLV+h*HDIM;
  const unsigned lds0=(unsigned)(uintptr_t)shm;
  float*wsf=(float*)(shm+LDS_WS)+wid*64;
  bf16x8 qr[4];
  #pragma unroll
  for(int d0=0;d0<4;++d0)qr[d0]=*reinterpret_cast<const bf16x8*>(&Qw[(long)r32*DM+d0*16+hi*8]);
  unsigned selbits=(1u<<qb)-1u;
  if(qb>3){
    float*kml=(float*)(shm+LDS_KM);
    { const float*src=KM+(long)((b*NHEAD+h)*16)*HDIM; const f32x2_t v=*(const f32x2_t*)(src+2*tid); *(f32x2_t*)(kml+2*tid)=v; }
    asm volatile("s_waitcnt vmcnt(0) lgkmcnt(0)\n\ts_barrier":::"memory");
    float qf[32];
    #pragma unroll
    for(int d0=0;d0<4;++d0)
      #pragma unroll
      for(int e=0;e<8;++e)qf[d0*8+e]=bfl(qr[d0][e]);
    float g0=-INFINITY,g1=-INFINITY,g2=-INFINITY; int s0=0,s1=0,s2=0;
    for(int jb=0;jb<qb;++jb){
      const float*kr=kml+jb*64+hi*8; float g=0.f;
      #pragma unroll
      for(int d0=0;d0<4;++d0){ const f32x2_t*k2=(const f32x2_t*)(kr+d0*16);
        #pragma unroll
        for(int e=0;e<4;++e){ const f32x2_t kv=k2[e]; g+=qf[d0*8+2*e]*kv.x; g+=qf[d0*8+2*e+1]*kv.y; } }
      {auto rr=__builtin_amdgcn_permlane32_swap(__float_as_uint(g),__float_as_uint(g),false,false);g=__uint_as_float(rr[0])+__uint_as_float(rr[1]);}
      if(g>g0){g2=g1;s2=s1;g1=g0;s1=s0;g0=g;s0=jb;} else if(g>g1){g2=g1;s2=s1;g1=g;s1=jb;} else if(g>g2){g2=g;s2=jb;}
    }
    selbits=(1u<<s0)|(1u<<s1)|(1u<<s2);
  }
  #define TMASK(t) (((t)<4)?0xffffffffu:(0u-((selbits>>(((t)-4)>>2))&1u)))
  const bf16raw*ksrc=Kh+(long)lane*DM+wid*8;
  const bf16raw*vsrc=Vh+(long)(16*(wid&3)+(lane>>2))*DM+(wid>>2)*32+(lane&3)*8;
  const unsigned kdst=lds0+LDS_K+wid*1024, vdst=lds0+LDS_V+wid*1024;
  #define KT(t) (((t)<4)?(4*qb+(t)):((t)-4))
  #define DMA_K(t,slot) glds16(ksrc+(long)KT(t)*KVBLK*DM,(unsigned)__builtin_amdgcn_readfirstlane(kdst+(slot)))
  #define DMA_V(t,slot) glds16(vsrc+(long)KT(t)*KVBLK*DM,(unsigned)__builtin_amdgcn_readfirstlane(vdst+(slot)))
  const char*Kbase=shm+LDS_K; bf16x8 kf[8];
  const lds_cptr shm3=(lds_cptr)shm; const lds_cptr kp0=shm3+LDS_K+hi*1024+r32*16; const lds_cptr vp0=shm3+LDS_V+((lane>>4)&1)*32+(lane&3)*8+(4*hi+((lane&15)>>2))*64;
  const int vb0=(int)(lds0+LDS_V)+((lane>>4)&1)*32+(lane&3)*8+(4*hi+((lane&15)>>2))*64;
  const int NT=4*qb+4;
  DMA_K(0,0);DMA_V(0,0);DMA_K(1,SLOTB);
  float l_reg=0.f;f32x16 o[2];o[0]=f32x16{};o[1]=f32x16{};
  const int qrel=wid*QBLK+r32;
  f32x16 pA0,pA1,pB0,pB1;
  int sl_prev=0,sl_cur=0,sl_next=SLOTB;
  #define ROT() do{sl_prev=sl_cur;sl_cur=sl_next;sl_next=(sl_next==(NSLOT-1)*SLOTB)?0:sl_next+SLOTB;}while(0)
  DMA_K(2,2*SLOTB);
  WAIT_BAR(3);
  qkt(pA0,pA1,Kbase,qr,r32,hi);asm volatile("s_nop 15\n\ts_nop 7":"+v"(pA0),"+v"(pA1));cmask(pA0,pA1,0,qrel,hi);
  _Pragma("unroll") for(int r=0;r<16;++r){pA0[r]=__builtin_amdgcn_exp2f(pA0[r]);pA1[r]=__builtin_amdgcn_exp2f(pA1[r]);}
  WAIT_BAR(0);
  DMA_K(3,0);DMA_V(1,SLOTB);
  ROT();
  kload8(kf,kp0+sl_cur);
  WAIT_BAR(2);
  s16x4 vlo[8],vhi[8]; u32x4 pw0,pw1,pw2,pw3;
  const f32x16 zf=f32x16{};
  #define PKW(P,B) (cvtpk_s(P[B],P[B+1])&mprev_)
  #define PAF(k) __builtin_bit_cast(bf16x8,pw##k)
  #define VFR(i) (bf16x8){vlo[i][0],vlo[i][1],vlo[i][2],vlo[i][3],vhi[i][0],vhi[i][1],vhi[i][2],vhi[i][3]}
  #define PIN(x) asm volatile("":"+v"(x))
  #define GAPA(MF,A0,A1,A2,A3,W0,W1,PW) do{ MF; sacc+=A0; sacc+=A1; sacc+=A2; sacc+=A3; PIN(sacc); W0; W1; PIN(PW); SBAR(); }while(0)
  #define EX(v) __builtin_amdgcn_exp2f(v)
  #define GAPB(MF,X,B) do{ MF; X[B]=EX(X[B]); X[B+1]=EX(X[B+1]); X[B+2]=EX(X[B+2]); X[B+3]=EX(X[B+3]); PIN(X); SBAR(); }while(0)
  #define VRD(i) do{ vlo[i]=vtr(vp_+(((i)>>2)*4096+((i)&3)*1024)); vhi[i]=vtr(vp_+(((i)>>2)*4096+((i)&3)*1024+512)); }while(0)
  #define KRD(G,j) do{ if(G){ kload2(kf,kp0+sl_next,j); SBAR(); } }while(0)
  #define STEP(C0,C1,P0,P1,t,GK,GV,GL,CM) do{ SBAR(); \
    const unsigned mprev_=TMASK((t)-1); \
    const lds_cptr vp_=vp0+sl_prev; \
    VRD(0); SBAR(); float sacc=(P0[0]+P0[1]); \
    GAPA(C0=__builtin_amdgcn_mfma_f32_32x32x16_bf16(kf[0],qr[0],zf,0,0,0), P0[2],P0[3],P0[4],P0[5],     pw0[0]=PKW(P0,0), pw0[1]=PKW(P0,2), pw0); \
    VRD(4); SBAR(); GAPA(C1=__builtin_amdgcn_mfma_f32_32x32x16_bf16(kf[1],qr[0],zf,0,0,0), P0[6],P0[7],P0[8],P0[9],     pw0[2]=PKW(P0,4), pw0[3]=PKW(P0,6), pw0); \
    VRD(1); SBAR(); GAPA(C0=__builtin_amdgcn_mfma_f32_32x32x16_bf16(kf[2],qr[1],C0,0,0,0),   P0[10],P0[11],P0[12],P0[13], pw1[0]=PKW(P0,8), pw1[1]=PKW(P0,10), pw1); \
    VRD(5); SBAR(); GAPA(C1=__builtin_amdgcn_mfma_f32_32x32x16_bf16(kf[3],qr[1],C1,0,0,0),   P0[14],P0[15],P1[0],P1[1],   pw1[2]=PKW(P0,12),pw1[3]=PKW(P0,14), pw1); \
    VRD(2); SBAR(); GAPA(C0=__builtin_amdgcn_mfma_f32_32x32x16_bf16(kf[4],qr[2],C0,0,0,0),   P1[2],P1[3],P1[4],P1[5],     pw2[0]=PKW(P1,0), pw2[1]=PKW(P1,2), pw2); \
    VRD(6); SBAR(); GAPA(C1=__builtin_amdgcn_mfma_f32_32x32x16_bf16(kf[5],qr[2],C1,0,0,0),   P1[6],P1[7],P1[8],P1[9],     pw2[2]=PKW(P1,4), pw2[3]=PKW(P1,6), pw2); \
    VRD(3); SBAR(); GAPA(C0=__builtin_amdgcn_mfma_f32_32x32x16_bf16(kf[6],qr[3],C0,0,0,0),   P1[10],P1[11],P1[12],P1[13], pw3[0]=PKW(P1,8), pw3[1]=PKW(P1,10), pw3); \
    VRD(7); SBAR(); GAPA(C1=__builtin_amdgcn_mfma_f32_32x32x16_bf16(kf[7],qr[3],C1,0,0,0),   P1[14],P1[15],0.f,0.f,       pw3[2]=PKW(P1,12),pw3[3]=PKW(P1,14), pw3); \
    l_reg+=__uint_as_float(__float_as_uint(sacc)&mprev_); \
    if(GK){DMA_K((t)+3,sl_cur);} if(GV){DMA_V((t)+1,sl_next);} \
    if(CM){cmask(C0,C1,(t),qrel,hi);} \
    SBAR(); \
    GAPB(o[0]=__builtin_amdgcn_mfma_f32_32x32x16_bf16(PAF(0),VFR(0),o[0],0,0,0), C0,0); \
    GAPB(o[1]=__builtin_amdgcn_mfma_f32_32x32x16_bf16(PAF(0),VFR(4),o[1],0,0,0), C0,4); \
    KRD(GL,0); GAPB(o[0]=__builtin_amdgcn_mfma_f32_32x32x16_bf16(PAF(1),VFR(1),o[0],0,0,0), C0,8); \
    KRD(GL,1); GAPB(o[1]=__builtin_amdgcn_mfma_f32_32x32x16_bf16(PAF(1),VFR(5),o[1],0,0,0), C0,12); \
    KRD(GL,2); GAPB(o[0]=__builtin_amdgcn_mfma_f32_32x32x16_bf16(PAF(2),VFR(2),o[0],0,0,0), C1,0); \
    KRD(GL,3); GAPB(o[1]=__builtin_amdgcn_mfma_f32_32x32x16_bf16(PAF(2),VFR(6),o[1],0,0,0), C1,4); \
    GAPB(o[0]=__builtin_amdgcn_mfma_f32_32x32x16_bf16(PAF(3),VFR(3),o[0],0,0,0), C1,8); \
    GAPB(o[1]=__builtin_amdgcn_mfma_f32_32x32x16_bf16(PAF(3),VFR(7),o[1],0,0,0), C1,12); \
    }while(0)
  #define ENDW(tt) do{ if((tt)+3<NT){WAIT_BAR(2);} else if((tt)+2<NT){WAIT_BAR(1);} else {WAIT_BAR(0);} }while(0)
  STEP(pB0,pB1,pA0,pA1,1,(4<NT),true,true,true);          ENDW(1); ROT();
  STEP(pA0,pA1,pB0,pB1,2,(5<NT),true,true,true);          ENDW(2); ROT();
  STEP(pB0,pB1,pA0,pA1,3,(6<NT),(4<NT),(4<NT),true);
  if(NT>4){
    ENDW(3); ROT();
    int t=4;
    for(;t+5<NT;t+=2){
      STEP(pA0,pA1,pB0,pB1,t,true,true,true,false);     WAIT_BAR(2); ROT();
      STEP(pB0,pB1,pA0,pA1,t+1,true,true,true,false);   WAIT_BAR(2); ROT();
    }
    for(;t+2<NT;t+=2){
      STEP(pA0,pA1,pB0,pB1,t,(t+3<NT),(t+1<NT),(t+1<NT),false);       ENDW(t);   ROT();
      STEP(pB0,pB1,pA0,pA1,t+1,(t+4<NT),(t+2<NT),(t+2<NT),false);     ENDW(t+1); ROT();
    }
    STEP(pA0,pA1,pB0,pB1,t,false,true,true,false);      ENDW(t); ROT();
    STEP(pB0,pB1,pA0,pA1,t+1,false,false,false,false);
  }
  { const unsigned mprev_=TMASK(NT-1);
    float sacc=pB0[0]+pB0[1]; _Pragma("unroll") for(int r=2;r<16;++r)sacc+=pB0[r]; _Pragma("unroll") for(int r=0;r<16;++r)sacc+=pB1[r]; l_reg+=__uint_as_float(__float_as_uint(sacc)&mprev_);
    pw0=(u32x4){PKW(pB0,0),PKW(pB0,2),PKW(pB0,4),PKW(pB0,6)};pw1=(u32x4){PKW(pB0,8),PKW(pB0,10),PKW(pB0,12),PKW(pB0,14)};pw2=(u32x4){PKW(pB1,0),PKW(pB1,2),PKW(pB1,4),PKW(pB1,6)};pw3=(u32x4){PKW(pB1,8),PKW(pB1,10),PKW(pB1,12),PKW(pB1,14)};
    SBAR(); pv(o,vb0+sl_cur,PAF(0),PAF(1),PAF(2),PAF(3)); }
  #undef PKW
  #undef PAF
  #undef VFR
  #undef PIN
  #undef GAPA
  #undef GAPB
  #undef EX
  #undef VRD
  #undef KRD
  #undef STEP
  #undef ENDW
  {auto rr=__builtin_amdgcn_permlane32_swap(__float_as_uint(l_reg),__float_as_uint(l_reg),false,false);l_reg=__uint_as_float(rr[0])+__uint_as_float(rr[1]);}
  if(hi==0)wsf[32+r32]=l_reg;asm volatile("s_waitcnt lgkmcnt(0)":::"memory");
  float rli[16];
  #pragma unroll
  for(int r=0;r<16;++r)rli[r]=__builtin_amdgcn_rcpf(wsf[32+crow(r,hi)]);
  { bf16raw*stg=(bf16raw*)(shm+LDS_OST)+wid*2048;
    #pragma unroll
    for(int r=0;r<16;++r){const int orow=crow(r,hi);
      #pragma unroll
      for(int d0=0;d0<2;++d0)stg[orow*64+d0*32+r32]=(bf16raw)(cvtpk_s(o[d0][r]*rli[r],0.f)&0xffffu);}
    asm volatile("s_waitcnt lgkmcnt(0)":::"memory");
    #pragma unroll
    for(int i=0;i<4;++i){const int row=i*8+(lane>>3),ch=lane&7; const u32x4 v=*(const u32x4*)(stg+row*64+ch*8); *(u32x4*)(Qw+(ocol-COLQ)+(long)row*DM+ch*8)=v;} }
  asm volatile("s_waitcnt lgkmcnt(0)\n\ts_barrier":::"memory");
  #undef DMA_K
  #undef DMA_V
  #undef KT
  #undef TMASK
  #undef ROT
}
#undef SBAR
#undef WAIT_BAR
}

constexpr int NWAVES = 8, NTHR = NWAVES * 64;
#ifndef MK_ONE_LAUNCH
#define MK_ONE_LAUNCH 1
#endif
constexpr int BATCH = 8, SEQ = 4096, D = 1024, M = BATCH * SEQ;
constexpr int NCOL = 7168;
constexpr int C_XA = 0, C_BA = 512, C_CA = 1024, C_Q = 1536, C_K = 2048, C_V = 2560, C_XC = 3072, C_GC = 3584, C_G = 4096;
constexpr int NH = 8, HD = 64, BLK = 256, NBLK = SEQ / BLK;
constexpr int DFF = 2816, EFF = 3584, NEXP = 8;
constexpr int LCH = 64, NCH = SEQ / LCH;
constexpr float EPS = 1e-6f;
constexpr float QSCALE = 0.18033688011112042f;
constexpr int MOE_DOWN_COST = 3;
constexpr int MOE_TILES = 136, MOE_ROWS = MOE_TILES * 256;
constexpr int N_PHASES = 20;

constexpr size_t MiB = 1u << 20;
constexpr size_t WS_CTL = 0, CTL_ZERO_BYTES = 1 * MiB;
constexpr size_t WS_ROPE = 1 * MiB;
constexpr size_t WS_KMEAN = 1 * MiB + 256 * 1024;
constexpr size_t WS_SUM = 2 * MiB;
constexpr size_t WS_TOK = 4 * MiB;
constexpr size_t WS_WL = 6 * MiB;
constexpr size_t WS_ROWTOK = 8 * MiB;
constexpr size_t WS_ROWW = 8 * MiB + 512 * 1024;
constexpr size_t WS_XB = 9 * MiB;
constexpr size_t WS_WIN = 73 * MiB;
constexpr size_t WS_WOABC = 87 * MiB;
constexpr size_t WS_WO = 90 * MiB;
constexpr size_t WS_FGU = 92 * MiB;
constexpr size_t WS_FDN = 103 * MiB;
constexpr size_t WS_P = 109 * MiB;
constexpr size_t WS_HID0 = WS_P;
constexpr float SC_X8 = 8.f, SC_W8 = 64.f, SC_H8 = 8.f;
constexpr size_t WS_MGU = 73 * MiB;
constexpr size_t WS_MDN = 129 * MiB;
constexpr size_t WS_MH = 157 * MiB;
constexpr size_t MH_LIST = (size_t)MOE_ROWS * EFF, XG_LIST = (size_t)MOE_ROWS * D;
constexpr size_t WS_XG = 395 * MiB;
constexpr size_t WS_END = 557 * MiB;
static_assert(WS_P + (size_t)M * NCOL * 2 <= WS_END && WS_XG + 2 * XG_LIST <= WS_END && WS_MH + 2 * MH_LIST <= WS_XG && (size_t)2 * MOE_ROWS * 4 <= 512 * 1024 && WS_MGU + (size_t)8 * 7168 * D <= WS_MDN && WS_MDN + (size_t)8 * D * EFF <= WS_MH && WS_FDN + (size_t)D * DFF * 2 <= WS_P, "d_ws map");
constexpr int CW_BAR = 4096;
constexpr int CW_CNT = 16384;

constexpr int RING_BYTES = 131072;
constexpr int MISC_OFF = 147456 - 256;
constexpr int LDS_BYTES = 147456;

struct Args { const float* in[25]; float* out; unsigned char* ws; int ph_lo, ph_hi; };
struct Ctx { LAS unsigned char* lds; int tid, lane, wave, bid, G; };

__device__ __forceinline__ float shx(float v, int o, int lane) { return __int_as_float(__builtin_amdgcn_ds_bpermute((lane ^ o) << 2, __float_as_int(v))); }
__device__ __forceinline__ float wave_sum(float v, int lane) {
#pragma unroll
    for (int o = 1; o < 64; o <<= 1) v += shx(v, o, lane);
    return v;
}

struct ConvJob { const float* W; int ldw; bf16* WT; int ldk, k0, n0, dst; bool f8; };
__device__ __forceinline__ void conv_load(const ConvJob& j, float (&tv)[32], int lane) {
#pragma unroll
    for (int i = 0; i < 32; ++i) tv[i] = j.W[(size_t)(j.k0 + 2 * i + (lane >> 5)) * j.ldw + j.n0 + (lane & 31)];
}
__device__ __forceinline__ void conv_store(const ConvJob& j, const float (&tv)[32], LAS float* scr, int lane) {
#pragma unroll
    for (int i = 0; i < 32; ++i) scr[(2 * i + (lane >> 5)) * 33 + (lane & 31)] = tv[i];
    LDS_WAIT(); asm volatile("" ::: "memory");
    const int c = lane & 7;
#pragma unroll
    for (int q = 0; q < 4; ++q) { const int n = (lane >> 3) + 8 * q; const LAS float* s = scr + (8 * c) * 33 + n;
        v4u o; o.x = pk2(s[0 * 33], s[1 * 33]); o.y = pk2(s[2 * 33], s[3 * 33]); o.z = pk2(s[4 * 33], s[5 * 33]); o.w = pk2(s[6 * 33], s[7 * 33]);
        *(GAS v4u*)(j.WT + (size_t)(j.dst + n) * j.ldk + j.k0 + 8 * c) = o; }
    LDS_WAIT(); asm volatile("" ::: "memory");
}
__device__ __forceinline__ void conv_store8(const ConvJob& j, const float (&tv)[32], LAS float* scr, int lane) {
#pragma unroll
    for (int i = 0; i < 32; ++i) scr[(2 * i + (lane >> 5)) * 33 + (lane & 31)] = tv[i];
    LDS_WAIT(); asm volatile("" ::: "memory");
    const int c = lane & 3; unsigned char* WT8 = (unsigned char*)j.WT;
#pragma unroll
    for (int q = 0; q < 2; ++q) { const int n = (lane >> 2) + 16 * q; const LAS float* s = scr + (16 * c) * 33 + n;
        v4u o; o.x = pk4_fp8(s[0 * 33] * SC_W8, s[1 * 33] * SC_W8, s[2 * 33] * SC_W8, s[3 * 33] * SC_W8); o.y = pk4_fp8(s[4 * 33] * SC_W8, s[5 * 33] * SC_W8, s[6 * 33] * SC_W8, s[7 * 33] * SC_W8);
        o.z = pk4_fp8(s[8 * 33] * SC_W8, s[9 * 33] * SC_W8, s[10 * 33] * SC_W8, s[11 * 33] * SC_W8); o.w = pk4_fp8(s[12 * 33] * SC_W8, s[13 * 33] * SC_W8, s[14 * 33] * SC_W8, s[15 * 33] * SC_W8);
        *(GAS v4u*)(WT8 + (size_t)(j.dst + n) * j.ldk + j.k0 + 16 * c) = o; }
    LDS_WAIT(); asm volatile("" ::: "memory");
}
__device__ __forceinline__ ConvJob conv_job(const float* W, int K, int N, bf16* WT, int mode, int item, bool f8 = false) {
    const int nblk = N / 32, kb = item / nblk, nb = item - kb * nblk, k0 = 64 * kb, n0 = 32 * nb;
    const int dst = mode == 0 ? n0 : (n0 >> 7) * 256 + (n0 & 127) + (mode == 2 ? 128 : 0);
    return ConvJob{W, N, WT, K, k0, n0, dst, f8};
}
__device__ __forceinline__ ConvJob layer_job(const Args& A, int l, int it) {
    constexpr int I_IN = 16 * 224, I_A = 8 * 32, I_O = 16 * 32, I_G = 16 * 88;
    unsigned char* ws = A.ws; int r = it;
    if (r < I_IN) { const bool gate = (r % 224) >= 128;
        return gate ? conv_job(A.in[2] + (size_t)l * D * NCOL, D, NCOL, (bf16*)(ws + WS_WIN + (size_t)4096 * D), 0, r, true) : conv_job(A.in[2] + (size_t)l * D * NCOL, D, NCOL, (bf16*)(ws + WS_WIN), 0, r); } r -= I_IN;
    if (r < I_A) return conv_job(A.in[4] + (size_t)l * 512 * D, 512, D, (bf16*)(ws + WS_WOABC), 0, r); r -= I_A;
    if (r < I_A) return conv_job(A.in[7] + (size_t)l * 512 * D, 512, D, (bf16*)(ws + WS_WOABC) + 1024 * 512, 0, r); r -= I_A;
    if (r < I_A) return conv_job(A.in[15] + (size_t)l * 512 * D, 512, D, (bf16*)(ws + WS_WOABC) + 2 * 1024 * 512, 0, r); r -= I_A;
    if (r < I_O) return conv_job(A.in[16] + (size_t)l * D * D, D, D, (bf16*)(ws + WS_WO), 0, r); r -= I_O;
    if (r < I_G) return conv_job(A.in[18], D, DFF, (bf16*)(ws + WS_FGU), 1, r); r -= I_G;
    if (r < I_G) return conv_job(A.in[19], D, DFF, (bf16*)(ws + WS_FGU), 2, r); r -= I_G;
    return conv_job(A.in[20], DFF, D, (bf16*)(ws + WS_FDN), 0, r);
}
__device__ __forceinline__ void convert_layer_weights(const Ctx& C, const Args& A, int l) {
    LAS float* scr = (LAS float*)(C.lds + C.wave * 16896);
    const int gw = C.bid * NWAVES + C.wave, NGW = C.G * NWAVES;
    constexpr int I_IN = 16 * 224, I_A = 8 * 32, I_O = 16 * 32, I_G = 16 * 88, I_D = 44 * 32;
    const int nitems = I_IN + 3 * I_A + I_O + (l == 0 ? 2 * I_G + I_D : 0);
    for (int it = gw; it < nitems; it += 2 * NGW) {
        const bool two = it + NGW < nitems;
        const ConvJob j0 = layer_job(A, l, it), j1 = layer_job(A, l, two ? it + NGW : it);
        float t0[32], t1[32];
        conv_load(j0, t0, C.lane); if (two) conv_load(j1, t1, C.lane);
        if (j0.f8) conv_store8(j0, t0, scr, C.lane); else conv_store(j0, t0, scr, C.lane);
        if (two) { if (j1.f8) conv_store8(j1, t1, scr + 64 * 33, C.lane); else conv_store(j1, t1, scr + 64 * 33, C.lane); }
    }
}
__device__ __forceinline__ ConvJob moe_job(const Args& A, int it) {
    constexpr int I_G = 16 * 112, I_D = 56 * 32, PER_E = 2 * I_G + I_D;
    unsigned char* ws = A.ws; const int e = it / PER_E; int r = it - e * PER_E;
    if (r < I_G) return conv_job(A.in[22] + (size_t)e * D * EFF, D, EFF, (bf16*)(ws + WS_MGU + (size_t)e * 7168 * D), 1, r); r -= I_G;
    if (r < I_G) return conv_job(A.in[23] + (size_t)e * D * EFF, D, EFF, (bf16*)(ws + WS_MGU + (size_t)e * 7168 * D), 2, r); r -= I_G;
    return conv_job(A.in[24] + (size_t)e * EFF * D, EFF, D, (bf16*)(ws + WS_MDN + (size_t)e * D * EFF), 0, r);
}
__device__ __forceinline__ void convert_moe_weights(const Ctx& C, const Args& A) {
    LAS float* scr = (LAS float*)(C.lds + C.wave * 16896);
    const int gw = C.bid * NWAVES + C.wave, NGW = C.G * NWAVES;
    constexpr int NIT = NEXP * (2 * 16 * 112 + 56 * 32);
    static_assert(NIT % 2 == 0, "items are taken in adjacent pairs");
    for (int it = 2 * gw; it < NIT; it += 2 * NGW) {
        const bool two = true;
        const ConvJob j0 = moe_job(A, it), j1 = moe_job(A, it + 1);
        float t0[32], t1[32];
        conv_load(j0, t0, C.lane); if (two) conv_load(j1, t1, C.lane);
        conv_store8(j0, t0, scr, C.lane); if (two) conv_store8(j1, t1, scr + 64 * 33, C.lane);
    }
}
__device__ __forceinline__ void rope_table(const Ctx& C, unsigned char* ws) {
    const double invf_rev[8] = {0.15915494309189535, 0.03086376340470123, 0.005985185712713705, 0.001160663641240061,
                                0.00022507907903927653, 4.364795279280289e-05, 8.464330808241401e-06, 1.6414262627950345e-06};
    float* ct = (float*)(ws + WS_ROPE); float* st = ct + SEQ * 8;
    for (int g = C.bid * NTHR + C.tid; g < SEQ * 8; g += C.G * NTHR) {
        const int pos = g >> 3, i = g & 7;
        double f = invf_rev[0];
#pragma unroll
        for (int k = 1; k < 8; ++k) f = (i == k) ? invf_rev[k] : f;
        double t = (double)pos * f; t -= floor(t);
        ct[g] = __builtin_amdgcn_cosf((float)t); st[g] = __builtin_amdgcn_sinf((float)t);
    }
}

template <bool ROUTE, bool ALSO8>
__device__ __forceinline__ void norm_rows(const Ctx& C, const float* xin, const float* gain, bf16* XN, const float* router, unsigned char* ws, unsigned char* X8 = nullptr) {
    constexpr int RB = 4;
    const int gw = C.bid * NWAVES + C.wave, NGW = C.G * NWAVES;
    LAS float* R = (LAS float*)C.lds;
    LAS int* rt_tok = (LAS int*)(C.lds + 32768); LAS int* rt_e = rt_tok + 256; LAS float* rt_w = (LAS float*)(rt_e + 256);
    if (ROUTE) { for (int i = C.tid; i < D * NEXP / 4; i += NTHR) ((LAS f32x4*)R)[i] = ((const f32x4*)router)[i];
                 for (int i = C.tid; i < 256; i += NTHR) rt_tok[i] = -1;
                 __syncthreads(); }
    f32x4 g[4];
#pragma unroll
    for (int j = 0; j < 4; ++j) g[j] = ((const f32x4*)gain)[C.lane + 64 * j];
    int slot = C.wave;
    for (int m0 = gw; m0 < M; m0 += RB * NGW) {
        f32x4 v[RB][4];
#pragma unroll
        for (int i = 0; i < RB; ++i) { const int m = m0 + i * NGW; if (m < M) { const GAS f32x4* xr = (const GAS f32x4*)(xin + (size_t)m * D) + C.lane;
#pragma unroll
            for (int j = 0; j < 4; ++j) v[i][j] = xr[64 * j]; } }
#pragma unroll
        for (int i = 0; i < RB; ++i) { const int m = m0 + i * NGW; if (m < M) {
            float s = 0.f;
#pragma unroll
            for (int j = 0; j < 4; ++j) s += (v[i][j].x * v[i][j].x + v[i][j].y * v[i][j].y) + (v[i][j].z * v[i][j].z + v[i][j].w * v[i][j].w);
            const float rstd = 1.0f / sqrtf(wave_sum(s, C.lane) * (1.f / D) + EPS);
            GAS unsigned long long* o8 = (GAS unsigned long long*)(XN + (size_t)m * D) + C.lane;
#pragma unroll
            for (int j = 0; j < 4; ++j) { v[i][j] = v[i][j] * rstd * g[j]; o8[64 * j] = (unsigned long long)pk2(v[i][j].x, v[i][j].y) | ((unsigned long long)pk2(v[i][j].z, v[i][j].w) << 32);
                if (ALSO8) ((unsigned*)(X8 + (size_t)m * D))[C.lane + 64 * j] = pk4_fp8(v[i][j].x * SC_X8, v[i][j].y * SC_X8, v[i][j].z * SC_X8, v[i][j].w * SC_X8); }
            if (ROUTE) {
                float lg[8];
#pragma unroll
                for (int e = 0; e < 8; ++e) lg[e] = 0.f;
#pragma unroll
                for (int j = 0; j < 4; ++j)
#pragma unroll
                    for (int k = 0; k < 4; ++k) { const int d = 4 * C.lane + k + 256 * j; const f32x4 r0 = *(LAS f32x4*)(R + d * 8), r1 = *(LAS f32x4*)(R + d * 8 + 4); const float h = v[i][j][k];
                        lg[0] += h * r0.x; lg[1] += h * r0.y; lg[2] += h * r0.z; lg[3] += h * r0.w; lg[4] += h * r1.x; lg[5] += h * r1.y; lg[6] += h * r1.z; lg[7] += h * r1.w; }
#pragma unroll
                for (int e = 0; e < 8; ++e) lg[e] = wave_sum(lg[e], C.lane);
                float l1 = -INFINITY, l2 = -INFINITY; int e1 = 0, e2 = 0;
#pragma unroll
                for (int e = 0; e < 8; ++e) if (lg[e] > l1) { l1 = lg[e]; e1 = e; }
#pragma unroll
                for (int e = 0; e < 8; ++e) if (e != e1 && lg[e] > l2) { l2 = lg[e]; e2 = e; }
                if (C.lane == 0 && slot < 256) { rt_tok[slot] = m; rt_e[slot] = e1 | (e2 << 8); rt_w[slot] = 1.0f / (1.0f + expf(l2 - l1)); }
                slot += NWAVES;
            } } }
    }
    if (ROUTE) {
        __syncthreads();
        if (C.tid < 16) {
            const int list = C.tid >> 3, e = C.tid & 7; int n = 0;
            for (int sidx = 0; sidx < 256; ++sidx) { const int t = rt_tok[sidx]; const int ee = (rt_e[sidx] >> (8 * list)) & 0xff; n += (t >= 0 && ee == e) ? 1 : 0; }
            gu32* cnt = (gu32*)(ws + WS_CTL) + CW_CNT; int* tokl = (int*)(ws + WS_TOK); float* wl = (float*)(ws + WS_WL);
            unsigned pos = n ? __hip_atomic_fetch_add(cnt + C.tid, (unsigned)n, RLX_AGENT) : 0u;
            for (int sidx = 0; sidx < 256; ++sidx) { const int t = rt_tok[sidx]; const int ee = (rt_e[sidx] >> (8 * list)) & 0xff;
                if (t >= 0 && ee == e) { const float w1 = rt_w[sidx]; tokl[(size_t)C.tid * M + pos] = t; wl[(size_t)C.tid * M + pos] = list == 0 ? w1 : 1.0f - w1; ++pos; } }
        }
        __syncthreads();
    }
}

template <bool ROUTE, bool ALSO8 = false>
__device__ __forceinline__ void norm_rows_b(const Ctx& C, const bf16* xin, const float* gain, bf16* XN, const float* router, unsigned char* ws, unsigned char* X8 = nullptr) {
    constexpr int RB = 4;
    const int gw = C.bid * NWAVES + C.wave, NGW = C.G * NWAVES;
    LAS float* R = (LAS float*)C.lds;
    LAS int* rt_tok = (LAS int*)(C.lds + 32768); LAS int* rt_e = rt_tok + 256; LAS float* rt_w = (LAS float*)(rt_e + 256);
    if (ROUTE) { for (int i = C.tid; i < D * NEXP / 4; i += NTHR) ((LAS f32x4*)R)[i] = ((const f32x4*)router)[i];
                 for (int i = C.tid; i < 256; i += NTHR) rt_tok[i] = -1;
                 __syncthreads(); }
    float g[16];
#pragma unroll
    for (int c = 0; c < 2; ++c) { const f32x4 a = *(const f32x4*)(gain + 512 * c + 8 * C.lane), b = *(const f32x4*)(gain + 512 * c + 8 * C.lane + 4);
        g[8 * c] = a.x; g[8 * c + 1] = a.y; g[8 * c + 2] = a.z; g[8 * c + 3] = a.w; g[8 * c + 4] = b.x; g[8 * c + 5] = b.y; g[8 * c + 6] = b.z; g[8 * c + 7] = b.w; }
    int slot = C.wave;
    for (int m0 = gw; m0 < M; m0 += RB * NGW) {
        v4u raw[RB][2];
#pragma unroll
        for (int i = 0; i < RB; ++i) { const int m = m0 + i * NGW; if (m < M) { const v4u* xr = (const v4u*)(xin + (size_t)m * D) + C.lane; raw[i][0] = xr[0]; raw[i][1] = xr[64]; } }
#pragma unroll
        for (int i = 0; i < RB; ++i) { const int m = m0 + i * NGW; if (m < M) {
            float v[16];
#pragma unroll
            for (int c = 0; c < 2; ++c) { const v4u w = raw[i][c]; v[8 * c] = bflo(w.x); v[8 * c + 1] = bfhi(w.x); v[8 * c + 2] = bflo(w.y); v[8 * c + 3] = bfhi(w.y); v[8 * c + 4] = bflo(w.z); v[8 * c + 5] = bfhi(w.z); v[8 * c + 6] = bflo(w.w); v[8 * c + 7] = bfhi(w.w); }
            float s = 0.f;
#pragma unroll
            for (int k = 0; k < 16; ++k) s += v[k] * v[k];
            const float rstd = 1.0f / sqrtf(wave_sum(s, C.lane) * (1.f / D) + EPS);
#pragma unroll
            for (int k = 0; k < 16; ++k) v[k] = v[k] * rstd * g[k];
            if (ROUTE) {
                v2u* o8 = (v2u*)((unsigned char*)XN + (size_t)m * D) + C.lane;
#pragma unroll
                for (int c = 0; c < 2; ++c) { v2u w; w.x = pk4_fp8(v[8 * c] * SC_X8, v[8 * c + 1] * SC_X8, v[8 * c + 2] * SC_X8, v[8 * c + 3] * SC_X8); w.y = pk4_fp8(v[8 * c + 4] * SC_X8, v[8 * c + 5] * SC_X8, v[8 * c + 6] * SC_X8, v[8 * c + 7] * SC_X8); o8[64 * c] = w; }
            } else {
            v4u* o = (v4u*)(XN + (size_t)m * D) + C.lane;
#pragma unroll
            for (int c = 0; c < 2; ++c) { v4u w; w.x = pk2(v[8 * c], v[8 * c + 1]); w.y = pk2(v[8 * c + 2], v[8 * c + 3]); w.z = pk2(v[8 * c + 4], v[8 * c + 5]); w.w = pk2(v[8 * c + 6], v[8 * c + 7]); o[64 * c] = w; }
            if (ALSO8) { v2u* o8 = (v2u*)(X8 + (size_t)m * D) + C.lane;
#pragma unroll
                for (int c = 0; c < 2; ++c) { v2u w; w.x = pk4_fp8(v[8 * c] * SC_X8, v[8 * c + 1] * SC_X8, v[8 * c + 2] * SC_X8, v[8 * c + 3] * SC_X8); w.y = pk4_fp8(v[8 * c + 4] * SC_X8, v[8 * c + 5] * SC_X8, v[8 * c + 6] * SC_X8, v[8 * c + 7] * SC_X8); o8[64 * c] = w; } }
            }
            if (ROUTE) {
                float lg[8];
#pragma unroll
                for (int e = 0; e < 8; ++e) lg[e] = 0.f;
#pragma unroll
                for (int c = 0; c < 2; ++c)
#pragma unroll
                    for (int k = 0; k < 8; ++k) { const int d = 512 * c + 8 * C.lane + k; const f32x4 r0 = *(LAS f32x4*)(R + d * 8), r1 = *(LAS f32x4*)(R + d * 8 + 4); const float h = v[8 * c + k];
                        lg[0] += h * r0.x; lg[1] += h * r0.y; lg[2] += h * r0.z; lg[3] += h * r0.w; lg[4] += h * r1.x; lg[5] += h * r1.y; lg[6] += h * r1.z; lg[7] += h * r1.w; }
#pragma unroll
                for (int e = 0; e < 8; ++e) lg[e] = wave_sum(lg[e], C.lane);
                float l1 = -INFINITY, l2 = -INFINITY; int e1 = 0, e2 = 0;
#pragma unroll
                for (int e = 0; e < 8; ++e) if (lg[e] > l1) { l1 = lg[e]; e1 = e; }
#pragma unroll
                for (int e = 0; e < 8; ++e) if (e != e1 && lg[e] > l2) { l2 = lg[e]; e2 = e; }
                if (C.lane == 0 && slot < 256) { rt_tok[slot] = m; rt_e[slot] = e1 | (e2 << 8); rt_w[slot] = 1.0f / (1.0f + expf(l2 - l1)); }
                slot += NWAVES;
            } } }
    }
    if (ROUTE) {
        __syncthreads();
        if (C.tid < 16) {
            const int list = C.tid >> 3, e = C.tid & 7; int n = 0;
            for (int sidx = 0; sidx < 256; ++sidx) { const int t = rt_tok[sidx]; const int ee = (rt_e[sidx] >> (8 * list)) & 0xff; n += (t >= 0 && ee == e) ? 1 : 0; }
            gu32* cnt = (gu32*)(ws + WS_CTL) + CW_CNT; int* tokl = (int*)(ws + WS_TOK); float* wl = (float*)(ws + WS_WL);
            unsigned pos = n ? __hip_atomic_fetch_add(cnt + C.tid, (unsigned)n, RLX_AGENT) : 0u;
            for (int sidx = 0; sidx < 256; ++sidx) { const int t = rt_tok[sidx]; const int ee = (rt_e[sidx] >> (8 * list)) & 0xff;
                if (t >= 0 && ee == e) { const float w1 = rt_w[sidx]; tokl[(size_t)C.tid * M + pos] = t; wl[(size_t)C.tid * M + pos] = list == 0 ? w1 : 1.0f - w1; ++pos; } }
        }
        __syncthreads();
    }
}

__device__ __forceinline__ void qk_item(const Ctx& C, const Args& A, int l, int item) {
    unsigned char* ws = A.ws; bf16* P = (bf16*)(ws + WS_P);
    const float* ct = (const float*)(ws + WS_ROPE); const float* st = ct + SEQ * 8;
    const int rb = item >> 3, h = item & 7, ch = C.tid & 7, rg = C.tid >> 3;
    LAS float* part = (LAS float*)C.lds;
    for (int which = 0; which < 2; ++which) {
        const float* gn = A.in[which == 0 ? 5 : 6] + l * HD + ch * 8;
        const f32x4 ga = *(const f32x4*)gn, gb = *(const f32x4*)(gn + 4);
        const float gv[8] = {ga.x, ga.y, ga.z, ga.w, gb.x, gb.y, gb.z, gb.w};
        float ks[8];
#pragma unroll
        for (int j = 0; j < 8; ++j) ks[j] = 0.f;
        v4u wv[4]; f32x4 c0[4], c1[4], s0[4], s1[4];
#pragma unroll
        for (int pass = 0; pass < 4; ++pass) { const int row = rb * 256 + pass * 64 + rg, pos = row & (SEQ - 1);
            wv[pass] = *(const v4u*)(P + (size_t)row * NCOL + (which == 0 ? C_Q : C_K) + h * HD + ch * 8);
            c0[pass] = *(const f32x4*)(ct + pos * 8); c1[pass] = *(const f32x4*)(ct + pos * 8 + 4); s0[pass] = *(const f32x4*)(st + pos * 8); s1[pass] = *(const f32x4*)(st + pos * 8 + 4); }
#pragma unroll
        for (int pass = 0; pass < 4; ++pass) {
            const int row = rb * 256 + pass * 64 + rg;
            bf16* p = P + (size_t)row * NCOL + (which == 0 ? C_Q : C_K) + h * HD + ch * 8;
            const v4u w = wv[pass];
            float v[8] = {bflo(w.x), bfhi(w.x), bflo(w.y), bfhi(w.y), bflo(w.z), bfhi(w.z), bflo(w.w), bfhi(w.w)};
            const float cs8[8] = {c0[pass].x, c0[pass].y, c0[pass].z, c0[pass].w, c1[pass].x, c1[pass].y, c1[pass].z, c1[pass].w};
            const float sn8[8] = {s0[pass].x, s0[pass].y, s0[pass].z, s0[pass].w, s1[pass].x, s1[pass].y, s1[pass].z, s1[pass].w};
            float ss = 0.f;
#pragma unroll
            for (int j = 0; j < 8; ++j) ss += v[j] * v[j];
            ss += shx(ss, 1, C.lane); ss += shx(ss, 2, C.lane); ss += shx(ss, 4, C.lane);
            const float rstd = 1.0f / sqrtf(ss * (1.f / HD) + EPS);
#pragma unroll
            for (int j = 0; j < 8; ++j) v[j] = v[j] * rstd * gv[j];
#pragma unroll
            for (int j = 0; j < 8; ++j) {
                const float other = shx(v[j], 1, C.lane);
                const float rot = (ch == 0) ? (v[j] * cs8[j] - other * sn8[j]) : (v[j] * cs8[j] + other * sn8[j]);
                v[j] = (ch < 2) ? rot : v[j];
            }
            if (which == 0) {
#pragma unroll
                for (int j = 0; j < 8; ++j) v[j] *= QSCALE;
            } else {
#pragma unroll
                for (int j = 0; j < 8; ++j) ks[j] += v[j];
            }
            v4u o; o.x = pk2(v[0], v[1]); o.y = pk2(v[2], v[3]); o.z = pk2(v[4], v[5]); o.w = pk2(v[6], v[7]);
            *(v4u*)p = o;
        }
        if (which == 1) {
#pragma unroll
            for (int j = 0; j < 8; ++j) part[rg * 64 + ch * 8 + j] = ks[j];
            __syncthreads();
            if (C.tid < 64) { float s = 0.f;
#pragma unroll 16
                for (int r = 0; r < 64; ++r) s += part[r * 64 + C.tid];
                const int b = rb >> 4, blk = rb & 15;
                ((float*)(ws + WS_KMEAN))[(size_t)((b * NH + h) * NBLK + blk) * HD + C.tid] = s * (1.f / 256.f); }
            __syncthreads();
        }
    }
}
__device__ __forceinline__ void conva_tasks(const Ctx& C, const Args& A, int l) {
    bf16* P = (bf16*)(A.ws + WS_P); const float* cw = A.in[3] + l * 3 * 512;
    const int stride = C.G * NTHR;
    for (int g0 = C.bid * NTHR + C.tid; g0 < M * 64; g0 += 4 * stride) {
        v4u xa[4][3], ca[4][3], ba[4];
#pragma unroll
        for (int i = 0; i < 4; ++i) { const int g = g0 + i * stride; if (g < M * 64) { const int row = g >> 6, c = (g & 63) * 8, t = row & (SEQ - 1);
            const bf16* base = P + (size_t)row * NCOL + c;
#pragma unroll
            for (int k = 0; k < 3; ++k) { const int dt = 2 - k; if (t >= dt) { xa[i][k] = *(const v4u*)(base - (size_t)dt * NCOL + C_XA); ca[i][k] = *(const v4u*)(base - (size_t)dt * NCOL + C_CA); } else { xa[i][k] = (v4u){0u, 0u, 0u, 0u}; ca[i][k] = xa[i][k]; } }
            ba[i] = *(const v4u*)(base + C_BA); } }
#pragma unroll
        for (int i = 0; i < 4; ++i) { const int g = g0 + i * stride; if (g < M * 64) { const int row = g >> 6, c = (g & 63) * 8;
            float acc[8];
#pragma unroll
            for (int j = 0; j < 8; ++j) acc[j] = 0.f;
#pragma unroll
            for (int k = 0; k < 3; ++k) {
                const v4u x = xa[i][k], cc = ca[i][k];
                const f32x4 w0 = *(const f32x4*)(cw + k * 512 + c), w1 = *(const f32x4*)(cw + k * 512 + c + 4);
                acc[0] += w0.x * (bflo(x.x) * bflo(cc.x)); acc[1] += w0.y * (bfhi(x.x) * bfhi(cc.x)); acc[2] += w0.z * (bflo(x.y) * bflo(cc.y)); acc[3] += w0.w * (bfhi(x.y) * bfhi(cc.y));
                acc[4] += w1.x * (bflo(x.z) * bflo(cc.z)); acc[5] += w1.y * (bfhi(x.z) * bfhi(cc.z)); acc[6] += w1.z * (bflo(x.w) * bflo(cc.w)); acc[7] += w1.w * (bfhi(x.w) * bfhi(cc.w));
            }
            const v4u b = ba[i];
            v4u o; o.x = pk2(bflo(b.x) * acc[0], bfhi(b.x) * acc[1]); o.y = pk2(bflo(b.y) * acc[2], bfhi(b.y) * acc[3]);
            o.z = pk2(bflo(b.z) * acc[4], bfhi(b.z) * acc[5]); o.w = pk2(bflo(b.w) * acc[6], bfhi(b.w) * acc[7]);
            *(v4u*)(P + (size_t)row * NCOL + c + C_BA) = o; } }
    }
}
__device__ __forceinline__ void lru_pass1_phase(const Ctx& C, const Args& A, int l) {
    typedef pg8::bf16x8 bx8;
    unsigned char* ws = A.ws; const bf16* P = (const bf16*)(ws + WS_P);
    bf16* LA = (bf16*)A.out + (size_t)M * D; bf16* UU = LA + (size_t)M * 512;
    const int hb = C.wave, lane = C.lane, fr = lane & 15, fq = lane >> 4, c = hb * 64 + lane;
    bx8 wR[2][4], wI[2][4]; float bR[4], bI[4];
    { const float* wrp = A.in[10] + (size_t)l * 32768 + hb * 4096; const float* wip = A.in[12] + (size_t)l * 32768 + hb * 4096;
#pragma unroll
      for (int ks = 0; ks < 2; ++ks)
#pragma unroll
        for (int ct = 0; ct < 4; ++ct) { const int k0 = 32 * ks + 8 * fq, col = 16 * ct + fr; v4u a, b2;
            a.x = pk2(wrp[(k0 + 0) * 64 + col], wrp[(k0 + 1) * 64 + col]); a.y = pk2(wrp[(k0 + 2) * 64 + col], wrp[(k0 + 3) * 64 + col]);
            a.z = pk2(wrp[(k0 + 4) * 64 + col], wrp[(k0 + 5) * 64 + col]); a.w = pk2(wrp[(k0 + 6) * 64 + col], wrp[(k0 + 7) * 64 + col]);
            b2.x = pk2(wip[(k0 + 0) * 64 + col], wip[(k0 + 1) * 64 + col]); b2.y = pk2(wip[(k0 + 2) * 64 + col], wip[(k0 + 3) * 64 + col]);
            b2.z = pk2(wip[(k0 + 4) * 64 + col], wip[(k0 + 5) * 64 + col]); b2.w = pk2(wip[(k0 + 6) * 64 + col], wip[(k0 + 7) * 64 + col]);
            wR[ks][ct] = __builtin_bit_cast(bx8, a); wI[ks][ct] = __builtin_bit_cast(bx8, b2); }
#pragma unroll
      for (int ct = 0; ct < 4; ++ct) { bR[ct] = A.in[11][l * 512 + hb * 64 + 16 * ct + fr]; bI[ct] = A.in[13][l * 512 + hb * 64 + 16 * ct + fr]; } }
    const float lam = A.in[14][l * 512 + c];
    const float sp = log1pf(expf(-lam));
    const float* cw = A.in[8] + l * 4 * 512 + c; const float w0 = cw[0], w1 = cw[512], w2 = cw[1024], w3 = cw[1536], bc = A.in[9][l * 512 + c];
    LAS unsigned char* wl = C.lds + hb * 13312;
    LAS unsigned short* Xs = (LAS unsigned short*)wl; LAS unsigned* Gs = (LAS unsigned*)(wl + 4608);
    for (int item = C.bid; item < BATCH * NCH; item += C.G) {
        const int b = item >> 6, ci = item & 63;
        const size_t row0 = (size_t)b * SEQ + ci * LCH;
        const bf16* xcp = P + row0 * NCOL + C_XC + c;
        float x3 = 0.f, x2 = 0.f, x1 = 0.f;
        if (ci > 0) { x3 = bf2f(*(xcp - 3 * (size_t)NCOL)); x2 = bf2f(*(xcp - 2 * (size_t)NCOL)); x1 = bf2f(*(xcp - (size_t)NCOL)); }
        float Ap = 1.f, h = 0.f;
#pragma unroll 1
        for (int sub = 0; sub < 2; ++sub) {
            { bf16 xin[32];
#pragma unroll
              for (int r = 0; r < 32; ++r) xin[r] = xcp[(size_t)(sub * 32 + r) * NCOL];
#pragma unroll
              for (int r = 0; r < 32; ++r) { const float x0 = bf2f(xin[r]); const float xv = w0 * x3 + w1 * x2 + w2 * x1 + w3 * x0 + bc; x3 = x2; x2 = x1; x1 = x0; Xs[r * 72 + lane] = f2bf(xv); } }
            LDS_WAIT();
            pg8::f32x4 aR[2][4], aI[2][4];
#pragma unroll
            for (int rt = 0; rt < 2; ++rt)
#pragma unroll
                for (int ct = 0; ct < 4; ++ct) { aR[rt][ct] = (pg8::f32x4){0.f, 0.f, 0.f, 0.f}; aI[rt][ct] = (pg8::f32x4){0.f, 0.f, 0.f, 0.f}; }
#pragma unroll
            for (int rt = 0; rt < 2; ++rt)
#pragma unroll
                for (int ks = 0; ks < 2; ++ks) { const bx8 af = *(const LAS bx8*)(wl + (16 * rt + fr) * 144 + (32 * ks + 8 * fq) * 2);
#pragma unroll
                    for (int ct = 0; ct < 4; ++ct) { aR[rt][ct] = __builtin_amdgcn_mfma_f32_16x16x32_bf16(af, wR[ks][ct], aR[rt][ct], 0, 0, 0); aI[rt][ct] = __builtin_amdgcn_mfma_f32_16x16x32_bf16(af, wI[ks][ct], aI[rt][ct], 0, 0, 0); } }
#pragma unroll
            for (int rt = 0; rt < 2; ++rt)
#pragma unroll
                for (int ct = 0; ct < 4; ++ct)
#pragma unroll
                    for (int jj = 0; jj < 4; ++jj) Gs[(16 * rt + 4 * fq + jj) * 68 + 16 * ct + fr] = pk2(sigmoidf_(aR[rt][ct][jj] + bR[ct]), sigmoidf_(aI[rt][ct][jj] + bI[ct]));
            LDS_WAIT();
#pragma unroll 4
            for (int r = 0; r < 32; ++r) {
                const unsigned g = Gs[r * 68 + lane]; const float xv = bf2f(Xs[r * 72 + lane]);
                const float la = bfround(-8.0f * bflo(g) * sp), a = __expf(la), x2l = 2.0f * la;
                const float em = (x2l > -0.25f) ? -(x2l * (1.f + x2l * (0.5f + x2l * (0.16666667f + x2l * (0.041666668f + x2l * (0.0083333338f + x2l * 0.0013888889f)))))) : (1.0f - __expf(x2l));
                const float u = bfround(sqrtf(em) * (bfhi(g) * xv));
                Ap *= a; h = a * h + u;
                Gs[r * 68 + lane] = pk2(la, u);
            }
            LDS_WAIT();
#pragma unroll
            for (int q = 0; q < 4; ++q) { const int rr = (lane >> 3) + 8 * q, ch = lane & 7;
                const v4u w0 = *(const LAS v4u*)(Gs + rr * 68 + ch * 8), w1 = *(const LAS v4u*)(Gs + rr * 68 + ch * 8 + 4);
                v4u lo, hi;
                lo.x = (w0.x & 0xffffu) | (w0.y << 16); lo.y = (w0.z & 0xffffu) | (w0.w << 16); lo.z = (w1.x & 0xffffu) | (w1.y << 16); lo.w = (w1.z & 0xffffu) | (w1.w << 16);
                hi.x = (w0.x >> 16) | (w0.y & 0xffff0000u); hi.y = (w0.z >> 16) | (w0.w & 0xffff0000u); hi.z = (w1.x >> 16) | (w1.y & 0xffff0000u); hi.w = (w1.z >> 16) | (w1.w & 0xffff0000u);
                const size_t o = (row0 + sub * 32 + rr) * 512 + hb * 64 + ch * 8;
                *(v4u*)(LA + o) = lo; *(v4u*)(UU + o) = hi; }
            LDS_WAIT();
        }
        ((f32x2*)(ws + WS_SUM))[(size_t)(b * NCH + ci) * 512 + c] = (f32x2){Ap, h};
    }
}
__device__ __forceinline__ void lru_pass2_item(const Ctx& C, const Args& A, int item) {
    unsigned char* ws = A.ws; bf16* P = (bf16*)(ws + WS_P);
    const bf16* LA = (const bf16*)A.out + (size_t)M * D; const bf16* UU = LA + (size_t)M * 512;
    const int b = item >> 6, ci = item & 63, w = C.wave, lane = C.lane, c8 = lane * 8;
    LAS f32x4* comp = (LAS f32x4*)C.lds;
    LAS f32x4* loc = comp + 8 * 64 * 4;
    const size_t row0 = (size_t)b * SEQ + ci * LCH + w * 8;
    v4u la4[8], u4[8];
#pragma unroll
    for (int r = 0; r < 8; ++r) { la4[r] = *(const v4u*)(LA + (row0 + r) * 512 + c8); u4[r] = *(const v4u*)(UU + (row0 + r) * 512 + c8); }
    float fa[8], fh[8];
#pragma unroll
    for (int k = 0; k < 8; ++k) { fa[k] = 1.f; fh[k] = 0.f; }
    { const int clo = (ci * w) >> 3, chi = (ci * (w + 1)) >> 3;
      const f32x4* sm = (const f32x4*)(ws + WS_SUM) + ((size_t)(b * NCH) * 512 + c8) / 2;
      for (int cc = clo; cc < chi; ++cc) { const f32x4* s = sm + (size_t)cc * 256;
#pragma unroll
        for (int q = 0; q < 4; ++q) { const f32x4 v = s[q]; fh[2 * q] = v.x * fh[2 * q] + v.y; fa[2 * q] *= v.x; fh[2 * q + 1] = v.z * fh[2 * q + 1] + v.w; fa[2 * q + 1] *= v.z; } } }
#pragma unroll
    for (int q = 0; q < 4; ++q) comp[(w * 64 + lane) * 4 + q] = (f32x4){fa[2 * q], fh[2 * q], fa[2 * q + 1], fh[2 * q + 1]};
    float ta[8], th[8];
#pragma unroll
    for (int k = 0; k < 8; ++k) { ta[k] = 1.f; th[k] = 0.f; }
#pragma unroll
    for (int r = 0; r < 8; ++r) { const v4u lw = la4[r], uw = u4[r];
        const float l8[8] = {bflo(lw.x), bfhi(lw.x), bflo(lw.y), bfhi(lw.y), bflo(lw.z), bfhi(lw.z), bflo(lw.w), bfhi(lw.w)};
        const float u8[8] = {bflo(uw.x), bfhi(uw.x), bflo(uw.y), bfhi(uw.y), bflo(uw.z), bfhi(uw.z), bflo(uw.w), bfhi(uw.w)};
#pragma unroll
        for (int k = 0; k < 8; ++k) { const float a = __expf(l8[k]); ta[k] *= a; th[k] = a * th[k] + u8[k]; } }
#pragma unroll
    for (int q = 0; q < 4; ++q) loc[(w * 64 + lane) * 4 + q] = (f32x4){ta[2 * q], th[2 * q], ta[2 * q + 1], th[2 * q + 1]};
    __syncthreads();
#pragma unroll
    for (int r = 0; r < 8; ++r) asm volatile("" : "+v"(la4[r]), "+v"(u4[r]));
    v4u g4[8];
#pragma unroll
    for (int r = 0; r < 8; ++r) g4[r] = *(const v4u*)(P + (row0 + r) * NCOL + C_GC + c8);
    float h[8];
#pragma unroll
    for (int k = 0; k < 8; ++k) h[k] = 0.f;
#pragma unroll
    for (int ww = 0; ww < 8; ++ww)
#pragma unroll
        for (int q = 0; q < 4; ++q) { const f32x4 v = comp[(ww * 64 + lane) * 4 + q]; h[2 * q] = v.x * h[2 * q] + v.y; h[2 * q + 1] = v.z * h[2 * q + 1] + v.w; }
    for (int ww = 0; ww < w; ++ww)
#pragma unroll
        for (int q = 0; q < 4; ++q) { const f32x4 v = loc[(ww * 64 + lane) * 4 + q]; h[2 * q] = v.x * h[2 * q] + v.y; h[2 * q + 1] = v.z * h[2 * q + 1] + v.w; }
#pragma unroll
    for (int r = 0; r < 8; ++r) { const v4u lw = la4[r], uw = u4[r], gw = g4[r];
        const float l8[8] = {bflo(lw.x), bfhi(lw.x), bflo(lw.y), bfhi(lw.y), bflo(lw.z), bfhi(lw.z), bflo(lw.w), bfhi(lw.w)};
        const float u8[8] = {bflo(uw.x), bfhi(uw.x), bflo(uw.y), bfhi(uw.y), bflo(uw.z), bfhi(uw.z), bflo(uw.w), bfhi(uw.w)};
        const float g8[8] = {bflo(gw.x), bfhi(gw.x), bflo(gw.y), bfhi(gw.y), bflo(gw.z), bfhi(gw.z), bflo(gw.w), bfhi(gw.w)};
        float y[8];
#pragma unroll
        for (int k = 0; k < 8; ++k) { h[k] = __expf(l8[k]) * h[k] + u8[k]; const float x = g8[k]; y[k] = x * rcp_(1.0f + __expf(-1.5957691216f * (x + 0.044715f * x * x * x))) * h[k]; }
        v4u o; o.x = pk2(y[0], y[1]); o.y = pk2(y[2], y[3]); o.z = pk2(y[4], y[5]); o.w = pk2(y[6], y[7]);
        *(v4u*)(P + (row0 + r) * NCOL + C_GC + c8) = o; }
    __syncthreads();
}

struct PlainSched {
    pg8::TileOrder T; const char* A; const char* B; size_t tA, tB;
    __device__ __forceinline__ bool next(int i, pg8::Unit& u) const { int pm, pn; if (!T.map((long)i * T.G + T.c, pm, pn)) return false;
        u.pm = pm; u.pn = pn; u.a = A + (size_t)pm * tA; u.b = B + (size_t)pn * tB; u.x = 0; return true; }
    __device__ __forceinline__ void a_ready(const pg8::Unit&) const {}
    __device__ __forceinline__ void done(const pg8::Unit&) const {}
};
struct MergeSched {
    pg8::TileOrder T; const char* P; const char* W;
    __device__ __forceinline__ bool next(int i, pg8::Unit& u) const { const int ti = i / 3, br = i - 3 * ti; int pm, pn; if (!T.map((long)ti * T.G + T.c, pm, pn)) return false;
        const int colA = br == 0 ? C_BA : (br == 1 ? C_Q : C_GC);
        u.pm = pm; u.pn = pn; u.a = P + ((size_t)pm * 256 * NCOL + colA) * 2; u.b = W + ((size_t)br * 1024 * 512 + (size_t)pn * 256 * 512) * 2; u.x = br; return true; }
    __device__ __forceinline__ void a_ready(const pg8::Unit&) const {}
    __device__ __forceinline__ void done(const pg8::Unit&) const {}
};
struct MoeTiles {
    int nt[8]; int ntiles;
    __device__ __forceinline__ void init(const unsigned* cnt) { ntiles = 0;
#pragma unroll
        for (int e = 0; e < 8; ++e) { nt[e] = (int)((cnt[e] + 255u) >> 8); ntiles += nt[e]; } }
    __device__ __forceinline__ void locate(int pm, int& e, int& base) const { e = 0; base = 0; int cum = 0;
#pragma unroll
        for (int k = 0; k < 7; ++k) { cum += nt[k]; if (pm >= cum) { e = k + 1; base = cum; } } }
};
struct MoeSched {
    pg8::TileOrder T0, T1; const unsigned* cnt; int l0, first0, l1, first1;
    const char* A; size_t tA; const char* W; size_t eStride, tB; int skipE, skipR;
    __device__ __forceinline__ void init(const unsigned* cnt_, int nN, int G, int c, int l0_, int f0, int n0, int l1_, int f1, int n1) {
        cnt = cnt_; l0 = l0_; first0 = f0; l1 = l1_; first1 = f1; T0.init(n0, nN, G, c); T1.init(n1, nN, G, c); skipE = 0; skipR = 0; }
    __device__ __forceinline__ int nunits() const { return T0.nwg + T1.nwg; }
    __device__ __forceinline__ bool next(int i, pg8::Unit& u) const { int pm, pn, list;
        const int G = T0.G, c = T0.c, ge = G - skipE;
        const long L = (c < skipE) ? (long)skipR * ge + (long)i * G + c : (i < skipR ? (long)i * ge + (c - skipE) : (long)skipR * ge + (long)(i - skipR) * G + c);
        if (L < T0.nwg) { T0.map(L, pm, pn); pm += first0; list = l0; } else { if (!T1.map(L - T0.nwg, pm, pn)) return false; pm += first1; list = l1; }
        MoeTiles mt; mt.init(cnt + 8 * list); int e, base; mt.locate(pm, e, base);
        u.pm = list * MOE_TILES + pm; u.pn = pn; u.a = A + (size_t)u.pm * tA; u.b = W + (size_t)e * eStride + (size_t)pn * tB; u.x = e; return true; }
    __device__ __forceinline__ void a_ready(const pg8::Unit&) const {}
    __device__ __forceinline__ void done(const pg8::Unit&) const {}
};

struct EpiMerge {
    static constexpr bool PERM = true, AFTER_DRAIN = false, CHAIN = true;
    bf16* MG; const bf16* P;
    __device__ __forceinline__ void operator()(const pg8::f32x4 (&)[2][2][4][2], const pg8::Unit&, int, int, int, int) const {}
    __device__ __forceinline__ bool chain(pg8::f32x4 (&acc)[2][2][4][2], const pg8::Unit& u, int wr, int wc, int fr, int fq) const {
        const int br = u.x, row0 = u.pm * 256 + wr * 64 + fr, col0 = u.pn * 256 + wc * 32 + 8 * fq;
#pragma unroll
        for (int ai = 0; ai < 2; ++ai) {
            v4u gn[4][2], gd[4][2];
#pragma unroll
            for (int m = 0; m < 4; ++m)
#pragma unroll
                for (int bj = 0; bj < 2; ++bj) { const size_t row = (size_t)(row0 + ai * 128 + m * 16); const int col = col0 + bj * 128;
                    gn[m][bj] = *(const v4u*)(P + row * NCOL + C_G + br * 1024 + col);
                    gd[m][bj] = (br < 2) ? *(const v4u*)(P + row * NCOL + C_G + (br + 1) * 1024 + col) : (v4u){0u, 0u, 0u, 0u}; }
#pragma unroll
            for (int m = 0; m < 4; ++m)
#pragma unroll
                for (int bj = 0; bj < 2; ++bj) { const size_t row = (size_t)(row0 + ai * 128 + m * 16); const int col = col0 + bj * 128;
                    const v4u a = gn[m][bj], d = gd[m][bj];
                    const float an[8] = {bflo(a.x), bfhi(a.x), bflo(a.y), bfhi(a.y), bflo(a.z), bfhi(a.z), bflo(a.w), bfhi(a.w)};
                    const float dn[8] = {bflo(d.x), bfhi(d.x), bflo(d.y), bfhi(d.y), bflo(d.z), bfhi(d.z), bflo(d.w), bfhi(d.w)};
                    float f[8];
#pragma unroll
                    for (int k = 0; k < 8; ++k) f[k] = (br < 2) ? an[k] * rcp_(fmaxf(dn[k], 1e-30f)) : an[k];
                    pg8::f32x4& v0 = acc[ai][bj][m][0]; pg8::f32x4& v1 = acc[ai][bj][m][1];
                    v0[0] *= f[0]; v0[1] *= f[1]; v0[2] *= f[2]; v0[3] *= f[3]; v1[0] *= f[4]; v1[1] *= f[5]; v1[2] *= f[6]; v1[3] *= f[7];
                    if (br == 2) { v4u w; w.x = pk2(v0[0], v0[1]); w.y = pk2(v0[2], v0[3]); w.z = pk2(v1[0], v1[1]); w.w = pk2(v1[2], v1[3]); *(v4u*)(MG + row * D + col) = w; } }
            asm volatile("" ::: "memory");
        }
        return br < 2;
    }
};
template <bool BASE_F32>
struct EpiRes {
    static constexpr bool PERM = true, AFTER_DRAIN = false, CHAIN = false;
    const void* base; bf16* out;
    __device__ __forceinline__ void operator()(const pg8::f32x4 (&acc)[2][2][4][2], const pg8::Unit& u, int wr, int wc, int fr, int fq) const {
        const int row0 = u.pm * 256 + wr * 64 + fr, col0 = u.pn * 256 + wc * 32 + 8 * fq;
#pragma unroll
        for (int ai = 0; ai < 2; ++ai) {
            f32x4 b0[4][2], b1[4][2];
#pragma unroll
            for (int m = 0; m < 4; ++m)
#pragma unroll
                for (int bj = 0; bj < 2; ++bj) { const size_t off = (size_t)(row0 + ai * 128 + m * 16) * D + col0 + bj * 128;
                    if (BASE_F32) { b0[m][bj] = *(const f32x4*)((const float*)base + off); b1[m][bj] = *(const f32x4*)((const float*)base + off + 4); }
                    else { const v4u w = *(const v4u*)((const bf16*)base + off); b0[m][bj] = (f32x4){bflo(w.x), bfhi(w.x), bflo(w.y), bfhi(w.y)}; b1[m][bj] = (f32x4){bflo(w.z), bfhi(w.z), bflo(w.w), bfhi(w.w)}; } }
#pragma unroll
            for (int m = 0; m < 4; ++m)
#pragma unroll
                for (int bj = 0; bj < 2; ++bj) { const size_t off = (size_t)(row0 + ai * 128 + m * 16) * D + col0 + bj * 128;
                    const f32x4 r0 = b0[m][bj] + acc[ai][bj][m][0], r1 = b1[m][bj] + acc[ai][bj][m][1];
                    v4u w; w.x = pk2(r0[0], r0[1]); w.y = pk2(r0[2], r0[3]); w.z = pk2(r1[0], r1[1]); w.w = pk2(r1[2], r1[3]);
                    *(v4u*)(out + off) = w; }
            asm volatile("" ::: "memory");
        }
    }
};
struct EpiSwiGLU {
    static constexpr bool PERM = true, AFTER_DRAIN = false, CHAIN = false;
    bf16* H; int ldc;
    __device__ __forceinline__ void operator()(const pg8::f32x4 (&acc)[2][2][4][2], const pg8::Unit& u, int wr, int wc, int fr, int fq) const {
        const int row0 = u.pm * 256 + wr * 64 + fr, col0 = u.pn * 128 + wc * 32 + 8 * fq;
#pragma unroll
        for (int ai = 0; ai < 2; ++ai)
#pragma unroll
            for (int m = 0; m < 4; ++m) { const f32x4 g0 = acc[ai][0][m][0], g1 = acc[ai][0][m][1], u0 = acc[ai][1][m][0], u1 = acc[ai][1][m][1];
                v4u w; w.x = pk2(g0[0] * sigmoidf_(g0[0]) * u0[0], g0[1] * sigmoidf_(g0[1]) * u0[1]); w.y = pk2(g0[2] * sigmoidf_(g0[2]) * u0[2], g0[3] * sigmoidf_(g0[3]) * u0[3]);
                w.z = pk2(g1[0] * sigmoidf_(g1[0]) * u1[0], g1[1] * sigmoidf_(g1[1]) * u1[1]); w.w = pk2(g1[2] * sigmoidf_(g1[2]) * u1[2], g1[3] * sigmoidf_(g1[3]) * u1[3]);
                *(v4u*)(H + (size_t)(row0 + ai * 128 + m * 16) * ldc + col0) = w; }
    }
};
struct EpiSwiGLU8 {
    static constexpr bool PERM = true, AFTER_DRAIN = false, CHAIN = false;
    unsigned char* H; int ldc;
    __device__ __forceinline__ void operator()(const pg8::f32x4 (&acc)[2][2][4][2], const pg8::Unit& u, int wr, int wc, int fr, int fq) const {
        const int row0 = u.pm * 256 + wr * 64 + fr, colw = u.pn * 128 + wc * 32; constexpr float ds = 1.0f / (SC_X8 * SC_W8);
        const bool odd = (fq & 1) != 0;
        unsigned char* p = H + (size_t)(row0 + (odd ? 16 : 0)) * ldc + colw + 8 * (fq & ~1);
#pragma unroll
        for (int ai = 0; ai < 2; ++ai)
#pragma unroll
            for (int mp = 0; mp < 2; ++mp) {
                v2u x[2];
#pragma unroll
                for (int h = 0; h < 2; ++h) { const int m = 2 * mp + h;
                    const f32x4 g0 = acc[ai][0][m][0] * ds, g1 = acc[ai][0][m][1] * ds, u0 = acc[ai][1][m][0] * (ds * SC_H8), u1 = acc[ai][1][m][1] * (ds * SC_H8);
                    x[h].x = pk4_fp8(g0[0] * sigmoidf_(g0[0]) * u0[0], g0[1] * sigmoidf_(g0[1]) * u0[1], g0[2] * sigmoidf_(g0[2]) * u0[2], g0[3] * sigmoidf_(g0[3]) * u0[3]);
                    x[h].y = pk4_fp8(g1[0] * sigmoidf_(g1[0]) * u1[0], g1[1] * sigmoidf_(g1[1]) * u1[1], g1[2] * sigmoidf_(g1[2]) * u1[2], g1[3] * sigmoidf_(g1[3]) * u1[3]); }
                const auto sx = __builtin_amdgcn_permlane16_swap(x[0].x, x[1].x, false, false), sy = __builtin_amdgcn_permlane16_swap(x[0].y, x[1].y, false, false);
                v4u w; w.x = sx[0]; w.y = sy[0]; w.z = sx[1]; w.w = sy[1];
                *(v4u*)(p + (size_t)(ai * 128 + mp * 32) * ldc) = w; }
    }
};
template <bool OUT_F32, bool SIDE>
struct EpiScatter {
    static constexpr bool PERM = true, AFTER_DRAIN = false, CHAIN = false;
    const int* rowtok; const float* roww; const bf16* XB; void* out; float ds; float* side;
    __device__ __forceinline__ void operator()(const pg8::f32x4 (&acc)[2][2][4][2], const pg8::Unit& u, int wr, int wc, int fr, int fq) const {
        const int row0 = u.pm * 256 + wr * 64 + fr, col0 = u.pn * 256 + wc * 32 + 8 * fq;
        const bool sd = SIDE && u.pm >= MOE_TILES;
#pragma unroll
        for (int ai = 0; ai < 2; ++ai) {
            int tok[4]; float w[4]; v4u bw[4][2];
#pragma unroll
            for (int m = 0; m < 4; ++m) { const int gr = row0 + ai * 128 + m * 16; tok[m] = rowtok[gr]; w[m] = roww[gr] * ds; }
#pragma unroll
            for (int m = 0; m < 4; ++m)
#pragma unroll
                for (int bj = 0; bj < 2; ++bj) bw[m][bj] = (tok[m] >= 0 && !sd) ? *(const v4u*)(XB + (size_t)tok[m] * D + col0 + bj * 128) : (v4u){0u, 0u, 0u, 0u};
#pragma unroll
            for (int m = 0; m < 4; ++m) if (tok[m] >= 0) {
#pragma unroll
                for (int bj = 0; bj < 2; ++bj) { const size_t off = (size_t)tok[m] * D + col0 + bj * 128; const v4u b = bw[m][bj];
                    const f32x4 r0 = (f32x4){bflo(b.x), bfhi(b.x), bflo(b.y), bfhi(b.y)} + acc[ai][bj][m][0] * w[m], r1 = (f32x4){bflo(b.z), bfhi(b.z), bflo(b.w), bfhi(b.w)} + acc[ai][bj][m][1] * w[m];
                    if (OUT_F32) { *(f32x4*)((float*)out + off) = r0; *(f32x4*)((float*)out + off + 4) = r1; }
                    else if (sd) { *(f32x4*)(side + off) = r0; *(f32x4*)(side + off + 4) = r1; }
                    else { v4u o; o.x = pk2(r0[0], r0[1]); o.y = pk2(r0[2], r0[3]); o.z = pk2(r1[0], r1[1]); o.w = pk2(r1[2], r1[3]); *(v4u*)((bf16*)out + off) = o; } } }
            asm volatile("" ::: "memory");
        }
    }
};
__device__ __forceinline__ void moe_side_combine(const Ctx& C, const unsigned char* ws, const bf16* XB, float* out, int row_lo, int row_hi) {
    const int* rowtok = (const int*)(ws + WS_ROWTOK);
    const int gw = C.bid * NWAVES + C.wave, NGW = C.G * NWAVES;
    for (int r = row_lo + gw; r < row_hi; r += NGW) { const int tok = rowtok[r];
        if (tok >= 0) { const size_t off = (size_t)tok * D + 16 * C.lane;
            const v4u b0 = *(const v4u*)(XB + off), b1 = *(const v4u*)(XB + off + 8);
            f32x4 o0 = *(const f32x4*)(out + off), o1 = *(const f32x4*)(out + off + 4), o2 = *(const f32x4*)(out + off + 8), o3 = *(const f32x4*)(out + off + 12);
            o0 += (f32x4){bflo(b0.x), bfhi(b0.x), bflo(b0.y), bfhi(b0.y)}; o1 += (f32x4){bflo(b0.z), bfhi(b0.z), bflo(b0.w), bfhi(b0.w)};
            o2 += (f32x4){bflo(b1.x), bfhi(b1.x), bflo(b1.y), bfhi(b1.y)}; o3 += (f32x4){bflo(b1.z), bfhi(b1.z), bflo(b1.w), bfhi(b1.w)};
            *(f32x4*)(out + off) = o0; *(f32x4*)(out + off + 4) = o1; *(f32x4*)(out + off + 8) = o2; *(f32x4*)(out + off + 12) = o3; } }
}
__device__ __forceinline__ void moe_gather(const Ctx& C, unsigned char* ws, const bf16* XN, int list) {
    const unsigned* cnt = (const unsigned*)(ws + WS_CTL) + CW_CNT + list * 8;
    MoeTiles mt; mt.init(cnt);
    const int* tokl = (const int*)(ws + WS_TOK) + (size_t)list * 8 * M; const float* wl = (const float*)(ws + WS_WL) + (size_t)list * 8 * M;
    int* rowtok = (int*)(ws + WS_ROWTOK) + list * MOE_ROWS; float* roww = (float*)(ws + WS_ROWW) + list * MOE_ROWS;
    unsigned char* XG = ws + WS_XG + list * XG_LIST; const unsigned char* XN8 = (const unsigned char*)XN;
    const int gw = C.bid * NWAVES + C.wave, NGW = C.G * NWAVES, nrows = mt.ntiles * 256;
    for (int g0 = gw; g0 < nrows; g0 += 4 * NGW) {
        int tok[4]; float w[4]; v4u a[4];
#pragma unroll
        for (int i = 0; i < 4; ++i) { const int gr = g0 + i * NGW; tok[i] = -1; w[i] = 0.f;
            if (gr < nrows) { int e, base; mt.locate(gr >> 8, e, base); const int local = ((gr >> 8) - base) * 256 + (gr & 255);
                if (local < (int)cnt[e]) { tok[i] = tokl[(size_t)e * M + local]; w[i] = wl[(size_t)e * M + local]; } } }
#pragma unroll
        for (int i = 0; i < 4; ++i) { a[i] = (v4u){0u, 0u, 0u, 0u};
            if (tok[i] >= 0) a[i] = ((const v4u*)(XN8 + (size_t)tok[i] * D))[C.lane]; }
#pragma unroll
        for (int i = 0; i < 4; ++i) { const int gr = g0 + i * NGW;
            if (gr < nrows) { if (C.lane == 0) { rowtok[gr] = tok[i]; roww[gr] = w[i]; }
                ((v4u*)(XG + (size_t)gr * D))[C.lane] = a[i]; } }
    }
}

__global__ void __launch_bounds__(NTHR, 2) fwd(Args args) {
    extern __shared__ __attribute__((aligned(16))) unsigned char lds_raw[];
    Ctx C; C.lds = (LAS unsigned char*)lds_raw; C.tid = threadIdx.x; C.lane = C.tid & 63; C.wave = __builtin_amdgcn_readfirstlane(C.tid >> 6); C.bid = blockIdx.x; C.G = gridDim.x;
    unsigned char* ws = args.ws;
    volatile LAS unsigned* MISC = (volatile LAS unsigned*)(C.lds + MISC_OFF);
    for (int u = C.tid; u < (LDS_BYTES - RING_BYTES) / 4; u += NTHR) ((LAS unsigned*)(C.lds + RING_BYTES))[u] = 0u;
    __syncthreads();
    const int lo = args.ph_lo, hi = args.ph_hi;
    const int wave_s = C.wave;
    XcdBarrier bar; bar.bar = (unsigned*)(ws + WS_CTL) + CW_BAR; bar.x = 0; bar.st = nullptr;
    if (MK_ONE_LAUNCH || hi - lo > 1) bar = xcd_barrier_post((unsigned*)(ws + WS_CTL) + CW_BAR, MISC + 8, C.tid == 0);
#if MK_ONE_LAUNCH
#define IN(k) true
#else
#define IN(k) (lo <= (k) && (k) < hi)
#endif
#define FRESH() do { unsigned z_ = 0u; asm volatile("" : "+v"(z_)); int t_ = wave_s * 64 + (int)__builtin_amdgcn_mbcnt_hi(~0u, __builtin_amdgcn_mbcnt_lo(~0u, z_)); asm volatile("" : "+v"(t_)); C.tid = t_; C.lane = t_ & 63; C.wave = wave_s; } while (0)
#if MK_ONE_LAUNCH
#define SEAM(k) xcd_barrier(bar, C.tid == 0)
#else
#define SEAM(k) do { if (IN(k) && IN((k) + 1)) xcd_barrier(bar, C.tid == 0); } while (0)
#endif
    bf16* XN = (bf16*)args.out; bf16* P = (bf16*)(ws + WS_P); bf16* XB = (bf16*)(ws + WS_XB);
    unsigned char* XN8 = (unsigned char*)args.out + (size_t)64 * MiB;

    if (IN(0)) { FRESH(); convert_layer_weights(C, args, 0); rope_table(C, ws); norm_rows<false, true>(C, args.in[0], args.in[1], XN, nullptr, ws, XN8); SEAM(0); }

#pragma unroll
    for (int l = 0; l < 2; ++l) {
        const int pb = 1 + 9 * l;
        if (IN(pb + 0)) { FRESH();
            {
                PlainSched S; S.T.init(M / 256, C_G / 256, C.G, C.bid); S.A = (const char*)XN; S.B = (const char*)(ws + WS_WIN); S.tA = (size_t)256 * D * 2; S.tB = (size_t)256 * D * 2;
                pg8::EpiBf16 E{P, NCOL, 1 << 30, 1.0f};
                pg8::gemm_phase<pg8::EpiBf16, PlainSched, true, true>(C.tid, C.lds, pg8::Gemm{D, D, D}, S, E); }
            FRESH();
            {
                PlainSched S; S.T.init(M / 256, (NCOL - C_G) / 256, C.G, C.bid); S.A = (const char*)XN8; S.B = (const char*)(ws + WS_WIN + (size_t)8 * MiB); S.tA = (size_t)256 * D; S.tB = (size_t)256 * D;
                pg8::EpiBf16 E{P + C_G, NCOL, 0, 1.0f / (SC_X8 * SC_W8)};
                pg8::gemm_phase<pg8::EpiBf16, PlainSched, true, true, true>(C.tid, C.lds, pg8::Gemm{D, D, D}, S, E); }
            SEAM(pb + 0);
        }
        if (IN(pb + 1)) { FRESH();
            lru_pass1_phase(C, args, l);
            __syncthreads(); FRESH();
            for (int it = C.bid; it < (M / 256) * NH; it += C.G) qk_item(C, args, l, it);
            FRESH();
            conva_tasks(C, args, l);
            SEAM(pb + 1);
        }
        if (IN(pb + 2)) { FRESH();
            {
                static_assert(moba::LDS_BYTES <= RING_BYTES, "attention scratch fits the ring region");
                const int v0 = (C.G % 8 == 0) ? (C.bid % 8) * (C.G / 8) + C.bid / 8 : C.bid;
                for (int v = v0; v < BATCH * NH * 4; v += C.G) { const int s = v & 3, bh = v >> 2;
#pragma unroll 1
                    for (int i = 0; i < 4; ++i) { const int qb = (i == 0) ? s : (i == 1) ? 7 - s : (i == 2) ? 8 + s : 15 - s;
                        moba::moba_unit(C.tid, bh >> 3, bh & 7, qb, (moba::bf16raw*)P, (const float*)(ws + WS_KMEAN), (char*)lds_raw); } }
            }
            FRESH();
            for (int it = C.bid; it < BATCH * NCH; it += C.G) lru_pass2_item(C, args, it);
            SEAM(pb + 2);
        }
        if (IN(pb + 3)) { FRESH();
            MergeSched S; S.T.init(M / 256, D / 256, C.G, C.bid); S.P = (const char*)P; S.W = (const char*)(ws + WS_WOABC);
            EpiMerge E{XN, P};
            pg8::gemm_phase<EpiMerge, MergeSched, true, true>(C.tid, C.lds, pg8::Gemm{512, NCOL, 512}, S, E);
            SEAM(pb + 3);
        }
        if (IN(pb + 4)) { FRESH();
            PlainSched S; S.T.init(M / 256, D / 256, C.G, C.bid); S.A = (const char*)XN; S.B = (const char*)(ws + WS_WO); S.tA = (size_t)256 * D * 2; S.tB = (size_t)256 * D * 2;
            if (l == 0) { EpiRes<true> E{args.in[0], XB}; pg8::gemm_phase<EpiRes<true>, PlainSched, true, true>(C.tid, C.lds, pg8::Gemm{D, D, D}, S, E); }
            else { EpiRes<false> E{XB, XB}; pg8::gemm_phase<EpiRes<false>, PlainSched, true, true>(C.tid, C.lds, pg8::Gemm{D, D, D}, S, E); }
            SEAM(pb + 4);
        }
        if (l == 0) {
            if (IN(pb + 5)) { FRESH(); norm_rows_b<false>(C, XB, args.in[17], XN, nullptr, ws); SEAM(pb + 5); }
            if (IN(pb + 6)) { FRESH();
                PlainSched S; S.T.init(M / 256, 2 * DFF / 256, C.G, C.bid); S.A = (const char*)XN; S.B = (const char*)(ws + WS_FGU); S.tA = (size_t)256 * D * 2; S.tB = (size_t)256 * D * 2;
                EpiSwiGLU E{(bf16*)(ws + WS_HID0), DFF};
                pg8::gemm_phase<EpiSwiGLU, PlainSched, true, true>(C.tid, C.lds, pg8::Gemm{D, D, D}, S, E);
                SEAM(pb + 6);
            }
            if (IN(pb + 7)) { FRESH();
                PlainSched S; S.T.init(M / 256, D / 256, C.G, C.bid); S.A = (const char*)(ws + WS_HID0); S.B = (const char*)(ws + WS_FDN); S.tA = (size_t)256 * DFF * 2; S.tB = (size_t)256 * DFF * 2;
                EpiRes<false> E{XB, XB};
                pg8::gemm_phase<EpiRes<false>, PlainSched, true, true>(C.tid, C.lds, pg8::Gemm{DFF, DFF, DFF}, S, E);
                SEAM(pb + 7);
            }
            if (IN(pb + 8)) { FRESH(); convert_layer_weights(C, args, 1); norm_rows_b<false, true>(C, XB, args.in[1] + D, XN, nullptr, ws, XN8); SEAM(pb + 8); }
        } else {
            if (IN(15)) { FRESH(); norm_rows_b<true>(C, XB, args.in[17] + D, XN, args.in[21], ws); convert_moe_weights(C, args); SEAM(15); }
            if (IN(16)) { FRESH(); moe_gather(C, ws, XN, 0); FRESH(); moe_gather(C, ws, XN, 1); SEAM(16); }
            const unsigned* cnt = (const unsigned*)(ws + WS_CTL) + CW_CNT;
            int nt0, nt1; { MoeTiles t; t.init(cnt); nt0 = t.ntiles; t.init(cnt + 8); nt1 = t.ntiles; }
            const int reg1 = ((nt1 * (D / 256)) / C.G) * C.G / (D / 256);
            constexpr float dsc = 1.0f / (SC_H8 * SC_W8);
            if (IN(17)) { FRESH();
                MoeSched S; S.init(cnt, 2 * EFF / 256, C.G, C.bid, 0, 0, nt0, 1, reg1, nt1 - reg1);
                S.A = (const char*)(ws + WS_XG); S.tA = (size_t)256 * D; S.W = (const char*)(ws + WS_MGU); S.eStride = (size_t)7168 * D; S.tB = (size_t)256 * D;
                EpiSwiGLU8 E{ws + WS_MH, EFF};
                pg8::gemm_phase<EpiSwiGLU8, MoeSched, true, true, true>(C.tid, C.lds, pg8::Gemm{D, D, D}, S, E);
                SEAM(17);
            }
            if (IN(18)) { FRESH();
                int extra;
                {   MoeSched S; S.init(cnt, D / 256, C.G, C.bid, 0, 0, nt0, 1, reg1, nt1 - reg1); extra = S.nunits() % C.G;
                    S.A = (const char*)(ws + WS_MH); S.tA = (size_t)256 * EFF; S.W = (const char*)(ws + WS_MDN); S.eStride = (size_t)D * EFF; S.tB = (size_t)256 * EFF;
                    EpiScatter<false, true> E{(const int*)(ws + WS_ROWTOK), (const float*)(ws + WS_ROWW), XB, XB, dsc, args.out};
                    pg8::gemm_phase<EpiScatter<false, true>, MoeSched, true, true, true>(C.tid, C.lds, pg8::Gemm{EFF, EFF, EFF}, S, E); }
                FRESH();
                {   MoeSched S; S.init(cnt, 2 * EFF / 256, C.G, C.bid, 1, 0, reg1, 1, 0, 0); S.skipE = extra; S.skipR = MOE_DOWN_COST;
                    S.A = (const char*)(ws + WS_XG); S.tA = (size_t)256 * D; S.W = (const char*)(ws + WS_MGU); S.eStride = (size_t)7168 * D; S.tB = (size_t)256 * D;
                    EpiSwiGLU8 E{ws + WS_MH, EFF};
                    pg8::gemm_phase<EpiSwiGLU8, MoeSched, true, true, true>(C.tid, C.lds, pg8::Gemm{D, D, D}, S, E); }
                SEAM(18);
            }
            if (IN(19)) { FRESH();
                moe_side_combine(C, ws, XB, args.out, (MOE_TILES + reg1) * 256, (MOE_TILES + nt1) * 256);
                FRESH();
                MoeSched S; S.init(cnt, D / 256, C.G, C.bid, 1, 0, reg1, 1, 0, 0);
                S.A = (const char*)(ws + WS_MH); S.tA = (size_t)256 * EFF; S.W = (const char*)(ws + WS_MDN); S.eStride = (size_t)D * EFF; S.tB = (size_t)256 * EFF;
                EpiScatter<true, false> E{(const int*)(ws + WS_ROWTOK), (const float*)(ws + WS_ROWW), XB, args.out, dsc, nullptr};
                pg8::gemm_phase<EpiScatter<true, false>, MoeSched, true, true, true>(C.tid, C.lds, pg8::Gemm{EFF, EFF, EFF}, S, E);
            }
        }
    }
#undef IN
#undef SEAM
}

extern "C" void kernel_launch(void* const* d_in, const int* in_sizes, int n_in, void* d_out, int out_size, void* d_ws, size_t ws_size, hipStream_t stream) {
    static int grid = 0;
    if (grid == 0) {
        if (n_in != 25 || in_sizes[0] != M * D || out_size != M * D || ws_size < WS_END) { fprintf(stderr, "kernel_launch: unexpected shapes (n_in %d, in0 %d, out %d, ws %zu); nothing launched\n", n_in, n_in > 0 ? in_sizes[0] : -1, out_size, ws_size); grid = -1; return; }
        int dev = 0, cus = 0, per_cu = 0;
        if (hipGetDevice(&dev) != hipSuccess || hipDeviceGetAttribute(&cus, hipDeviceAttributeMultiprocessorCount, dev) != hipSuccess) { grid = -1; return; }
        if (hipFuncSetAttribute((const void*)fwd, hipFuncAttributeMaxDynamicSharedMemorySize, LDS_BYTES) != hipSuccess) { fprintf(stderr, "kernel_launch: hipFuncSetAttribute failed\n"); grid = -1; return; }
        if (hipOccupancyMaxActiveBlocksPerMultiprocessor(&per_cu, (const void*)fwd, NTHR, LDS_BYTES) != hipSuccess || per_cu < 1) { fprintf(stderr, "kernel_launch: occupancy query reports %d workgroups per CU\n", per_cu); }
        (void)hipGetLastError();
        grid = cus;
    }
    if (grid < 0) return;
    if (hipMemsetAsync((char*)d_ws + WS_CTL, 0, CTL_ZERO_BYTES, stream) != hipSuccess) return;
    Args a{};
    for (int i = 0; i < 25; ++i) a.in[i] = (const float*)d_in[i];
    a.out = (float*)d_out; a.ws = (unsigned char*)d_ws;
#if MK_ONE_LAUNCH
    a.ph_lo = 0; a.ph_hi = N_PHASES;
    hipLaunchKernelGGL(fwd, dim3(grid), dim3(NTHR), LDS_BYTES, stream, a);
#else
    for (int p = 0; p < N_PHASES; ++p) { a.ph_lo = p; a.ph_hi = p + 1; hipLaunchKernelGGL(fwd, dim3(grid), dim3(NTHR), LDS_BYTES, stream, a); }
#endif
}
```

```cpp
#include <hip/hip_runtime.h>
#include <cstdio>
#include <cstdint>

namespace pg8 {
#define PG8_LAS __attribute__((address_space(3)))
typedef unsigned short bf16_t;
typedef short bf16x8 __attribute__((ext_vector_type(8)));
typedef float f32x4 __attribute__((ext_vector_type(4)));
typedef unsigned u32x4 __attribute__((ext_vector_type(4)));
constexpr int BM = 256, BK = 64, HALF = 128, HTB = HALF * BK * 2  , STAGE_BYTES = 8 * HTB, NXCD = 8, WGM = 8;

__host__ __device__ __forceinline__ int lds_byte(int r, int c) { const int st = (r >> 4) * 2 + (c >> 5), rr = r & 15, cc = c & 31, ob = rr * 64 + cc * 2; return st * 1024 + (ob ^ (((ob >> 9) & 1) << 5)); }
__host__ __device__ __forceinline__ void stage_rc(int b, int& R, int& C) { const int st = b / 1024, sb = b % 1024, swz = sb ^ (((sb >> 9) & 1) << 5); R = (st >> 1) * 16 + swz / 64; C = (st & 1) * 32 + (swz % 64) / 2; }
__host__ __device__ __forceinline__ int perm32(int rho) { const int n = rho >> 4, i = rho & 15; return 8 * (i >> 2) + 4 * n + (i & 3); }

struct Unit { int pm, pn; const char* a; const char* b; int x; };
struct Gemm { int K, lda, ldb; };

struct TileOrder {
    int nM, nN, nwg, G, c;
    __device__ __forceinline__ void init(int nM_, int nN_, int G_, int c_) { nM = nM_; nN = nN_; nwg = nM * nN; G = G_; c = c_; }
    __device__ __forceinline__ bool map(long L, int& pm, int& pn) const {
        if (L >= nwg) return false;
        int wgid = (int)L; { const int q = nwg / NXCD, r = nwg % NXCD, xcd = wgid % NXCD, off = wgid / NXCD; wgid = (xcd < r ? xcd * (q + 1) : r * (q + 1) + (xcd - r) * q) + off; }
        const int nig = WGM * nN, gid = wgid / nig, fm = gid * WGM, gsz = (nM - fm) < WGM ? (nM - fm) : WGM;
        pm = fm + ((wgid % nig) % gsz); pn = (wgid % nig) / gsz; return true;
    }
};

typedef float f32x2_cv __attribute__((ext_vector_type(2))); typedef __bf16 bf16x2_cv __attribute__((ext_vector_type(2)));
__device__ __forceinline__ unsigned cvt_pk_bf16(float lo, float hi) { const f32x2_cv v = {lo, hi}; const bf16x2_cv b = __builtin_convertvector(v, bf16x2_cv); return __builtin_bit_cast(unsigned, b); }

struct EpiBf16 {
    static constexpr bool PERM = true, AFTER_DRAIN = false, CHAIN = false;
    bf16_t* O; int ldc; int sig_from; float ds;
    __device__ __forceinline__ void operator()(const f32x4 (&acc)[2][2][4][2], const Unit& u, int wr, int wc, int fr, int fq) const {
        const int row0 = u.pm * BM + wr * 64 + fr; const int col0 = u.pn * BM + wc * 32 + 8 * fq;
#pragma unroll
        for (int ai = 0; ai < 2; ++ai)
#pragma unroll
            for (int m = 0; m < 4; ++m) { bf16_t* rowp = O + (size_t)(row0 + ai * HALF + m * 16) * ldc + col0;
#pragma unroll
                for (int bj = 0; bj < 2; ++bj) { f32x4 v0 = acc[ai][bj][m][0] * ds, v1 = acc[ai][bj][m][1] * ds;
                    if (u.pn >= sig_from) {
#pragma unroll
                        for (int k = 0; k < 4; ++k) { v0[k] = __builtin_amdgcn_rcpf(1.0f + __expf(-v0[k])); v1[k] = __builtin_amdgcn_rcpf(1.0f + __expf(-v1[k])); } }
                    u32x4 w; w.x = cvt_pk_bf16(v0[0], v0[1]); w.y = cvt_pk_bf16(v0[2], v0[3]); w.z = cvt_pk_bf16(v1[0], v1[1]); w.w = cvt_pk_bf16(v1[2], v1[3]);
                    *(u32x4*)(rowp + bj * HALF) = w; } }
    }
};

typedef int pg8_v4i __attribute__((ext_vector_type(4))); typedef int pg8_v8i __attribute__((ext_vector_type(8)));
__device__ __forceinline__ pg8_v8i f8cat(bf16x8 lo, bf16x8 hi) { const pg8_v4i a = __builtin_bit_cast(pg8_v4i, lo), b = __builtin_bit_cast(pg8_v4i, hi); return __builtin_shufflevector(a, b, 0, 1, 2, 3, 4, 5, 6, 7); }
template <class Epi, class Sched, bool ALIGN_EPI = false, bool SP2 = false, bool F8 = false>
__device__ __forceinline__ void gemm_phase(int tid_, PG8_LAS unsigned char* lds, const Gemm g, const Sched& S, const Epi& E) {
    const int tid = tid_, wid = __builtin_amdgcn_readfirstlane(tid >> 6), lane = tid & 63, wr = wid >> 2, wc = wid & 3, fr = lane & 15, fq = lane >> 4;
    const int K = g.K, nt = F8 ? K / 128 : K / BK; constexpr int ESZ = F8 ? 1 : 2;
    unsigned voffA[2], voffB[2];
#pragma unroll
    for (int i = 0; i < 2; ++i) { int R, C; stage_rc(tid * 16 + i * 8192, R, C); const int Rb = Epi::PERM ? ((R & ~31) + perm32(R & 31)) : R;
        voffA[i] = (unsigned)(R * g.lda * ESZ + C * 2); voffB[i] = (unsigned)(Rb * g.ldb * ESZ + C * 2); }
    const size_t kstep = (size_t)(BK * 2);
    const size_t hstepA = (size_t)HALF * g.lda * ESZ, hstepB = (size_t)HALF * g.ldb * ESZ;
    const unsigned ldsw = (unsigned)wid * 1024u;
    const int aoff = lds_byte(wr * 64 + fr, fq * 8), boff = lds_byte(wc * 32 + fr, fq * 8);
#define PG8_SA(b, h) (((b) * 2 + (h)) * HTB)
#define PG8_SB(b, h) ((4 + (b) * 2 + (h)) * HTB)
#define PG8_STAGE(bufoff, gbase, voff) do { _Pragma("unroll") for (int _i = 0; _i < 2; ++_i) \
        __builtin_amdgcn_global_load_lds((const unsigned*)((const char*)(gbase) + (voff)[_i]), (PG8_LAS unsigned*)(lds + (bufoff) + ldsw + _i * 8192), 16, 0, 0); } while (0)
#define PG8_LDA(dst, b, h) do { _Pragma("unroll") for (int m = 0; m < 4; ++m) { const bf16x8 lo_ = *(const PG8_LAS bf16x8*)(lds + PG8_SA(b, h) + aoff + m * 2048), hi_ = *(const PG8_LAS bf16x8*)(lds + PG8_SA(b, h) + aoff + m * 2048 + 1024); \
        if constexpr (F8) dst##8[m] = f8cat(lo_, hi_); else { dst[m][0] = lo_; dst[m][1] = hi_; } } } while (0)
#define PG8_LDB(dst, b, h) do { _Pragma("unroll") for (int n = 0; n < 2; ++n) { const bf16x8 lo_ = *(const PG8_LAS bf16x8*)(lds + PG8_SB(b, h) + boff + n * 2048), hi_ = *(const PG8_LAS bf16x8*)(lds + PG8_SB(b, h) + boff + n * 2048 + 1024); \
        if constexpr (F8) dst##8[n] = f8cat(lo_, hi_); else { dst[n][0] = lo_; dst[n][1] = hi_; } } } while (0)
#define PG8_MMA(ai, bj, At, Bt) do { __builtin_amdgcn_s_setprio(1); _Pragma("unroll") for (int m = 0; m < 4; ++m) _Pragma("unroll") for (int n = 0; n < 2; ++n) { \
        if constexpr (F8) asm volatile("v_mfma_scale_f32_16x16x128_f8f6f4 %0, %1, %2, %0, %3, %3 op_sel_hi:[0,0,0]" : "+v"(acc[ai][bj][m][n]) : "v"(Bt##8[n]), "v"(At##8[m]), "v"(f8scale));   \
        else { _Pragma("unroll") for (int k = 0; k < 2; ++k) acc[ai][bj][m][n] = __builtin_amdgcn_mfma_f32_16x16x32_bf16(Bt[n][k], At[m][k], acc[ai][bj][m][n], 0, 0, 0); } } __builtin_amdgcn_s_setprio(0); } while (0)
#define PG8_WAIT_V(n) asm volatile("s_waitcnt vmcnt(" #n ")" ::: "memory")
#define PG8_WAIT_L(n) asm volatile("s_waitcnt lgkmcnt(" #n ")" ::: "memory")
#define PG8_BAR __builtin_amdgcn_s_barrier()
#define PG8_SCHED __builtin_amdgcn_sched_barrier(0)
    Unit cur, nxt; int ui = 0;
    if (!S.next(0, cur)) return;
    f32x4 acc[2][2][4][2];
#pragma unroll
    for (int a = 0; a < 2; ++a)
#pragma unroll
        for (int b = 0; b < 2; ++b)
#pragma unroll
            for (int m = 0; m < 4; ++m)
#pragma unroll
                for (int n = 0; n < 2; ++n) acc[a][b][m][n] = (f32x4){0.f, 0.f, 0.f, 0.f};
    bf16x8 At[4][2], B0[2][2], B1[2][2]; pg8_v8i At8[4], B08[2], B18[2]; const int f8scale = 0x7f7f7f7f;
    const char* cA = cur.a; const char* cB = cur.b;
    S.a_ready(cur);
    if constexpr (SP2) {
        PG8_STAGE(PG8_SB(0, 0), cB, voffB); PG8_STAGE(PG8_SB(0, 1), cB + hstepB, voffB); PG8_STAGE(PG8_SA(0, 0), cA, voffA); PG8_STAGE(PG8_SA(0, 1), cA + hstepA, voffA);
        if (wr == 1) PG8_BAR;
        PG8_WAIT_V(2); PG8_BAR;
        PG8_STAGE(PG8_SB(1, 0), cB + kstep, voffB); PG8_STAGE(PG8_SA(1, 0), cA + kstep, voffA); PG8_STAGE(PG8_SB(1, 1), cB + hstepB + kstep, voffB);
        PG8_WAIT_V(6); PG8_BAR;
    } else {
        PG8_STAGE(PG8_SB(0, 0), cB, voffB); PG8_STAGE(PG8_SA(0, 0), cA, voffA); PG8_STAGE(PG8_SB(0, 1), cB + hstepB, voffB); PG8_STAGE(PG8_SA(0, 1), cA + hstepA, voffA);
        if (wr == 1) PG8_BAR;
        PG8_WAIT_V(4); PG8_BAR;
        PG8_STAGE(PG8_SB(1, 0), cB + kstep, voffB); PG8_STAGE(PG8_SA(1, 0), cA + kstep, voffA); PG8_STAGE(PG8_SB(1, 1), cB + hstepB + kstep, voffB);
        PG8_WAIT_V(6); PG8_BAR;
    }
    for (;;) {
        const bool has_next = S.next(ui + 1, nxt);
        const char* nA = has_next ? nxt.a : cA; const char* nB = has_next ? nxt.b : cB;
#pragma unroll 1
        for (int t = 0; t < nt; t += 2) {
            const bool last = (t == nt - 2);
            const char* a1 = cA + (size_t)(t + 1) * kstep;
            const char* a2 = last ? nA : cA + (size_t)(t + 2) * kstep; const char* b2 = last ? nB : cB + (size_t)(t + 2) * kstep;
            const char* a3 = a2 + kstep; const char* b3 = b2 + kstep;
            if (last && has_next) S.a_ready(nxt);
            if constexpr (SP2) {
            PG8_LDB(B0, 0, 0); PG8_LDB(B1, 0, 1); PG8_SCHED; PG8_LDA(At, 0, 0); PG8_STAGE(PG8_SA(1, 1), a1 + hstepA, voffA);
            PG8_WAIT_V(8); PG8_WAIT_L(0); PG8_BAR; PG8_MMA(0, 0, At, B0); PG8_MMA(0, 1, At, B1); PG8_BAR; PG8_SCHED;
            PG8_LDA(At, 0, 1); PG8_STAGE(PG8_SB(0, 0), b2, voffB); PG8_STAGE(PG8_SB(0, 1), b2 + hstepB, voffB); PG8_STAGE(PG8_SA(0, 0), a2, voffA);
            PG8_WAIT_V(8); PG8_WAIT_L(0); PG8_BAR; PG8_MMA(1, 0, At, B0); PG8_MMA(1, 1, At, B1); PG8_BAR; PG8_SCHED;
            PG8_LDB(B0, 1, 0); PG8_LDB(B1, 1, 1); PG8_SCHED; PG8_LDA(At, 1, 0); PG8_STAGE(PG8_SA(0, 1), a2 + hstepA, voffA);
            PG8_WAIT_V(8); PG8_WAIT_L(0); PG8_BAR; PG8_MMA(0, 0, At, B0); PG8_MMA(0, 1, At, B1); PG8_BAR; PG8_SCHED;
            PG8_LDA(At, 1, 1); PG8_STAGE(PG8_SB(1, 0), b3, voffB); PG8_STAGE(PG8_SB(1, 1), b3 + hstepB, voffB); PG8_STAGE(PG8_SA(1, 0), a3, voffA);
            PG8_WAIT_V(8); PG8_WAIT_L(0); PG8_BAR; PG8_MMA(1, 0, At, B0); PG8_MMA(1, 1, At, B1); PG8_BAR; PG8_SCHED;
            } else {
            PG8_LDB(B0, 0, 0); PG8_SCHED; PG8_LDA(At, 0, 0); PG8_STAGE(PG8_SA(1, 1), a1 + hstepA, voffA);
            PG8_WAIT_L(8); PG8_BAR; PG8_WAIT_L(0); PG8_MMA(0, 0, At, B0); PG8_BAR; PG8_SCHED;
            PG8_LDB(B1, 0, 1); PG8_STAGE(PG8_SB(0, 0), b2, voffB);
            PG8_BAR; PG8_WAIT_L(0); PG8_MMA(0, 1, At, B1); PG8_BAR;
            PG8_LDA(At, 0, 1); PG8_STAGE(PG8_SA(0, 0), a2, voffA);
            PG8_BAR; PG8_WAIT_L(0); PG8_MMA(1, 0, At, B0); PG8_BAR; PG8_SCHED;
            PG8_STAGE(PG8_SB(0, 1), b2 + hstepB, voffB);
            PG8_WAIT_V(6); PG8_BAR; PG8_MMA(1, 1, At, B1); PG8_BAR;
            PG8_LDB(B0, 1, 0); PG8_SCHED; PG8_LDA(At, 1, 0); PG8_STAGE(PG8_SA(0, 1), a2 + hstepA, voffA);
            PG8_WAIT_L(8); PG8_BAR; PG8_WAIT_L(0); PG8_MMA(0, 0, At, B0); PG8_BAR; PG8_SCHED;
            PG8_LDB(B1, 1, 1); PG8_STAGE(PG8_SB(1, 0), b3, voffB);
            PG8_BAR; PG8_WAIT_L(0); PG8_MMA(0, 1, At, B1); PG8_BAR;
            PG8_LDA(At, 1, 1); PG8_STAGE(PG8_SA(1, 0), a3, voffA);
            PG8_BAR; PG8_WAIT_L(0); PG8_MMA(1, 0, At, B0); PG8_BAR; PG8_SCHED;
            PG8_STAGE(PG8_SB(1, 1), b3 + hstepB, voffB);
            PG8_WAIT_V(6); PG8_BAR; PG8_MMA(1, 1, At, B1); PG8_BAR;
            }
        }
        if constexpr (ALIGN_EPI) { if (wr == 0) PG8_BAR; }
        if constexpr (F8) asm volatile("s_nop 15\n\ts_nop 7" ::: "memory");
        bool keep = false;
        if constexpr (!Epi::AFTER_DRAIN) { if constexpr (Epi::CHAIN) keep = E.chain(acc, cur, wr, wc, fr, fq); else E(acc, cur, wr, wc, fr, fq); S.done(cur); }
        if (!has_next) break;
        if (!keep) {
#pragma unroll
        for (int a = 0; a < 2; ++a)
#pragma unroll
            for (int b = 0; b < 2; ++b)
#pragma unroll
                for (int m = 0; m < 4; ++m)
#pragma unroll
                    for (int n = 0; n < 2; ++n) acc[a][b][m][n] = (f32x4){0.f, 0.f, 0.f, 0.f};
        }
        cur = nxt; cA = nA; cB = nB; ++ui;
        if constexpr (ALIGN_EPI) { if (wr == 1) PG8_BAR; }
    }
    PG8_WAIT_V(0);
    if constexpr (!ALIGN_EPI) { if (wr == 0) PG8_BAR; }
    PG8_BAR;
    if constexpr (Epi::AFTER_DRAIN) { E.fused(acc, cur, wr, wc, fr, fq, lds, wid, lane); S.done(cur); }
#undef PG8_SA
#undef PG8_SB
#undef PG8_STAGE
#undef PG8_LDA
#undef PG8_LDB
#undef PG8_MMA
#undef PG8_WAIT_V
#undef PG8_WAIT_L
#undef PG8_BAR
#undef PG8_SCHED
}
}

#define GAS __attribute__((address_space(1)))
#define LAS __attribute__((address_space(3)))
typedef unsigned short bf16;
typedef unsigned v4u __attribute__((ext_vector_type(4)));
typedef unsigned v2u __attribute__((ext_vector_type(2)));
typedef float f32x4 __attribute__((ext_vector_type(4)));
typedef float f32x2 __attribute__((ext_vector_type(2)));
typedef GAS unsigned gu32;
#define RLX_AGENT __ATOMIC_RELAXED, __HIP_MEMORY_SCOPE_AGENT
#define LDS_WAIT() asm volatile("s_waitcnt lgkmcnt(0)" ::: "memory")
#define VM_WAIT() asm volatile("s_waitcnt vmcnt(0)" ::: "memory")
__device__ __forceinline__ unsigned pk2(float lo, float hi) { return pg8::cvt_pk_bf16(lo, hi); }
__device__ __forceinline__ float bflo(unsigned w) { return __uint_as_float(w << 16); }
__device__ __forceinline__ float bfhi(unsigned w) { return __uint_as_float(w & 0xffff0000u); }
__device__ __forceinline__ float bf2f(bf16 b) { return __uint_as_float((unsigned)b << 16); }
__device__ __forceinline__ bf16 f2bf(float f) { return (bf16)(pk2(f, 0.f) & 0xffffu); }
__device__ __forceinline__ float bfround(float f) { return bflo(pk2(f, 0.f)); }
__device__ __forceinline__ unsigned pk4_fp8(float a, float b, float c, float d) {
    a = fminf(fmaxf(a, -448.f), 448.f); b = fminf(fmaxf(b, -448.f), 448.f); c = fminf(fmaxf(c, -448.f), 448.f); d = fminf(fmaxf(d, -448.f), 448.f);
    int p = 0; p = __builtin_amdgcn_cvt_pk_fp8_f32(a, b, p, false); p = __builtin_amdgcn_cvt_pk_fp8_f32(c, d, p, true); return (unsigned)p; }
__device__ __forceinline__ float rcp_(float x) { return __builtin_amdgcn_rcpf(x); }
__device__ __forceinline__ float sigmoidf_(float x) { return rcp_(1.0f + __expf(-x)); }

#define XB_TMO      128
#define XB_XCNT(j)  (256  + 64 * (j))
#define XB_XSUB(j)  (1280 + 64 * (j))
#define XB_XGEN(j)  (2304 + 64 * (j))
#define XB_TOP      3328
#define XB_TOPGEN   3392
#define XCD_BAR_WORDS 3456
#define XB_SPIN_CAP (1u << 18)

__device__ __forceinline__ unsigned xb_ld(unsigned* p)              { return __hip_atomic_load(p, __ATOMIC_RELAXED, __HIP_MEMORY_SCOPE_AGENT); }
__device__ __forceinline__ unsigned xb_add(unsigned* p, unsigned v) { return __hip_atomic_fetch_add(p, v, __ATOMIC_RELAXED, __HIP_MEMORY_SCOPE_AGENT); }
__device__ __forceinline__ unsigned xb_xcc_id() { return (unsigned)__builtin_amdgcn_s_getreg((3 << 11) | 20) & 0xFu; }
#define XB_SPIN(cond, bar) do { unsigned _sp = 0; while (cond) { __builtin_amdgcn_s_sleep(1); \
    if ((++_sp & 255u) == 0u) { if (xb_ld(&(bar)[XB_TMO])) break; if (_sp > XB_SPIN_CAP) { atomicAdd(&(bar)[XB_TMO], 1u); break; } } } } while (0)

struct XcdBarrier {
    unsigned* bar; unsigned x;
    volatile LAS unsigned* st;
};

__device__ __forceinline__ XcdBarrier xcd_barrier_post(unsigned* bar, volatile LAS unsigned* st, bool leader) {
    XcdBarrier b; b.bar = bar; b.x = xb_xcc_id(); b.st = st;
    if (leader) (void)xb_add(&bar[XB_XCNT(b.x)], 1u);
    return b;
}
__device__ __forceinline__ void xcd_barrier_complete(unsigned* bar, unsigned x, unsigned& nloc, unsigned& nx) {
    const unsigned G = gridDim.x * gridDim.y * gridDim.z;
    unsigned sum, cnt, mine, sp = 0u;
    for (;;) {
        sum = 0u; cnt = 0u; mine = 0u;
#pragma unroll
        for (unsigned j = 0; j < 16; ++j) { const unsigned c = xb_ld(&bar[XB_XCNT(j)]); sum += c; cnt += (c > 0u) ? 1u : 0u; mine = (j == x) ? c : mine; }
        if (sum == G) break;
        __builtin_amdgcn_s_sleep(1);
        if ((++sp & 255u) == 0u) { if (xb_ld(&bar[XB_TMO])) break; if (sp > XB_SPIN_CAP) { atomicAdd(&bar[XB_TMO], 1u); break; } }
    }
    nloc = mine > 0u ? mine : 1u; nx = cnt > 0u ? cnt : 1u;
}

__device__ __forceinline__ void xcd_barrier(const XcdBarrier& b_, bool leader) {
    XcdBarrier b = b_; asm volatile("" : "+s"(b.x));
    asm volatile("s_waitcnt vmcnt(0)" ::: "memory");
    __syncthreads();
    if (leader) {
        unsigned* bar = b.bar;
        __builtin_amdgcn_s_waitcnt(0);
        unsigned nloc = b.st[0], nx = b.st[1];
        if (nloc == 0u) { xcd_barrier_complete(bar, b.x, nloc, nx); b.st[0] = nloc; b.st[1] = nx; }
        const unsigned old = xb_add(&bar[XB_XSUB(b.x)], 1u);
        const unsigned gen = old / nloc;
        if (old + 1u == (gen + 1u) * nloc) {
            __builtin_amdgcn_fence(__ATOMIC_RELEASE, "agent");
            asm volatile("s_waitcnt vmcnt(0)" ::: "memory");
            const unsigned og = xb_add(&bar[XB_TOP], 1u);
            const unsigned tg = og / nx;
            if (og + 1u == (tg + 1u) * nx) xb_add(&bar[XB_TOPGEN], 1u);
            else XB_SPIN(xb_ld(&bar[XB_TOPGEN]) == tg, bar);
            __builtin_amdgcn_fence(__ATOMIC_ACQUIRE, "agent");
            xb_add(&bar[XB_XGEN(b.x)], 1u);
            asm volatile("s_waitcnt vmcnt(0)" ::: "memory");
        } else {
            XB_SPIN(xb_ld(&bar[XB_XGEN(b.x)]) == gen, bar);
            __builtin_amdgcn_fence(__ATOMIC_ACQUIRE, "agent");
            asm volatile("s_waitcnt vmcnt(0)" ::: "memory");
        }
    }
    __syncthreads();
}

namespace moba {
using bf16x8=__attribute__((ext_vector_type(8)))short;
using s16x4=__attribute__((ext_vector_type(4)))short;
using f32x16=__attribute__((ext_vector_type(16)))float;
using u32x4=__attribute__((ext_vector_type(4)))unsigned;
typedef unsigned short bf16raw;
constexpr int SEQL=4096,NHEAD=8,HDIM=64,DM=7168;
constexpr int COLQ=1536,COLK=2048,COLV=2560;
constexpr int NW=8,QBLK=32,QB=QBLK*NW,KVBLK=64;
__device__ __forceinline__ int crow(int r,int hi){return (r&3)+8*(r>>2)+4*hi;}
#define SBAR() __builtin_amdgcn_sched_barrier(0)
__device__ __forceinline__ void cmask(f32x16&p0,f32x16&p1,int jb,int qrel,int hi){
  const float NEG=-INFINITY; int kb=64*jb+4*hi;
  #pragma unroll
  for(int r=0;r<16;++r){int kv=kb+(r&3)+8*(r>>2); if(kv>qrel)p0[r]=NEG; if(kv+32>qrel)p1[r]=NEG;}
}
constexpr int NSLOT=3, SLOTB=8192;
constexpr int LDS_K=0, LDS_V=NSLOT*SLOTB, LDS_WS=2*NSLOT*SLOTB, LDS_OST=LDS_WS+NW*64*4, LDS_KM=LDS_OST+NW*4096, LDS_BYTES=LDS_KM+4096;
__device__ __forceinline__ void glds16(const void*gsrc,unsigned lds_dst){unsigned keep;
  asm volatile("s_mov_b32 %0, m0\n\ts_mov_b32 m0, %2\n\ts_nop 0\n\tglobal_load_lds_dwordx4 %1, off\n\ts_mov_b32 m0, %0":"=&s"(keep):"v"(gsrc),"s"(lds_dst):"memory");}
typedef float f32x2_t __attribute__((ext_vector_type(2))); typedef __bf16 bf16x2_t __attribute__((ext_vector_type(2)));
__device__ __forceinline__ unsigned cvtpk_s(float lo,float hi){f32x2_t v={lo,hi};bf16x2_t b=__builtin_convertvector(v,bf16x2_t);return __builtin_bit_cast(unsigned,b);}
#define WAIT_BAR(N) asm volatile("s_waitcnt vmcnt(" #N ") lgkmcnt(0)\n\ts_barrier":::"memory")

__device__ __forceinline__ void qkt(f32x16&p0,f32x16&p1,const char*Kslot,const bf16x8*qr,int r32,int hi){
  const char*kb=Kslot+hi*1024+r32*16; const f32x16 zf=f32x16{};
  #pragma unroll
  for(int d0=0;d0<4;++d0){
    const bf16x8 b0=*reinterpret_cast<const bf16x8*>(kb+d0*2048);
    const bf16x8 b1=*reinterpret_cast<const bf16x8*>(kb+d0*2048+512);
    if(d0==0){p0=__builtin_amdgcn_mfma_f32_32x32x16_bf16(b0,qr[0],zf,0,0,0);p1=__builtin_amdgcn_mfma_f32_32x32x16_bf16(b1,qr[0],zf,0,0,0);}
    else{p0=__builtin_amdgcn_mfma_f32_32x32x16_bf16(b0,qr[d0],p0,0,0,0);p1=__builtin_amdgcn_mfma_f32_32x32x16_bf16(b1,qr[d0],p1,0,0,0);}}
}
typedef __attribute__((address_space(3))) const char* lds_cptr;
typedef short v4i16_t __attribute__((ext_vector_type(4)));
__device__ __forceinline__ void kload8(bf16x8*kf,lds_cptr kp){
  kf[0]=*(const __attribute__((address_space(3))) bf16x8*)(kp);      kf[1]=*(const __attribute__((address_space(3))) bf16x8*)(kp+512);
  kf[2]=*(const __attribute__((address_space(3))) bf16x8*)(kp+2048); kf[3]=*(const __attribute__((address_space(3))) bf16x8*)(kp+2560);
  kf[4]=*(const __attribute__((address_space(3))) bf16x8*)(kp+4096); kf[5]=*(const __attribute__((address_space(3))) bf16x8*)(kp+4608);
  kf[6]=*(const __attribute__((address_space(3))) bf16x8*)(kp+6144); kf[7]=*(const __attribute__((address_space(3))) bf16x8*)(kp+6656);
}
__device__ __forceinline__ void kload2(bf16x8*kf,lds_cptr kp,int j){ kf[2*j]=*(const __attribute__((address_space(3))) bf16x8*)(kp+j*2048); kf[2*j+1]=*(const __attribute__((address_space(3))) bf16x8*)(kp+j*2048+512); }
__device__ __forceinline__ s16x4 vtr(lds_cptr p){ return __builtin_bit_cast(s16x4,__builtin_amdgcn_ds_read_tr16_b64_v4i16((__attribute__((address_space(3))) v4i16_t*)p)); }
__device__ __forceinline__ void pv(f32x16*o,int vb,bf16x8 pa0,bf16x8 pa1,bf16x8 pa2,bf16x8 pa3){
  #pragma unroll
  for(int d0=0;d0<2;++d0){s16x4 lo[4],hi[4];
    #pragma unroll
    for(int ks=0;ks<4;++ks){
      asm volatile("ds_read_b64_tr_b16 %0,%1 offset:%c2":"=&v"(lo[ks]):"v"(vb),"i"(d0*4096+ks*1024):"memory");
      asm volatile("ds_read_b64_tr_b16 %0,%1 offset:%c2":"=&v"(hi[ks]):"v"(vb),"i"(d0*4096+ks*1024+512):"memory");}
    asm volatile("s_waitcnt lgkmcnt(0)":::"memory");SBAR();
    #define PK(k) (bf16x8){lo[k][0],lo[k][1],lo[k][2],lo[k][3],hi[k][0],hi[k][1],hi[k][2],hi[k][3]}
    o[d0]=__builtin_amdgcn_mfma_f32_32x32x16_bf16(pa0,PK(0),o[d0],0,0,0);
    o[d0]=__builtin_amdgcn_mfma_f32_32x32x16_bf16(pa1,PK(1),o[d0],0,0,0);
    o[d0]=__builtin_amdgcn_mfma_f32_32x32x16_bf16(pa2,PK(2),o[d0],0,0,0);
    o[d0]=__builtin_amdgcn_mfma_f32_32x32x16_bf16(pa3,PK(3),o[d0],0,0,0);
    #undef PK
  }
}
__device__ __forceinline__ float bfl(short s){return __uint_as_float(((unsigned)(unsigned short)s)<<16);}

__device__ __forceinline__ void moba_unit(int tid_in,int b,int h,int qb,bf16raw*P,const float*KM,char*shm,int ocol=COLQ){
  int tid=tid_in; asm volatile("":"+v"(tid));
  const int lane=tid&63,r32=lane&31,hi=lane>>5; const int wid=__builtin_amdgcn_readfirstlane(tid>>6);
  const long rowbase=(long)b*SEQL; const int q0=qb*QB;
  bf16raw*Qw=P+(rowbase+q0+wid*QBLK)*DM+COLQ+h*HDIM;
  const bf16raw*Kh=P+rowbase*DM+COLK+h*HDIM,*Vh=P+rowbase*DM+COLV+h*HDIM;
  const unsigned lds0=(unsigned)(uintptr_t)shm;
  float*wsf=(float*)(shm+LDS_WS)+wid*64;
  bf16x8 qr[4];
  #pragma unroll
  for(int d0=0;d0<4;++d0)qr[d0]=*reinterpret_cast<const bf16x8*>(&Qw[(long)r32*DM+d0*16+hi*8]);
  unsigned selbits=(1u<<qb)-1u;
  if(qb>3){
    float*kml=(float*)(shm+LDS_KM);
    { const float*src=KM+(long)((b*NHEAD+h)*16)*HDIM; const f32x2_t v=*(const f32x2_t*)(src+2*tid); *(f32x2_t*)(kml+2*tid)=v; }
    asm volatile("s_waitcnt vmcnt(0) lgkmcnt(0)\n\ts_barrier":::"memory");
    float qf[32];
    #pragma unroll
    for(int d0=0;d0<4;++d0)
      #pragma unroll
      for(int e=0;e<8;++e)qf[d0*8+e]=bfl(qr[d0][e]);
    float g0=-INFINITY,g1=-INFINITY,g2=-INFINITY; int s0=0,s1=0,s2=0;
    for(int jb=0;jb<qb;++jb){
      const float*kr=kml+jb*64+hi*8; float g=0.f;
      #pragma unroll
      for(int d0=0;d0<4;++d0){ const f32x2_t*k2=(const f32x2_t*)(kr+d0*16);
        #pragma unroll
        for(int e=0;e<4;++e){ const f32x2_t kv=k2[e]; g+=qf[d0*8+2*e]*kv.x; g+=qf[d0*8+2*e+1]*kv.y; } }
      {auto rr=__builtin_amdgcn_permlane32_swap(__float_as_uint(g),__float_as_uint(g),false,false);g=__uint_as_float(rr[0])+__uint_as_float(rr[1]);}
      if(g>g0){g2=g1;s2=s1;g1=g0;s1=s0;g0=g;s0=jb;} else if(g>g1){g2=g1;s2=s1;g1=g;s1=jb;} else if(g>g2){g2=g;s2=jb;}
    }
    selbits=(1u<<s0)|(1u<<s1)|(1u<<s2);
  }
  #define TMASK(t) (((t)<4)?0xffffffffu:(0u-((selbits>>(((t)-4)>>2))&1u)))
  const bf16raw*ksrc=Kh+(long)lane*DM+wid*8;
  const bf16raw*vsrc=Vh+(long)(16*(wid&3)+(lane>>2))*DM+(wid>>2)*32+(lane&3)*8;
  const unsigned kdst=lds0+LDS_K+wid*1024, vdst=lds0+LDS_V+wid*1024;
  #define KT(t) (((t)<4)?(4*qb+(t)):((t)-4))
  #define DMA_K(t,slot) glds16(ksrc+(long)KT(t)*KVBLK*DM,(unsigned)__builtin_amdgcn_readfirstlane(kdst+(slot)))
  #define DMA_V(t,slot) glds16(vsrc+(long)KT(t)*KVBLK*DM,(unsigned)__builtin_amdgcn_readfirstlane(vdst+(slot)))
  const char*Kbase=shm+LDS_K; bf16x8 kf[8];
  const lds_cptr shm3=(lds_cptr)shm; const lds_cptr kp0=shm3+LDS_K+hi*1024+r32*16; const lds_cptr vp0=shm3+LDS_V+((lane>>4)&1)*32+(lane&3)*8+(4*hi+((lane&15)>>2))*64;
  const int vb0=(int)(lds0+LDS_V)+((lane>>4)&1)*32+(lane&3)*8+(4*hi+((lane&15)>>2))*64;
  const int NT=4*qb+4;
  DMA_K(0,0);DMA_V(0,0);DMA_K(1,SLOTB);
  float l_reg=0.f;f32x16 o[2];o[0]=f32x16{};o[1]=f32x16{};
  const int qrel=wid*QBLK+r32;
  f32x16 pA0,pA1,pB0,pB1;
  int sl_prev=0,sl_cur=0,sl_next=SLOTB;
  #define ROT() do{sl_prev=sl_cur;sl_cur=sl_next;sl_next=(sl_next==(NSLOT-1)*SLOTB)?0:sl_next+SLOTB;}while(0)
  DMA_K(2,2*SLOTB);
  WAIT_BAR(3);
  qkt(pA0,pA1,Kbase,qr,r32,hi);asm volatile("s_nop 15\n\ts_nop 7":"+v"(pA0),"+v"(pA1));cmask(pA0,pA1,0,qrel,hi);
  _Pragma("unroll") for(int r=0;r<16;++r){pA0[r]=__builtin_amdgcn_exp2f(pA0[r]);pA1[r]=__builtin_amdgcn_exp2f(pA1[r]);}
  WAIT_BAR(0);
  DMA_K(3,0);DMA_V(1,SLOTB);
  ROT();
  kload8(kf,kp0+sl_cur);
  WAIT_BAR(2);
  s16x4 vlo[8],vhi[8]; u32x4 pw0,pw1,pw2,pw3;
  const f32x16 zf=f32x16{};
  #define PKW(P,B) (cvtpk_s(P[B],P[B+1])&mprev_)
  #define PAF(k) __builtin_bit_cast(bf16x8,pw##k)
  #define VFR(i) (bf16x8){vlo[i][0],vlo[i][1],vlo[i][2],vlo[i][3],vhi[i][0],vhi[i][1],vhi[i][2],vhi[i][3]}
  #define PIN(x) asm volatile("":"+v"(x))
  #define GAPA(MF,A0,A1,A2,A3,W0,W1,PW) do{ MF; sacc+=A0; sacc+=A1; sacc+=A2; sacc+=A3; PIN(sacc); W0; W1; PIN(PW); SBAR(); }while(0)
  #define EX(v) __builtin_amdgcn_exp2f(v)
  #define GAPB(MF,X,B) do{ MF; X[B]=EX(X[B]); X[B+1]=EX(X[B+1]); X[B+2]=EX(X[B+2]); X[B+3]=EX(X[B+3]); PIN(X); SBAR(); }while(0)
  #define VRD(i) do{ vlo[i]=vtr(vp_+(((i)>>2)*4096+((i)&3)*1024)); vhi[i]=vtr(vp_+(((i)>>2)*4096+((i)&3)*1024+512)); }while(0)
  #define KRD(G,j) do{ if(G){ kload2(kf,kp0+sl_next,j); SBAR(); } }while(0)
  #define STEP(C0,C1,P0,P1,t,GK,GV,GL,CM) do{ SBAR(); \
    const unsigned mprev_=TMASK((t)-1); \
    const lds_cptr vp_=vp0+sl_prev; \
    VRD(0); SBAR(); float sacc=(P0[0]+P0[1]); \
    GAPA(C0=__builtin_amdgcn_mfma_f32_32x32x16_bf16(kf[0],qr[0],zf,0,0,0), P0[2],P0[3],P0[4],P0[5],     pw0[0]=PKW(P0,0), pw0[1]=PKW(P0,2), pw0); \
    VRD(4); SBAR(); GAPA(C1=__builtin_amdgcn_mfma_f32_32x32x16_bf16(kf[1],qr[0],zf,0,0,0), P0[6],P0[7],P0[8],P0[9],     pw0[2]=PKW(P0,4), pw0[3]=PKW(P0,6), pw0); \
    VRD(1); SBAR(); GAPA(C0=__builtin_amdgcn_mfma_f32_32x32x16_bf16(kf[2],qr[1],C0,0,0,0),   P0[10],P0[11],P0[12],P0[13], pw1[0]=PKW(P0,8), pw1[1]=PKW(P0,10), pw1); \
    VRD(5); SBAR(); GAPA(C1=__builtin_amdgcn_mfma_f32_32x32x16_bf16(kf[3],qr[1],C1,0,0,0),   P0[14],P0[15],P1[0],P1[1],   pw1[2]=PKW(P0,12),pw1[3]=PKW(P0,14), pw1); \
    VRD(2); SBAR(); GAPA(C0=__builtin_amdgcn_mfma_f32_32x32x16_bf16(kf[4],qr[2],C0,0,0,0),   P1[2],P1[3],P1[4],P1[5],     pw2[0]=PKW(P1,0), pw2[1]=PKW(P1,2), pw2); \
    VRD(6); SBAR(); GAPA(C1=__builtin_amdgcn_mfma_f32_32x32x16_bf16(kf[5],qr[2],C1,0,0,0),   P1[6],P1[7],P1[8],P1[9],     pw2[2]=PKW(P1,4), pw2[3]=PKW(P1,6), pw2); \
    VRD(3); SBAR(); GAPA(C0=__builtin_amdgcn_mfma_f32_32x32x16_bf16(kf[6],qr[3],C0,0,0,0),   P1[10],P1[11],P1[12],P1[13], pw3[0]=PKW(P1,8), pw3[1]=PKW(P1,10), pw3); \
    VRD(7); SBAR(); GAPA(C1=__builtin_amdgcn_mfma_f32_32x32x16_bf16(kf[7],qr[3],C1,0,0,0),   P1[14],P1[15],0.f,0.f,       pw3[2]=PKW(P1,12),pw3[3]=PKW(P1,14), pw3); \
    l_reg+=__uint_as_float(__float_as_uint(sacc)&mprev_); \
    if(GK){DMA_K((t)+3,sl_cur);} if(GV){DMA_V((t)+1,sl_next);} \
    if(CM){cmask(C0,C1,(t),qrel,hi);} \
    SBAR(); \
    GAPB(o[0]=__builtin_amdgcn_mfma_f32_32x32x16_bf16(PAF(0),VFR(0),o[0],0,0,0), C0,0); \
    GAPB(o[1]=__builtin_amdgcn_mfma_f32_32x32x16_bf16(PAF(0),VFR(4),o[1],0,0,0), C0,4); \
    KRD(GL,0); GAPB(o[0]=__builtin_amdgcn_mfma_f32_32x32x16_bf16(PAF(1),VFR(1),o[0],0,0,0), C0,8); \
    KRD(GL,1); GAPB(o[1]=__builtin_amdgcn_mfma_f32_32x32x16_bf16(PAF(1),VFR(5),o[1],0,0,0), C0,12); \
    KRD(GL,2); GAPB(o[0]=__builtin_amdgcn_mfma_f32_32x32x16_bf16(PAF(2),VFR(2),o[0],0,0,0), C1,0); \
    KRD(GL,3); GAPB(o[1]=__builtin_amdgcn_mfma_f32_32x32x16_bf16(PAF(2),VFR(6),o[1],0,0,0), C1,4); \
    GAPB(o[0]=__builtin_amdgcn_mfma_f32_32x32x16_bf16(PAF(3),VFR(3),o[0],0,0,0), C1,8); \
    GAPB(o[1]=__builtin_amdgcn_mfma_f32_32x32x16_bf16(PAF(3),VFR(7),o[1],0,0,0), C1,12); \
    }while(0)
  #define ENDW(tt) do{ if((tt)+3<NT){WAIT_BAR(2);} else if((tt)+2<NT){WAIT_BAR(1);} else {WAIT_BAR(0);} }while(0)
  STEP(pB0,pB1,pA0,pA1,1,(4<NT),true,true,true);          ENDW(1); ROT();
  STEP(pA0,pA1,pB0,pB1,2,(5<NT),true,true,true);          ENDW(2); ROT();
  STEP(pB0,pB1,pA0,pA1,3,(6<NT),(4<NT),(4<NT),true);
  if(NT>4){
    ENDW(3); ROT();
    int t=4;
    for(;t+5<NT;t+=2){
      STEP(pA0,pA1,pB0,pB1,t,true,true,true,false);     WAIT_BAR(2); ROT();
      STEP(pB0,pB1,pA0,pA1,t+1,true,true,true,false);   WAIT_BAR(2); ROT();
    }
    for(;t+2<NT;t+=2){
      STEP(pA0,pA1,pB0,pB1,t,(t+3<NT),(t+1<NT),(t+1<NT),false);       ENDW(t);   ROT();
      STEP(pB0,pB1,pA0,pA1,t+1,(t+4<NT),(t+2<NT),(t+2<NT),false);     ENDW(t+1); ROT();
    }
    STEP(pA0,pA1,pB0,pB1,t,false,true,true,false);      ENDW(t); ROT();
    STEP(pB0,pB1,pA0,pA1,t+1,false,false,false,false);
  }
  { const unsigned mprev_=TMASK(NT-1);
    float sacc=pB0[0]+pB0[1]; _Pragma("unroll") for(int r=2;r<16;++r)sacc+=pB0[r]; _Pragma("unroll") for(int r=0;r<16;++r)sacc+=pB1[r]; l_reg+=__uint_as_float(__float_as_uint(sacc)&mprev_);
    pw0=(u32x4){PKW(pB0,0),PKW(pB0,2),PKW(pB0,4),PKW(pB0,6)};pw1=(u32x4){PKW(pB0,8),PKW(pB0,10),PKW(pB0,12),PKW(pB0,14)};pw2=(u32x4){PKW(pB1,0),PKW(pB1,2),PKW(pB1,4),PKW(pB1,6)};pw3=(u32x4){PKW(pB1,8),PKW(pB1,10),PKW(pB1,12),PKW(pB1,14)};
    SBAR(); pv(o,vb0+sl_cur,PAF(0),PAF(1),PAF(2),PAF(3)); }
  #undef PKW
  #undef PAF
  #undef VFR
  #undef PIN
  #undef GAPA
  #undef GAPB
  #undef EX
  #undef VRD
  #undef KRD
  #undef STEP
  #undef ENDW
  {auto rr=__builtin_amdgcn_permlane32_swap(__float_as_uint(l_reg),__float_as_uint(l_reg),false,false);l_reg=__uint_as_float(rr[0])+__uint_as_float(rr[1]);}
  if(hi==0)wsf[32+r32]=l_reg;asm volatile("s_waitcnt lgkmcnt(0)":::"memory");
  float rli[16];
  #pragma unroll
  for(int r=0;r<16;++r)rli[r]=__builtin_amdgcn_rcpf(wsf[32+crow(r,hi)]);
  { bf16raw*stg=(bf16raw*)(shm+LDS_OST)+wid*2048;
    #pragma unroll
    for(int r=0;r<16;++r){const int orow=crow(r,hi);
      #pragma unroll
      for(int d0=0;d0<2;++d0)stg[orow*64+d0*32+r32]=(bf16raw)(cvtpk_s(o[d0][r]*rli[r],0.f)&0xffffu);}
    asm volatile("s_waitcnt lgkmcnt(0)":::"memory");
    #pragma unroll
    for(int i=0;i<4;++i){const int row=i*8+(lane>>3),ch=lane&7; const u32x4 v=*(const u32x4*)(stg+row*64+ch*8); *(u32x4*)(Qw+(ocol-COLQ)+(long)row*DM+ch*8)=v;} }
  asm volatile("s_waitcnt lgkmcnt(0)\n\ts_barrier":::"memory");
  #undef DMA_K
  #undef DMA_V
  #undef KT
  #undef TMASK
  #undef ROT
}
#undef SBAR
#undef WAIT_BAR
}

constexpr int NWAVES = 8, NTHR = NWAVES * 64;
#ifndef MK_ONE_LAUNCH
#define MK_ONE_LAUNCH 1
#endif
constexpr int BATCH = 8, SEQ = 4096, D = 1024, M = BATCH * SEQ;
constexpr int NCOL = 7168;
constexpr int C_XA = 0, C_BA = 512, C_CA = 1024, C_Q = 1536, C_K = 2048, C_V = 2560, C_XC = 3072, C_GC = 3584, C_G = 4096;
constexpr int NH = 8, HD = 64, BLK = 256, NBLK = SEQ / BLK;
constexpr int DFF = 2816, EFF = 3584, NEXP = 8;
constexpr int LCH = 64, NCH = SEQ / LCH;
constexpr float EPS = 1e-6f;
constexpr float QSCALE = 0.18033688011112042f;
constexpr int MOE_DOWN_COST = 3;
constexpr int MOE_TILES = 136, MOE_ROWS = MOE_TILES * 256;
constexpr int N_PHASES = 20;

constexpr size_t MiB = 1u << 20;
constexpr size_t WS_CTL = 0, CTL_ZERO_BYTES = 1 * MiB;
constexpr size_t WS_ROPE = 1 * MiB;
constexpr size_t WS_KMEAN = 1 * MiB + 256 * 1024;
constexpr size_t WS_SUM = 2 * MiB;
constexpr size_t WS_TOK = 4 * MiB;
constexpr size_t WS_WL = 6 * MiB;
constexpr size_t WS_ROWTOK = 8 * MiB;
constexpr size_t WS_ROWW = 8 * MiB + 512 * 1024;
constexpr size_t WS_XB = 9 * MiB;
constexpr size_t WS_WIN = 73 * MiB;
constexpr size_t WS_WOABC = 87 * MiB;
constexpr size_t WS_WO = 90 * MiB;
constexpr size_t WS_FGU = 92 * MiB;
constexpr size_t WS_FDN = 103 * MiB;
constexpr size_t WS_P = 109 * MiB;
constexpr size_t WS_HID0 = WS_P;
constexpr float SC_X8 = 8.f, SC_W8 = 64.f, SC_H8 = 8.f;
constexpr size_t WS_MGU = 73 * MiB;
constexpr size_t WS_MDN = 129 * MiB;
constexpr size_t WS_MH = 157 * MiB;
constexpr size_t MH_LIST = (size_t)MOE_ROWS * EFF, XG_LIST = (size_t)MOE_ROWS * D;
constexpr size_t WS_XG = 395 * MiB;
constexpr size_t WS_END = 557 * MiB;
static_assert(WS_P + (size_t)M * NCOL * 2 <= WS_END && WS_XG + 2 * XG_LIST <= WS_END && WS_MH + 2 * MH_LIST <= WS_XG && (size_t)2 * MOE_ROWS * 4 <= 512 * 1024 && WS_MGU + (size_t)8 * 7168 * D <= WS_MDN && WS_MDN + (size_t)8 * D * EFF <= WS_MH && WS_FDN + (size_t)D * DFF * 2 <= WS_P, "d_ws map");
constexpr int CW_BAR = 4096;
constexpr int CW_CNT = 16384;

constexpr int RING_BYTES = 131072;
constexpr int MISC_OFF = 147456 - 256;
constexpr int LDS_BYTES = 147456;

struct Args { const float* in[25]; float* out; unsigned char* ws; int ph_lo, ph_hi; };
struct Ctx { LAS unsigned char* lds; int tid, lane, wave, bid, G; };

__device__ __forceinline__ float shx(float v, int o, int lane) { return __int_as_float(__builtin_amdgcn_ds_bpermute((lane ^ o) << 2, __float_as_int(v))); }
__device__ __forceinline__ float wave_sum(float v, int lane) {
#pragma unroll
    for (int o = 1; o < 64; o <<= 1) v += shx(v, o, lane);
    return v;
}

struct ConvJob { const float* W; int ldw; bf16* WT; int ldk, k0, n0, dst; bool f8; };
__device__ __forceinline__ void conv_load(const ConvJob& j, float (&tv)[32], int lane) {
#pragma unroll
    for (int i = 0; i < 32; ++i) tv[i] = j.W[(size_t)(j.k0 + 2 * i + (lane >> 5)) * j.ldw + j.n0 + (lane & 31)];
}
__device__ __forceinline__ void conv_store(const ConvJob& j, const float (&tv)[32], LAS float* scr, int lane) {
#pragma unroll
    for (int i = 0; i < 32; ++i) scr[(2 * i + (lane >> 5)) * 33 + (lane & 31)] = tv[i];
    LDS_WAIT(); asm volatile("" ::: "memory");
    const int c = lane & 7;
#pragma unroll
    for (int q = 0; q < 4; ++q) { const int n = (lane >> 3) + 8 * q; const LAS float* s = scr + (8 * c) * 33 + n;
        v4u o; o.x = pk2(s[0 * 33], s[1 * 33]); o.y = pk2(s[2 * 33], s[3 * 33]); o.z = pk2(s[4 * 33], s[5 * 33]); o.w = pk2(s[6 * 33], s[7 * 33]);
        *(GAS v4u*)(j.WT + (size_t)(j.dst + n) * j.ldk + j.k0 + 8 * c) = o; }
    LDS_WAIT(); asm volatile("" ::: "memory");
}
__device__ __forceinline__ void conv_store8(const ConvJob& j, const float (&tv)[32], LAS float* scr, int lane) {
#pragma unroll
    for (int i = 0; i < 32; ++i) scr[(2 * i + (lane >> 5)) * 33 + (lane & 31)] = tv[i];
    LDS_WAIT(); asm volatile("" ::: "memory");
    const int c = lane & 3; unsigned char* WT8 = (unsigned char*)j.WT;
#pragma unroll
    for (int q = 0; q < 2; ++q) { const int n = (lane >> 2) + 16 * q; const LAS float* s = scr + (16 * c) * 33 + n;
        v4u o; o.x = pk4_fp8(s[0 * 33] * SC_W8, s[1 * 33] * SC_W8, s[2 * 33] * SC_W8, s[3 * 33] * SC_W8); o.y = pk4_fp8(s[4 * 33] * SC_W8, s[5 * 33] * SC_W8, s[6 * 33] * SC_W8, s[7 * 33] * SC_W8);
        o.z = pk4_fp8(s[8 * 33] * SC_W8, s[9 * 33] * SC_W8, s[10 * 33] * SC_W8, s[11 * 33] * SC_W8); o.w = pk4_fp8(s[12 * 33] * SC_W8, s[13 * 33] * SC_W8, s[14 * 33] * SC_W8, s[15 * 33] * SC_W8);
        *(GAS v4u*)(WT8 + (size_t)(j.dst + n) * j.ldk + j.k0 + 16 * c) = o; }
    LDS_WAIT(); asm volatile("" ::: "memory");
}
__device__ __forceinline__ ConvJob conv_job(const float* W, int K, int N, bf16* WT, int mode, int item, bool f8 = false) {
    const int nblk = N / 32, kb = item / nblk, nb = item - kb * nblk, k0 = 64 * kb, n0 = 32 * nb;
    const int dst = mode == 0 ? n0 : (n0 >> 7) * 256 + (n0 & 127) + (mode == 2 ? 128 : 0);
    return ConvJob{W, N, WT, K, k0, n0, dst, f8};
}
__device__ __forceinline__ ConvJob layer_job(const Args& A, int l, int it) {
    constexpr int I_IN = 16 * 224, I_A = 8 * 32, I_O = 16 * 32, I_G = 16 * 88;
    unsigned char* ws = A.ws; int r = it;
    if (r < I_IN) { const bool gate = (r % 224) >= 128;
        return gate ? conv_job(A.in[2] + (size_t)l * D * NCOL, D, NCOL, (bf16*)(ws + WS_WIN + (size_t)4096 * D), 0, r, true) : conv_job(A.in[2] + (size_t)l * D * NCOL, D, NCOL, (bf16*)(ws + WS_WIN), 0, r); } r -= I_IN;
    if (r < I_A) return conv_job(A.in[4] + (size_t)l * 512 * D, 512, D, (bf16*)(ws + WS_WOABC), 0, r); r -= I_A;
    if (r < I_A) return conv_job(A.in[7] + (size_t)l * 512 * D, 512, D, (bf16*)(ws + WS_WOABC) + 1024 * 512, 0, r); r -= I_A;
    if (r < I_A) return conv_job(A.in[15] + (size_t)l * 512 * D, 512, D, (bf16*)(ws + WS_WOABC) + 2 * 1024 * 512, 0, r); r -= I_A;
    if (r < I_O) return conv_job(A.in[16] + (size_t)l * D * D, D, D, (bf16*)(ws + WS_WO), 0, r); r -= I_O;
    if (r < I_G) return conv_job(A.in[18], D, DFF, (bf16*)(ws + WS_FGU), 1, r); r -= I_G;
    if (r < I_G) return conv_job(A.in[19], D, DFF, (bf16*)(ws + WS_FGU), 2, r); r -= I_G;
    return conv_job(A.in[20], DFF, D, (bf16*)(ws + WS_FDN), 0, r);
}
__device__ __forceinline__ void convert_layer_weights(const Ctx& C, const Args& A, int l) {
    LAS float* scr = (LAS float*)(C.lds + C.wave * 16896);
    const int gw = C.bid * NWAVES + C.wave, NGW = C.G * NWAVES;
    constexpr int I_IN = 16 * 224, I_A = 8 * 32, I_O = 16 * 32, I_G = 16 * 88, I_D = 44 * 32;
    const int nitems = I_IN + 3 * I_A + I_O + (l == 0 ? 2 * I_G + I_D : 0);
    for (int it = gw; it < nitems; it += 2 * NGW) {
        const bool two = it + NGW < nitems;
        const ConvJob j0 = layer_job(A, l, it), j1 = layer_job(A, l, two ? it + NGW : it);
        float t0[32], t1[32];
        conv_load(j0, t0, C.lane); if (two) conv_load(j1, t1, C.lane);
        if (j0.f8) conv_store8(j0, t0, scr, C.lane); else conv_store(j0, t0, scr, C.lane);
        if (two) { if (j1.f8) conv_store8(j1, t1, scr + 64 * 33, C.lane); else conv_store(j1, t1, scr + 64 * 33, C.lane); }
    }
}
__device__ __forceinline__ ConvJob moe_job(const Args& A, int it) {
    constexpr int I_G = 16 * 112, I_D = 56 * 32, PER_E = 2 * I_G + I_D;
    unsigned char* ws = A.ws; const int e = it / PER_E; int r = it - e * PER_E;
    if (r < I_G) return conv_job(A.in[22] + (size_t)e * D * EFF, D, EFF, (bf16*)(ws + WS_MGU + (size_t)e * 7168 * D), 1, r); r -= I_G;
    if (r < I_G) return conv_job(A.in[23] + (size_t)e * D * EFF, D, EFF, (bf16*)(ws + WS_MGU + (size_t)e * 7168 * D), 2, r); r -= I_G;
    return conv_job(A.in[24] + (size_t)e * EFF * D, EFF, D, (bf16*)(ws + WS_MDN + (size_t)e * D * EFF), 0, r);
}
__device__ __forceinline__ void convert_moe_weights(const Ctx& C, const Args& A) {
    LAS float* scr = (LAS float*)(C.lds + C.wave * 16896);
    const int gw = C.bid * NWAVES + C.wave, NGW = C.G * NWAVES;
    constexpr int NIT = NEXP * (2 * 16 * 112 + 56 * 32);
    constexpr int I_G = 16 * 112, I_D = 56 * 32, PER_E = 2 * I_G + I_D;
    for (int q = gw; q < NIT / 2; q += NGW) {
        const bool two = true;
        const int e = q / (PER_E / 2); int r = q - e * (PER_E / 2), seg0 = 0, NB = 112;
        if (r >= I_G / 2) { r -= I_G / 2; seg0 = I_G; if (r >= I_G / 2) { r -= I_G / 2; seg0 = 2 * I_G; NB = 32; } }
        const int it = e * PER_E + seg0 + 2 * (r / NB) * NB + r % NB;
        const ConvJob j0 = moe_job(A, it), j1 = moe_job(A, it + NB);
        float t0[32], t1[32];
        conv_load(j0, t0, C.lane); if (two) conv_load(j1, t1, C.lane);
        conv_store8(j0, t0, scr, C.lane); if (two) conv_store8(j1, t1, scr + 64 * 33, C.lane);
    }
}
__device__ __forceinline__ void rope_table(const Ctx& C, unsigned char* ws) {
    const double invf_rev[8] = {0.15915494309189535, 0.03086376340470123, 0.005985185712713705, 0.001160663641240061,
                                0.00022507907903927653, 4.364795279280289e-05, 8.464330808241401e-06, 1.6414262627950345e-06};
    float* ct = (float*)(ws + WS_ROPE); float* st = ct + SEQ * 8;
    for (int g = C.bid * NTHR + C.tid; g < SEQ * 8; g += C.G * NTHR) {
        const int pos = g >> 3, i = g & 7;
        double f = invf_rev[0];
#pragma unroll
        for (int k = 1; k < 8; ++k) f = (i == k) ? invf_rev[k] : f;
        double t = (double)pos * f; t -= floor(t);
        ct[g] = __builtin_amdgcn_cosf((float)t); st[g] = __builtin_amdgcn_sinf((float)t);
    }
}

template <bool ROUTE, bool ALSO8>
__device__ __forceinline__ void norm_rows(const Ctx& C, const float* xin, const float* gain, bf16* XN, const float* router, unsigned char* ws, unsigned char* X8 = nullptr) {
    constexpr int RB = 4;
    const int gw = C.bid * NWAVES + C.wave, NGW = C.G * NWAVES;
    LAS float* R = (LAS float*)C.lds;
    LAS int* rt_tok = (LAS int*)(C.lds + 32768); LAS int* rt_e = rt_tok + 256; LAS float* rt_w = (LAS float*)(rt_e + 256);
    if (ROUTE) { for (int i = C.tid; i < D * NEXP / 4; i += NTHR) ((LAS f32x4*)R)[i] = ((const f32x4*)router)[i];
                 for (int i = C.tid; i < 256; i += NTHR) rt_tok[i] = -1;
                 __syncthreads(); }
    f32x4 g[4];
#pragma unroll
    for (int j = 0; j < 4; ++j) g[j] = ((const f32x4*)gain)[C.lane + 64 * j];
    int slot = C.wave;
    for (int m0 = gw; m0 < M; m0 += RB * NGW) {
        f32x4 v[RB][4];
#pragma unroll
        for (int i = 0; i < RB; ++i) { const int m = m0 + i * NGW; if (m < M) { const GAS f32x4* xr = (const GAS f32x4*)(xin + (size_t)m * D) + C.lane;
#pragma unroll
            for (int j = 0; j < 4; ++j) v[i][j] = xr[64 * j]; } }
#pragma unroll
        for (int i = 0; i < RB; ++i) { const int m = m0 + i * NGW; if (m < M) {
            float s = 0.f;
#pragma unroll
            for (int j = 0; j < 4; ++j) s += (v[i][j].x * v[i][j].x + v[i][j].y * v[i][j].y) + (v[i][j].z * v[i][j].z + v[i][j].w * v[i][j].w);
            const float rstd = 1.0f / sqrtf(wave_sum(s, C.lane) * (1.f / D) + EPS);
            GAS unsigned long long* o8 = (GAS unsigned long long*)(XN + (size_t)m * D) + C.lane;
#pragma unroll
            for (int j = 0; j < 4; ++j) { v[i][j] = v[i][j] * rstd * g[j]; o8[64 * j] = (unsigned long long)pk2(v[i][j].x, v[i][j].y) | ((unsigned long long)pk2(v[i][j].z, v[i][j].w) << 32);
                if (ALSO8) ((unsigned*)(X8 + (size_t)m * D))[C.lane + 64 * j] = pk4_fp8(v[i][j].x * SC_X8, v[i][j].y * SC_X8, v[i][j].z * SC_X8, v[i][j].w * SC_X8); }
            if (ROUTE) {
                float lg[8];
#pragma unroll
                for (int e = 0; e < 8; ++e) lg[e] = 0.f;
#pragma unroll
                for (int j = 0; j < 4; ++j)
#pragma unroll
                    for (int k = 0; k < 4; ++k) { const int d = 4 * C.lane + k + 256 * j; const f32x4 r0 = *(LAS f32x4*)(R + d * 8), r1 = *(LAS f32x4*)(R + d * 8 + 4); const float h = v[i][j][k];
                        lg[0] += h * r0.x; lg[1] += h * r0.y; lg[2] += h * r0.z; lg[3] += h * r0.w; lg[4] += h * r1.x; lg[5] += h * r1.y; lg[6] += h * r1.z; lg[7] += h * r1.w; }
#pragma unroll
                for (int e = 0; e < 8; ++e) lg[e] = wave_sum(lg[e], C.lane);
                float l1 = -INFINITY, l2 = -INFINITY; int e1 = 0, e2 = 0;
#pragma unroll
                for (int e = 0; e < 8; ++e) if (lg[e] > l1) { l1 = lg[e]; e1 = e; }
#pragma unroll
                for (int e = 0; e < 8; ++e) if (e != e1 && lg[e] > l2) { l2 = lg[e]; e2 = e; }
                if (C.lane == 0 && slot < 256) { rt_tok[slot] = m; rt_e[slot] = e1 | (e2 << 8); rt_w[slot] = 1.0f / (1.0f + expf(l2 - l1)); }
                slot += NWAVES;
            } } }
    }
    if (ROUTE) {
        __syncthreads();
        if (C.tid < 16) {
            const int list = C.tid >> 3, e = C.tid & 7; int n = 0;
            for (int sidx = 0; sidx < 256; ++sidx) { const int t = rt_tok[sidx]; const int ee = (rt_e[sidx] >> (8 * list)) & 0xff; n += (t >= 0 && ee == e) ? 1 : 0; }
            gu32* cnt = (gu32*)(ws + WS_CTL) + CW_CNT; int* tokl = (int*)(ws + WS_TOK); float* wl = (float*)(ws + WS_WL);
            unsigned pos = n ? __hip_atomic_fetch_add(cnt + C.tid, (unsigned)n, RLX_AGENT) : 0u;
            for (int sidx = 0; sidx < 256; ++sidx) { const int t = rt_tok[sidx]; const int ee = (rt_e[sidx] >> (8 * list)) & 0xff;
                if (t >= 0 && ee == e) { const float w1 = rt_w[sidx]; tokl[(size_t)C.tid * M + pos] = t; wl[(size_t)C.tid * M + pos] = list == 0 ? w1 : 1.0f - w1; ++pos; } }
        }
        __syncthreads();
    }
}

template <bool ROUTE, bool ALSO8 = false>
__device__ __forceinline__ void norm_rows_b(const Ctx& C, const bf16* xin, const float* gain, bf16* XN, const float* router, unsigned char* ws, unsigned char* X8 = nullptr) {
    constexpr int RB = 4;
    const int gw = C.bid * NWAVES + C.wave, NGW = C.G * NWAVES;
    LAS float* R = (LAS float*)C.lds;
    LAS int* rt_tok = (LAS int*)(C.lds + 32768); LAS int* rt_e = rt_tok + 256; LAS float* rt_w = (LAS float*)(rt_e + 256);
    if (ROUTE) { for (int i = C.tid; i < D * NEXP / 4; i += NTHR) ((LAS f32x4*)R)[i] = ((const f32x4*)router)[i];
                 for (int i = C.tid; i < 256; i += NTHR) rt_tok[i] = -1;
                 __syncthreads(); }
    float g[16];
#pragma unroll
    for (int c = 0; c < 2; ++c) { const f32x4 a = *(const f32x4*)(gain + 512 * c + 8 * C.lane), b = *(const f32x4*)(gain + 512 * c + 8 * C.lane + 4);
        g[8 * c] = a.x; g[8 * c + 1] = a.y; g[8 * c + 2] = a.z; g[8 * c + 3] = a.w; g[8 * c + 4] = b.x; g[8 * c + 5] = b.y; g[8 * c + 6] = b.z; g[8 * c + 7] = b.w; }
    int slot = C.wave;
    for (int m0 = gw; m0 < M; m0 += RB * NGW) {
        v4u raw[RB][2];
#pragma unroll
        for (int i = 0; i < RB; ++i) { const int m = m0 + i * NGW; if (m < M) { const v4u* xr = (const v4u*)(xin + (size_t)m * D) + C.lane; raw[i][0] = xr[0]; raw[i][1] = xr[64]; } }
#pragma unroll
        for (int i = 0; i < RB; ++i) { const int m = m0 + i * NGW; if (m < M) {
            float v[16];
#pragma unroll
            for (int c = 0; c < 2; ++c) { const v4u w = raw[i][c]; v[8 * c] = bflo(w.x); v[8 * c + 1] = bfhi(w.x); v[8 * c + 2] = bflo(w.y); v[8 * c + 3] = bfhi(w.y); v[8 * c + 4] = bflo(w.z); v[8 * c + 5] = bfhi(w.z); v[8 * c + 6] = bflo(w.w); v[8 * c + 7] = bfhi(w.w); }
            float s = 0.f;
#pragma unroll
            for (int k = 0; k < 16; ++k) s += v[k] * v[k];
            const float rstd = 1.0f / sqrtf(wave_sum(s, C.lane) * (1.f / D) + EPS);
#pragma unroll
            for (int k = 0; k < 16; ++k) v[k] = v[k] * rstd * g[k];
            if (ROUTE) {
                v2u* o8 = (v2u*)((unsigned char*)XN + (size_t)m * D) + C.lane;
#pragma unroll
                for (int c = 0; c < 2; ++c) { v2u w; w.x = pk4_fp8(v[8 * c] * SC_X8, v[8 * c + 1] * SC_X8, v[8 * c + 2] * SC_X8, v[8 * c + 3] * SC_X8); w.y = pk4_fp8(v[8 * c + 4] * SC_X8, v[8 * c + 5] * SC_X8, v[8 * c + 6] * SC_X8, v[8 * c + 7] * SC_X8); o8[64 * c] = w; }
            } else {
            v4u* o = (v4u*)(XN + (size_t)m * D) + C.lane;
#pragma unroll
            for (int c = 0; c < 2; ++c) { v4u w; w.x = pk2(v[8 * c], v[8 * c + 1]); w.y = pk2(v[8 * c + 2], v[8 * c + 3]); w.z = pk2(v[8 * c + 4], v[8 * c + 5]); w.w = pk2(v[8 * c + 6], v[8 * c + 7]); o[64 * c] = w; }
            if (ALSO8) { v2u* o8 = (v2u*)(X8 + (size_t)m * D) + C.lane;
#pragma unroll
                for (int c = 0; c < 2; ++c) { v2u w; w.x = pk4_fp8(v[8 * c] * SC_X8, v[8 * c + 1] * SC_X8, v[8 * c + 2] * SC_X8, v[8 * c + 3] * SC_X8); w.y = pk4_fp8(v[8 * c + 4] * SC_X8, v[8 * c + 5] * SC_X8, v[8 * c + 6] * SC_X8, v[8 * c + 7] * SC_X8); o8[64 * c] = w; } }
            }
            if (ROUTE) {
                float lg[8];
#pragma unroll
                for (int e = 0; e < 8; ++e) lg[e] = 0.f;
#pragma unroll
                for (int c = 0; c < 2; ++c)
#pragma unroll
                    for (int k = 0; k < 8; ++k) { const int d = 512 * c + 8 * C.lane + k; const f32x4 r0 = *(LAS f32x4*)(R + d * 8), r1 = *(LAS f32x4*)(R + d * 8 + 4); const float h = v[8 * c + k];
                        lg[0] += h * r0.x; lg[1] += h * r0.y; lg[2] += h * r0.z; lg[3] += h * r0.w; lg[4] += h * r1.x; lg[5] += h * r1.y; lg[6] += h * r1.z; lg[7] += h * r1.w; }
#pragma unroll
                for (int e = 0; e < 8; ++e) lg[e] = wave_sum(lg[e], C.lane);
                float l1 = -INFINITY, l2 = -INFINITY; int e1 = 0, e2 = 0;
#pragma unroll
                for (int e = 0; e < 8; ++e) if (lg[e] > l1) { l1 = lg[e]; e1 = e; }
#pragma unroll
                for (int e = 0; e < 8; ++e) if (e != e1 && lg[e] > l2) { l2 = lg[e]; e2 = e; }
                if (C.lane == 0 && slot < 256) { rt_tok[slot] = m; rt_e[slot] = e1 | (e2 << 8); rt_w[slot] = 1.0f / (1.0f + expf(l2 - l1)); }
                slot += NWAVES;
            } } }
    }
    if (ROUTE) {
        __syncthreads();
        if (C.tid < 16) {
            const int list = C.tid >> 3, e = C.tid & 7; int n = 0;
            for (int sidx = 0; sidx < 256; ++sidx) { const int t = rt_tok[sidx]; const int ee = (rt_e[sidx] >> (8 * list)) & 0xff; n += (t >= 0 && ee == e) ? 1 : 0; }
            gu32* cnt = (gu32*)(ws + WS_CTL) + CW_CNT; int* tokl = (int*)(ws + WS_TOK); float* wl = (float*)(ws + WS_WL);
            unsigned pos = n ? __hip_atomic_fetch_add(cnt + C.tid, (unsigned)n, RLX_AGENT) : 0u;
            for (int sidx = 0; sidx < 256; ++sidx) { const int t = rt_tok[sidx]; const int ee = (rt_e[sidx] >> (8 * list)) & 0xff;
                if (t >= 0 && ee == e) { const float w1 = rt_w[sidx]; tokl[(size_t)C.tid * M + pos] = t; wl[(size_t)C.tid * M + pos] = list == 0 ? w1 : 1.0f - w1; ++pos; } }
        }
        __syncthreads();
    }
}

__device__ __forceinline__ void qk_item(const Ctx& C, const Args& A, int l, int item) {
    unsigned char* ws = A.ws; bf16* P = (bf16*)(ws + WS_P);
    const float* ct = (const float*)(ws + WS_ROPE); const float* st = ct + SEQ * 8;
    const int rb = item >> 3, h = item & 7, ch = C.tid & 7, rg = C.tid >> 3;
    LAS float* part = (LAS float*)C.lds;
    for (int which = 0; which < 2; ++which) {
        const float* gn = A.in[which == 0 ? 5 : 6] + l * HD + ch * 8;
        const f32x4 ga = *(const f32x4*)gn, gb = *(const f32x4*)(gn + 4);
        const float gv[8] = {ga.x, ga.y, ga.z, ga.w, gb.x, gb.y, gb.z, gb.w};
        float ks[8];
#pragma unroll
        for (int j = 0; j < 8; ++j) ks[j] = 0.f;
        v4u wv[4]; f32x4 c0[4], c1[4], s0[4], s1[4];
#pragma unroll
        for (int pass = 0; pass < 4; ++pass) { const int row = rb * 256 + pass * 64 + rg, pos = row & (SEQ - 1);
            wv[pass] = *(const v4u*)(P + (size_t)row * NCOL + (which == 0 ? C_Q : C_K) + h * HD + ch * 8);
            c0[pass] = *(const f32x4*)(ct + pos * 8); c1[pass] = *(const f32x4*)(ct + pos * 8 + 4); s0[pass] = *(const f32x4*)(st + pos * 8); s1[pass] = *(const f32x4*)(st + pos * 8 + 4); }
#pragma unroll
        for (int pass = 0; pass < 4; ++pass) {
            const int row = rb * 256 + pass * 64 + rg;
            bf16* p = P + (size_t)row * NCOL + (which == 0 ? C_Q : C_K) + h * HD + ch * 8;
            const v4u w = wv[pass];
            float v[8] = {bflo(w.x), bfhi(w.x), bflo(w.y), bfhi(w.y), bflo(w.z), bfhi(w.z), bflo(w.w), bfhi(w.w)};
            const float cs8[8] = {c0[pass].x, c0[pass].y, c0[pass].z, c0[pass].w, c1[pass].x, c1[pass].y, c1[pass].z, c1[pass].w};
            const float sn8[8] = {s0[pass].x, s0[pass].y, s0[pass].z, s0[pass].w, s1[pass].x, s1[pass].y, s1[pass].z, s1[pass].w};
            float ss = 0.f;
#pragma unroll
            for (int j = 0; j < 8; ++j) ss += v[j] * v[j];
            ss += shx(ss, 1, C.lane); ss += shx(ss, 2, C.lane); ss += shx(ss, 4, C.lane);
            const float rstd = 1.0f / sqrtf(ss * (1.f / HD) + EPS);
#pragma unroll
            for (int j = 0; j < 8; ++j) v[j] = v[j] * rstd * gv[j];
#pragma unroll
            for (int j = 0; j < 8; ++j) {
                const float other = shx(v[j], 1, C.lane);
                const float rot = (ch == 0) ? (v[j] * cs8[j] - other * sn8[j]) : (v[j] * cs8[j] + other * sn8[j]);
                v[j] = (ch < 2) ? rot : v[j];
            }
            if (which == 0) {
#pragma unroll
                for (int j = 0; j < 8; ++j) v[j] *= QSCALE;
            } else {
#pragma unroll
                for (int j = 0; j < 8; ++j) ks[j] += v[j];
            }
            v4u o; o.x = pk2(v[0], v[1]); o.y = pk2(v[2], v[3]); o.z = pk2(v[4], v[5]); o.w = pk2(v[6], v[7]);
            *(v4u*)p = o;
        }
        if (which == 1) {
#pragma unroll
            for (int j = 0; j < 8; ++j) part[rg * 64 + ch * 8 + j] = ks[j];
            __syncthreads();
            if (C.tid < 64) { float s = 0.f;
#pragma unroll 16
                for (int r = 0; r < 64; ++r) s += part[r * 64 + C.tid];
                const int b = rb >> 4, blk = rb & 15;
                ((float*)(ws + WS_KMEAN))[(size_t)((b * NH + h) * NBLK + blk) * HD + C.tid] = s * (1.f / 256.f); }
            __syncthreads();
        }
    }
}
__device__ __forceinline__ void conva_tasks(const Ctx& C, const Args& A, int l) {
    bf16* P = (bf16*)(A.ws + WS_P); const float* cw = A.in[3] + l * 3 * 512;
    const int stride = C.G * NTHR;
    for (int g0 = C.bid * NTHR + C.tid; g0 < M * 64; g0 += 4 * stride) {
        v4u xa[4][3], ca[4][3], ba[4];
#pragma unroll
        for (int i = 0; i < 4; ++i) { const int g = g0 + i * stride; if (g < M * 64) { const int row = g >> 6, c = (g & 63) * 8, t = row & (SEQ - 1);
            const bf16* base = P + (size_t)row * NCOL + c;
#pragma unroll
            for (int k = 0; k < 3; ++k) { const int dt = 2 - k; if (t >= dt) { xa[i][k] = *(const v4u*)(base - (size_t)dt * NCOL + C_XA); ca[i][k] = *(const v4u*)(base - (size_t)dt * NCOL + C_CA); } else { xa[i][k] = (v4u){0u, 0u, 0u, 0u}; ca[i][k] = xa[i][k]; } }
            ba[i] = *(const v4u*)(base + C_BA); } }
#pragma unroll
        for (int i = 0; i < 4; ++i) { const int g = g0 + i * stride; if (g < M * 64) { const int row = g >> 6, c = (g & 63) * 8;
            float acc[8];
#pragma unroll
            for (int j = 0; j < 8; ++j) acc[j] = 0.f;
#pragma unroll
            for (int k = 0; k < 3; ++k) {
                const v4u x = xa[i][k], cc = ca[i][k];
                const f32x4 w0 = *(const f32x4*)(cw + k * 512 + c), w1 = *(const f32x4*)(cw + k * 512 + c + 4);
                acc[0] += w0.x * (bflo(x.x) * bflo(cc.x)); acc[1] += w0.y * (bfhi(x.x) * bfhi(cc.x)); acc[2] += w0.z * (bflo(x.y) * bflo(cc.y)); acc[3] += w0.w * (bfhi(x.y) * bfhi(cc.y));
                acc[4] += w1.x * (bflo(x.z) * bflo(cc.z)); acc[5] += w1.y * (bfhi(x.z) * bfhi(cc.z)); acc[6] += w1.z * (bflo(x.w) * bflo(cc.w)); acc[7] += w1.w * (bfhi(x.w) * bfhi(cc.w));
            }
            const v4u b = ba[i];
            v4u o; o.x = pk2(bflo(b.x) * acc[0], bfhi(b.x) * acc[1]); o.y = pk2(bflo(b.y) * acc[2], bfhi(b.y) * acc[3]);
            o.z = pk2(bflo(b.z) * acc[4], bfhi(b.z) * acc[5]); o.w = pk2(bflo(b.w) * acc[6], bfhi(b.w) * acc[7]);
            *(v4u*)(P + (size_t)row * NCOL + c + C_BA) = o; } }
    }
}
__device__ __forceinline__ void lru_pass1_phase(const Ctx& C, const Args& A, int l) {
    typedef pg8::bf16x8 bx8;
    unsigned char* ws = A.ws; const bf16* P = (const bf16*)(ws + WS_P);
    bf16* LA = (bf16*)A.out + (size_t)M * D; bf16* UU = LA + (size_t)M * 512;
    const int hb = C.wave, lane = C.lane, fr = lane & 15, fq = lane >> 4, c = hb * 64 + lane;
    bx8 wR[2][4], wI[2][4]; float bR[4], bI[4];
    { const float* wrp = A.in[10] + (size_t)l * 32768 + hb * 4096; const float* wip = A.in[12] + (size_t)l * 32768 + hb * 4096;
#pragma unroll
      for (int ks = 0; ks < 2; ++ks)
#pragma unroll
        for (int ct = 0; ct < 4; ++ct) { const int k0 = 32 * ks + 8 * fq, col = 16 * ct + fr; v4u a, b2;
            a.x = pk2(wrp[(k0 + 0) * 64 + col], wrp[(k0 + 1) * 64 + col]); a.y = pk2(wrp[(k0 + 2) * 64 + col], wrp[(k0 + 3) * 64 + col]);
            a.z = pk2(wrp[(k0 + 4) * 64 + col], wrp[(k0 + 5) * 64 + col]); a.w = pk2(wrp[(k0 + 6) * 64 + col], wrp[(k0 + 7) * 64 + col]);
            b2.x = pk2(wip[(k0 + 0) * 64 + col], wip[(k0 + 1) * 64 + col]); b2.y = pk2(wip[(k0 + 2) * 64 + col], wip[(k0 + 3) * 64 + col]);
            b2.z = pk2(wip[(k0 + 4) * 64 + col], wip[(k0 + 5) * 64 + col]); b2.w = pk2(wip[(k0 + 6) * 64 + col], wip[(k0 + 7) * 64 + col]);
            wR[ks][ct] = __builtin_bit_cast(bx8, a); wI[ks][ct] = __builtin_bit_cast(bx8, b2); }
#pragma unroll
      for (int ct = 0; ct < 4; ++ct) { bR[ct] = A.in[11][l * 512 + hb * 64 + 16 * ct + fr]; bI[ct] = A.in[13][l * 512 + hb * 64 + 16 * ct + fr]; } }
    const float lam = A.in[14][l * 512 + c];
    const float sp = log1pf(expf(-lam));
    const float* cw = A.in[8] + l * 4 * 512 + c; const float w0 = cw[0], w1 = cw[512], w2 = cw[1024], w3 = cw[1536], bc = A.in[9][l * 512 + c];
    LAS unsigned char* wl = C.lds + hb * 13312;
    LAS unsigned short* Xs = (LAS unsigned short*)wl; LAS unsigned* Gs = (LAS unsigned*)(wl + 4608);
    for (int item = C.bid; item < BATCH * NCH; item += C.G) {
        const int b = item >> 6, ci = item & 63;
        const size_t row0 = (size_t)b * SEQ + ci * LCH;
        const bf16* xcp = P + row0 * NCOL + C_XC + c;
        float x3 = 0.f, x2 = 0.f, x1 = 0.f;
        if (ci > 0) { x3 = bf2f(*(xcp - 3 * (size_t)NCOL)); x2 = bf2f(*(xcp - 2 * (size_t)NCOL)); x1 = bf2f(*(xcp - (size_t)NCOL)); }
        float Ap = 1.f, h = 0.f;
#pragma unroll 1
        for (int sub = 0; sub < 2; ++sub) {
            { bf16 xin[32];
#pragma unroll
              for (int r = 0; r < 32; ++r) xin[r] = xcp[(size_t)(sub * 32 + r) * NCOL];
#pragma unroll
              for (int r = 0; r < 32; ++r) { const float x0 = bf2f(xin[r]); const float xv = w0 * x3 + w1 * x2 + w2 * x1 + w3 * x0 + bc; x3 = x2; x2 = x1; x1 = x0; Xs[r * 72 + lane] = f2bf(xv); } }
            LDS_WAIT();
            pg8::f32x4 aR[2][4], aI[2][4];
#pragma unroll
            for (int rt = 0; rt < 2; ++rt)
#pragma unroll
                for (int ct = 0; ct < 4; ++ct) { aR[rt][ct] = (pg8::f32x4){0.f, 0.f, 0.f, 0.f}; aI[rt][ct] = (pg8::f32x4){0.f, 0.f, 0.f, 0.f}; }
#pragma unroll
            for (int rt = 0; rt < 2; ++rt)
#pragma unroll
                for (int ks = 0; ks < 2; ++ks) { const bx8 af = *(const LAS bx8*)(wl + (16 * rt + fr) * 144 + (32 * ks + 8 * fq) * 2);
#pragma unroll
                    for (int ct = 0; ct < 4; ++ct) { aR[rt][ct] = __builtin_amdgcn_mfma_f32_16x16x32_bf16(af, wR[ks][ct], aR[rt][ct], 0, 0, 0); aI[rt][ct] = __builtin_amdgcn_mfma_f32_16x16x32_bf16(af, wI[ks][ct], aI[rt][ct], 0, 0, 0); } }
#pragma unroll
            for (int rt = 0; rt < 2; ++rt)
#pragma unroll
                for (int ct = 0; ct < 4; ++ct)
#pragma unroll
                    for (int jj = 0; jj < 4; ++jj) Gs[(16 * rt + 4 * fq + jj) * 68 + 16 * ct + fr] = pk2(sigmoidf_(aR[rt][ct][jj] + bR[ct]), sigmoidf_(aI[rt][ct][jj] + bI[ct]));
            LDS_WAIT();
#pragma unroll 4
            for (int r = 0; r < 32; ++r) {
                const unsigned g = Gs[r * 68 + lane]; const float xv = bf2f(Xs[r * 72 + lane]);
                const float la = bfround(-8.0f * bflo(g) * sp), a = __expf(la), x2l = 2.0f * la;
                const float em = (x2l > -0.25f) ? -(x2l * (1.f + x2l * (0.5f + x2l * (0.16666667f + x2l * (0.041666668f + x2l * (0.0083333338f + x2l * 0.0013888889f)))))) : (1.0f - __expf(x2l));
                const float u = bfround(sqrtf(em) * (bfhi(g) * xv));
                Ap *= a; h = a * h + u;
                Gs[r * 68 + lane] = pk2(la, u);
            }
            LDS_WAIT();
#pragma unroll
            for (int q = 0; q < 4; ++q) { const int rr = (lane >> 3) + 8 * q, ch = lane & 7;
                const v4u w0 = *(const LAS v4u*)(Gs + rr * 68 + ch * 8), w1 = *(const LAS v4u*)(Gs + rr * 68 + ch * 8 + 4);
                v4u lo, hi;
                lo.x = (w0.x & 0xffffu) | (w0.y << 16); lo.y = (w0.z & 0xffffu) | (w0.w << 16); lo.z = (w1.x & 0xffffu) | (w1.y << 16); lo.w = (w1.z & 0xffffu) | (w1.w << 16);
                hi.x = (w0.x >> 16) | (w0.y & 0xffff0000u); hi.y = (w0.z >> 16) | (w0.w & 0xffff0000u); hi.z = (w1.x >> 16) | (w1.y & 0xffff0000u); hi.w = (w1.z >> 16) | (w1.w & 0xffff0000u);
                const size_t o = (row0 + sub * 32 + rr) * 512 + hb * 64 + ch * 8;
                *(v4u*)(LA + o) = lo; *(v4u*)(UU + o) = hi; }
            LDS_WAIT();
        }
        ((f32x2*)(ws + WS_SUM))[(size_t)(b * NCH + ci) * 512 + c] = (f32x2){Ap, h};
    }
}
__device__ __forceinline__ void lru_pass2_item(const Ctx& C, const Args& A, int item) {
    unsigned char* ws = A.ws; bf16* P = (bf16*)(ws + WS_P);
    const bf16* LA = (const bf16*)A.out + (size_t)M * D; const bf16* UU = LA + (size_t)M * 512;
    const int b = item >> 6, ci = item & 63, w = C.wave, lane = C.lane, c8 = lane * 8;
    LAS f32x4* comp = (LAS f32x4*)C.lds;
    LAS f32x4* loc = comp + 8 * 64 * 4;
    const size_t row0 = (size_t)b * SEQ + ci * LCH + w * 8;
    v4u la4[8], u4[8];
#pragma unroll
    for (int r = 0; r < 8; ++r) { la4[r] = *(const v4u*)(LA + (row0 + r) * 512 + c8); u4[r] = *(const v4u*)(UU + (row0 + r) * 512 + c8); }
    float fa[8], fh[8];
#pragma unroll
    for (int k = 0; k < 8; ++k) { fa[k] = 1.f; fh[k] = 0.f; }
    { const int clo = (ci * w) >> 3, chi = (ci * (w + 1)) >> 3;
      const f32x4* sm = (const f32x4*)(ws + WS_SUM) + ((size_t)(b * NCH) * 512 + c8) / 2;
      for (int cc = clo; cc < chi; ++cc) { const f32x4* s = sm + (size_t)cc * 256;
#pragma unroll
        for (int q = 0; q < 4; ++q) { const f32x4 v = s[q]; fh[2 * q] = v.x * fh[2 * q] + v.y; fa[2 * q] *= v.x; fh[2 * q + 1] = v.z * fh[2 * q + 1] + v.w; fa[2 * q + 1] *= v.z; } } }
#pragma unroll
    for (int q = 0; q < 4; ++q) comp[(w * 64 + lane) * 4 + q] = (f32x4){fa[2 * q], fh[2 * q], fa[2 * q + 1], fh[2 * q + 1]};
    float ta[8], th[8];
#pragma unroll
    for (int k = 0; k < 8; ++k) { ta[k] = 1.f; th[k] = 0.f; }
#pragma unroll
    for (int r = 0; r < 8; ++r) { const v4u lw = la4[r], uw = u4[r];
        const float l8[8] = {bflo(lw.x), bfhi(lw.x), bflo(lw.y), bfhi(lw.y), bflo(lw.z), bfhi(lw.z), bflo(lw.w), bfhi(lw.w)};
        const float u8[8] = {bflo(uw.x), bfhi(uw.x), bflo(uw.y), bfhi(uw.y), bflo(uw.z), bfhi(uw.z), bflo(uw.w), bfhi(uw.w)};
#pragma unroll
        for (int k = 0; k < 8; ++k) { const float a = __expf(l8[k]); ta[k] *= a; th[k] = a * th[k] + u8[k]; } }
#pragma unroll
    for (int q = 0; q < 4; ++q) loc[(w * 64 + lane) * 4 + q] = (f32x4){ta[2 * q], th[2 * q], ta[2 * q + 1], th[2 * q + 1]};
    __syncthreads();
#pragma unroll
    for (int r = 0; r < 8; ++r) asm volatile("" : "+v"(la4[r]), "+v"(u4[r]));
    v4u g4[8];
#pragma unroll
    for (int r = 0; r < 8; ++r) g4[r] = *(const v4u*)(P + (row0 + r) * NCOL + C_GC + c8);
    float h[8];
#pragma unroll
    for (int k = 0; k < 8; ++k) h[k] = 0.f;
#pragma unroll
    for (int ww = 0; ww < 8; ++ww)
#pragma unroll
        for (int q = 0; q < 4; ++q) { const f32x4 v = comp[(ww * 64 + lane) * 4 + q]; h[2 * q] = v.x * h[2 * q] + v.y; h[2 * q + 1] = v.z * h[2 * q + 1] + v.w; }
    for (int ww = 0; ww < w; ++ww)
#pragma unroll
        for (int q = 0; q < 4; ++q) { const f32x4 v = loc[(ww * 64 + lane) * 4 + q]; h[2 * q] = v.x * h[2 * q] + v.y; h[2 * q + 1] = v.z * h[2 * q + 1] + v.w; }
#pragma unroll
    for (int r = 0; r < 8; ++r) { const v4u lw = la4[r], uw = u4[r], gw = g4[r];
        const float l8[8] = {bflo(lw.x), bfhi(lw.x), bflo(lw.y), bfhi(lw.y), bflo(lw.z), bfhi(lw.z), bflo(lw.w), bfhi(lw.w)};
        const float u8[8] = {bflo(uw.x), bfhi(uw.x), bflo(uw.y), bfhi(uw.y), bflo(uw.z), bfhi(uw.z), bflo(uw.w), bfhi(uw.w)};
        const float g8[8] = {bflo(gw.x), bfhi(gw.x), bflo(gw.y), bfhi(gw.y), bflo(gw.z), bfhi(gw.z), bflo(gw.w), bfhi(gw.w)};
        float y[8];
#pragma unroll
        for (int k = 0; k < 8; ++k) { h[k] = __expf(l8[k]) * h[k] + u8[k]; const float x = g8[k]; y[k] = x * rcp_(1.0f + __expf(-1.5957691216f * (x + 0.044715f * x * x * x))) * h[k]; }
        v4u o; o.x = pk2(y[0], y[1]); o.y = pk2(y[2], y[3]); o.z = pk2(y[4], y[5]); o.w = pk2(y[6], y[7]);
        *(v4u*)(P + (row0 + r) * NCOL + C_GC + c8) = o; }
    __syncthreads();
}

struct PlainSched {
    pg8::TileOrder T; const char* A; const char* B; size_t tA, tB;
    __device__ __forceinline__ bool next(int i, pg8::Unit& u) const { int pm, pn; if (!T.map((long)i * T.G + T.c, pm, pn)) return false;
        u.pm = pm; u.pn = pn; u.a = A + (size_t)pm * tA; u.b = B + (size_t)pn * tB; u.x = 0; return true; }
    __device__ __forceinline__ void a_ready(const pg8::Unit&) const {}
    __device__ __forceinline__ void done(const pg8::Unit&) const {}
};
struct MergeSched {
    pg8::TileOrder T; const char* P; const char* W;
    __device__ __forceinline__ bool next(int i, pg8::Unit& u) const { const int ti = i / 3, br = i - 3 * ti; int pm, pn; if (!T.map((long)ti * T.G + T.c, pm, pn)) return false;
        const int colA = br == 0 ? C_BA : (br == 1 ? C_Q : C_GC);
        u.pm = pm; u.pn = pn; u.a = P + ((size_t)pm * 256 * NCOL + colA) * 2; u.b = W + ((size_t)br * 1024 * 512 + (size_t)pn * 256 * 512) * 2; u.x = br; return true; }
    __device__ __forceinline__ void a_ready(const pg8::Unit&) const {}
    __device__ __forceinline__ void done(const pg8::Unit&) const {}
};
struct MoeTiles {
    int nt[8]; int ntiles;
    __device__ __forceinline__ void init(const unsigned* cnt) { ntiles = 0;
#pragma unroll
        for (int e = 0; e < 8; ++e) { nt[e] = (int)((cnt[e] + 255u) >> 8); ntiles += nt[e]; } }
    __device__ __forceinline__ void locate(int pm, int& e, int& base) const { e = 0; base = 0; int cum = 0;
#pragma unroll
        for (int k = 0; k < 7; ++k) { cum += nt[k]; if (pm >= cum) { e = k + 1; base = cum; } } }
};
struct MoeSched {
    pg8::TileOrder T0, T1; const unsigned* cnt; int l0, first0, l1, first1;
    const char* A; size_t tA; const char* W; size_t eStride, tB; int skipE, skipR;
    __device__ __forceinline__ void init(const unsigned* cnt_, int nN, int G, int c, int l0_, int f0, int n0, int l1_, int f1, int n1) {
        cnt = cnt_; l0 = l0_; first0 = f0; l1 = l1_; first1 = f1; T0.init(n0, nN, G, c); T1.init(n1, nN, G, c); skipE = 0; skipR = 0; }
    __device__ __forceinline__ int nunits() const { return T0.nwg + T1.nwg; }
    __device__ __forceinline__ bool next(int i, pg8::Unit& u) const { int pm, pn, list;
        const int G = T0.G, c = T0.c, ge = G - skipE;
        const long L = (c < skipE) ? (long)skipR * ge + (long)i * G + c : (i < skipR ? (long)i * ge + (c - skipE) : (long)skipR * ge + (long)(i - skipR) * G + c);
        if (L < T0.nwg) { T0.map(L, pm, pn); pm += first0; list = l0; } else { if (!T1.map(L - T0.nwg, pm, pn)) return false; pm += first1; list = l1; }
        MoeTiles mt; mt.init(cnt + 8 * list); int e, base; mt.locate(pm, e, base);
        u.pm = list * MOE_TILES + pm; u.pn = pn; u.a = A + (size_t)u.pm * tA; u.b = W + (size_t)e * eStride + (size_t)pn * tB; u.x = e; return true; }
    __device__ __forceinline__ void a_ready(const pg8::Unit&) const {}
    __device__ __forceinline__ void done(const pg8::Unit&) const {}
};

struct EpiMerge {
    static constexpr bool PERM = true, AFTER_DRAIN = false, CHAIN = true;
    bf16* MG; const bf16* P;
    __device__ __forceinline__ void operator()(const pg8::f32x4 (&)[2][2][4][2], const pg8::Unit&, int, int, int, int) const {}
    __device__ __forceinline__ bool chain(pg8::f32x4 (&acc)[2][2][4][2], const pg8::Unit& u, int wr, int wc, int fr, int fq) const {
        const int br = u.x, row0 = u.pm * 256 + wr * 64 + fr, col0 = u.pn * 256 + wc * 32 + 8 * fq;
#pragma unroll
        for (int ai = 0; ai < 2; ++ai) {
            v4u gn[4][2], gd[4][2];
#pragma unroll
            for (int m = 0; m < 4; ++m)
#pragma unroll
                for (int bj = 0; bj < 2; ++bj) { const size_t row = (size_t)(row0 + ai * 128 + m * 16); const int col = col0 + bj * 128;
                    gn[m][bj] = *(const v4u*)(P + row * NCOL + C_G + br * 1024 + col);
                    gd[m][bj] = (br < 2) ? *(const v4u*)(P + row * NCOL + C_G + (br + 1) * 1024 + col) : (v4u){0u, 0u, 0u, 0u}; }
#pragma unroll
            for (int m = 0; m < 4; ++m)
#pragma unroll
                for (int bj = 0; bj < 2; ++bj) { const size_t row = (size_t)(row0 + ai * 128 + m * 16); const int col = col0 + bj * 128;
                    const v4u a = gn[m][bj], d = gd[m][bj];
                    const float an[8] = {bflo(a.x), bfhi(a.x), bflo(a.y), bfhi(a.y), bflo(a.z), bfhi(a.z), bflo(a.w), bfhi(a.w)};
                    const float dn[8] = {bflo(d.x), bfhi(d.x), bflo(d.y), bfhi(d.y), bflo(d.z), bfhi(d.z), bflo(d.w), bfhi(d.w)};
                    float f[8];
#pragma unroll
                    for (int k = 0; k < 8; ++k) f[k] = (br < 2) ? an[k] * rcp_(fmaxf(dn[k], 1e-30f)) : an[k];
                    pg8::f32x4& v0 = acc[ai][bj][m][0]; pg8::f32x4& v1 = acc[ai][bj][m][1];
                    v0[0] *= f[0]; v0[1] *= f[1]; v0[2] *= f[2]; v0[3] *= f[3]; v1[0] *= f[4]; v1[1] *= f[5]; v1[2] *= f[6]; v1[3] *= f[7];
                    if (br == 2) { v4u w; w.x = pk2(v0[0], v0[1]); w.y = pk2(v0[2], v0[3]); w.z = pk2(v1[0], v1[1]); w.w = pk2(v1[2], v1[3]); *(v4u*)(MG + row * D + col) = w; } }
            asm volatile("" ::: "memory");
        }
        return br < 2;
    }
};
template <bool BASE_F32>
struct EpiRes {
    static constexpr bool PERM = true, AFTER_DRAIN = false, CHAIN = false;
    const void* base; bf16* out;
    __device__ __forceinline__ void operator()(const pg8::f32x4 (&acc)[2][2][4][2], const pg8::Unit& u, int wr, int wc, int fr, int fq) const {
        const int row0 = u.pm * 256 + wr * 64 + fr, col0 = u.pn * 256 + wc * 32 + 8 * fq;
#pragma unroll
        for (int ai = 0; ai < 2; ++ai) {
            f32x4 b0[4][2], b1[4][2];
#pragma unroll
            for (int m = 0; m < 4; ++m)
#pragma unroll
                for (int bj = 0; bj < 2; ++bj) { const size_t off = (size_t)(row0 + ai * 128 + m * 16) * D + col0 + bj * 128;
                    if (BASE_F32) { b0[m][bj] = *(const f32x4*)((const float*)base + off); b1[m][bj] = *(const f32x4*)((const float*)base + off + 4); }
                    else { const v4u w = *(const v4u*)((const bf16*)base + off); b0[m][bj] = (f32x4){bflo(w.x), bfhi(w.x), bflo(w.y), bfhi(w.y)}; b1[m][bj] = (f32x4){bflo(w.z), bfhi(w.z), bflo(w.w), bfhi(w.w)}; } }
#pragma unroll
            for (int m = 0; m < 4; ++m)
#pragma unroll
                for (int bj = 0; bj < 2; ++bj) { const size_t off = (size_t)(row0 + ai * 128 + m * 16) * D + col0 + bj * 128;
                    const f32x4 r0 = b0[m][bj] + acc[ai][bj][m][0], r1 = b1[m][bj] + acc[ai][bj][m][1];
                    v4u w; w.x = pk2(r0[0], r0[1]); w.y = pk2(r0[2], r0[3]); w.z = pk2(r1[0], r1[1]); w.w = pk2(r1[2], r1[3]);
                    *(v4u*)(out + off) = w; }
            asm volatile("" ::: "memory");
        }
    }
};
struct EpiSwiGLU {
    static constexpr bool PERM = true, AFTER_DRAIN = false, CHAIN = false;
    bf16* H; int ldc;
    __device__ __forceinline__ void operator()(const pg8::f32x4 (&acc)[2][2][4][2], const pg8::Unit& u, int wr, int wc, int fr, int fq) const {
        const int row0 = u.pm * 256 + wr * 64 + fr, col0 = u.pn * 128 + wc * 32 + 8 * fq;
#pragma unroll
        for (int ai = 0; ai < 2; ++ai)
#pragma unroll
            for (int m = 0; m < 4; ++m) { const f32x4 g0 = acc[ai][0][m][0], g1 = acc[ai][0][m][1], u0 = acc[ai][1][m][0], u1 = acc[ai][1][m][1];
                v4u w; w.x = pk2(g0[0] * sigmoidf_(g0[0]) * u0[0], g0[1] * sigmoidf_(g0[1]) * u0[1]); w.y = pk2(g0[2] * sigmoidf_(g0[2]) * u0[2], g0[3] * sigmoidf_(g0[3]) * u0[3]);
                w.z = pk2(g1[0] * sigmoidf_(g1[0]) * u1[0], g1[1] * sigmoidf_(g1[1]) * u1[1]); w.w = pk2(g1[2] * sigmoidf_(g1[2]) * u1[2], g1[3] * sigmoidf_(g1[3]) * u1[3]);
                *(v4u*)(H + (size_t)(row0 + ai * 128 + m * 16) * ldc + col0) = w; }
    }
};
struct EpiSwiGLU8 {
    static constexpr bool PERM = true, AFTER_DRAIN = false, CHAIN = false;
    unsigned char* H; int ldc;
    __device__ __forceinline__ void operator()(const pg8::f32x4 (&acc)[2][2][4][2], const pg8::Unit& u, int wr, int wc, int fr, int fq) const {
        const int row0 = u.pm * 256 + wr * 64 + fr, colw = u.pn * 128 + wc * 32; constexpr float ds = 1.0f / (SC_X8 * SC_W8);
        const bool odd = (fq & 1) != 0;
        unsigned char* p = H + (size_t)(row0 + (odd ? 16 : 0)) * ldc + colw + 8 * (fq & ~1);
#pragma unroll
        for (int ai = 0; ai < 2; ++ai)
#pragma unroll
            for (int mp = 0; mp < 2; ++mp) {
                v2u x[2];
#pragma unroll
                for (int h = 0; h < 2; ++h) { const int m = 2 * mp + h;
                    const f32x4 g0 = acc[ai][0][m][0] * ds, g1 = acc[ai][0][m][1] * ds, u0 = acc[ai][1][m][0] * (ds * SC_H8), u1 = acc[ai][1][m][1] * (ds * SC_H8);
                    x[h].x = pk4_fp8(g0[0] * sigmoidf_(g0[0]) * u0[0], g0[1] * sigmoidf_(g0[1]) * u0[1], g0[2] * sigmoidf_(g0[2]) * u0[2], g0[3] * sigmoidf_(g0[3]) * u0[3]);
                    x[h].y = pk4_fp8(g1[0] * sigmoidf_(g1[0]) * u1[0], g1[1] * sigmoidf_(g1[1]) * u1[1], g1[2] * sigmoidf_(g1[2]) * u1[2], g1[3] * sigmoidf_(g1[3]) * u1[3]); }
                const auto sx = __builtin_amdgcn_permlane16_swap(x[0].x, x[1].x, false, false), sy = __builtin_amdgcn_permlane16_swap(x[0].y, x[1].y, false, false);
                v4u w; w.x = sx[0]; w.y = sy[0]; w.z = sx[1]; w.w = sy[1];
                *(v4u*)(p + (size_t)(ai * 128 + mp * 32) * ldc) = w; }
    }
};
template <bool OUT_F32, bool SIDE>
struct EpiScatter {
    static constexpr bool PERM = true, AFTER_DRAIN = false, CHAIN = false;
    const int* rowtok; const float* roww; const bf16* XB; void* out; float ds; float* side;
    __device__ __forceinline__ void operator()(const pg8::f32x4 (&acc)[2][2][4][2], const pg8::Unit& u, int wr, int wc, int fr, int fq) const {
        const int row0 = u.pm * 256 + wr * 64 + fr, col0 = u.pn * 256 + wc * 32 + 8 * fq;
        const bool sd = SIDE && u.pm >= MOE_TILES;
#pragma unroll
        for (int ai = 0; ai < 2; ++ai) {
            int tok[4]; float w[4]; v4u bw[4][2];
#pragma unroll
            for (int m = 0; m < 4; ++m) { const int gr = row0 + ai * 128 + m * 16; tok[m] = rowtok[gr]; w[m] = roww[gr] * ds; }
#pragma unroll
            for (int m = 0; m < 4; ++m)
#pragma unroll
                for (int bj = 0; bj < 2; ++bj) bw[m][bj] = (tok[m] >= 0 && !sd) ? *(const v4u*)(XB + (size_t)tok[m] * D + col0 + bj * 128) : (v4u){0u, 0u, 0u, 0u};
#pragma unroll
            for (int m = 0; m < 4; ++m) if (tok[m] >= 0) {
#pragma unroll
                for (int bj = 0; bj < 2; ++bj) { const size_t off = (size_t)tok[m] * D + col0 + bj * 128; const v4u b = bw[m][bj];
                    const f32x4 r0 = (f32x4){bflo(b.x), bfhi(b.x), bflo(b.y), bfhi(b.y)} + acc[ai][bj][m][0] * w[m], r1 = (f32x4){bflo(b.z), bfhi(b.z), bflo(b.w), bfhi(b.w)} + acc[ai][bj][m][1] * w[m];
                    if (OUT_F32) { *(f32x4*)((float*)out + off) = r0; *(f32x4*)((float*)out + off + 4) = r1; }
                    else if (sd) { *(f32x4*)(side + off) = r0; *(f32x4*)(side + off + 4) = r1; }
                    else { v4u o; o.x = pk2(r0[0], r0[1]); o.y = pk2(r0[2], r0[3]); o.z = pk2(r1[0], r1[1]); o.w = pk2(r1[2], r1[3]); *(v4u*)((bf16*)out + off) = o; } } }
            asm volatile("" ::: "memory");
        }
    }
};
__device__ __forceinline__ void moe_side_combine(const Ctx& C, const unsigned char* ws, const bf16* XB, float* out, int row_lo, int row_hi) {
    const int* rowtok = (const int*)(ws + WS_ROWTOK);
    const int gw = C.bid * NWAVES + C.wave, NGW = C.G * NWAVES;
    for (int r = row_lo + gw; r < row_hi; r += NGW) { const int tok = rowtok[r];
        if (tok >= 0) { const size_t off = (size_t)tok * D + 16 * C.lane;
            const v4u b0 = *(const v4u*)(XB + off), b1 = *(const v4u*)(XB + off + 8);
            f32x4 o0 = *(const f32x4*)(out + off), o1 = *(const f32x4*)(out + off + 4), o2 = *(const f32x4*)(out + off + 8), o3 = *(const f32x4*)(out + off + 12);
            o0 += (f32x4){bflo(b0.x), bfhi(b0.x), bflo(b0.y), bfhi(b0.y)}; o1 += (f32x4){bflo(b0.z), bfhi(b0.z), bflo(b0.w), bfhi(b0.w)};
            o2 += (f32x4){bflo(b1.x), bfhi(b1.x), bflo(b1.y), bfhi(b1.y)}; o3 += (f32x4){bflo(b1.z), bfhi(b1.z), bflo(b1.w), bfhi(b1.w)};
            *(f32x4*)(out + off) = o0; *(f32x4*)(out + off + 4) = o1; *(f32x4*)(out + off + 8) = o2; *(f32x4*)(out + off + 12) = o3; } }
}
__device__ __forceinline__ void moe_gather(const Ctx& C, unsigned char* ws, const bf16* XN, int list) {
    const unsigned* cnt = (const unsigned*)(ws + WS_CTL) + CW_CNT + list * 8;
    MoeTiles mt; mt.init(cnt);
    const int* tokl = (const int*)(ws + WS_TOK) + (size_t)list * 8 * M; const float* wl = (const float*)(ws + WS_WL) + (size_t)list * 8 * M;
    int* rowtok = (int*)(ws + WS_ROWTOK) + list * MOE_ROWS; float* roww = (float*)(ws + WS_ROWW) + list * MOE_ROWS;
    unsigned char* XG = ws + WS_XG + list * XG_LIST; const unsigned char* XN8 = (const unsigned char*)XN;
    const int gw = C.bid * NWAVES + C.wave, NGW = C.G * NWAVES, nrows = mt.ntiles * 256;
    for (int g0 = gw; g0 < nrows; g0 += 4 * NGW) {
        int tok[4]; float w[4]; v4u a[4];
#pragma unroll
        for (int i = 0; i < 4; ++i) { const int gr = g0 + i * NGW; tok[i] = -1; w[i] = 0.f;
            if (gr < nrows) { int e, base; mt.locate(gr >> 8, e, base); const int local = ((gr >> 8) - base) * 256 + (gr & 255);
                if (local < (int)cnt[e]) { tok[i] = tokl[(size_t)e * M + local]; w[i] = wl[(size_t)e * M + local]; } } }
#pragma unroll
        for (int i = 0; i < 4; ++i) { a[i] = (v4u){0u, 0u, 0u, 0u};
            if (tok[i] >= 0) a[i] = ((const v4u*)(XN8 + (size_t)tok[i] * D))[C.lane]; }
#pragma unroll
        for (int i = 0; i < 4; ++i) { const int gr = g0 + i * NGW;
            if (gr < nrows) { if (C.lane == 0) { rowtok[gr] = tok[i]; roww[gr] = w[i]; }
                ((v4u*)(XG + (size_t)gr * D))[C.lane] = a[i]; } }
    }
}

__global__ void __launch_bounds__(NTHR, 2) fwd(Args args) {
    extern __shared__ __attribute__((aligned(16))) unsigned char lds_raw[];
    Ctx C; C.lds = (LAS unsigned char*)lds_raw; C.tid = threadIdx.x; C.lane = C.tid & 63; C.wave = __builtin_amdgcn_readfirstlane(C.tid >> 6); C.bid = blockIdx.x; C.G = gridDim.x;
    unsigned char* ws = args.ws;
    volatile LAS unsigned* MISC = (volatile LAS unsigned*)(C.lds + MISC_OFF);
    for (int u = C.tid; u < (LDS_BYTES - RING_BYTES) / 4; u += NTHR) ((LAS unsigned*)(C.lds + RING_BYTES))[u] = 0u;
    __syncthreads();
    const int lo = args.ph_lo, hi = args.ph_hi;
    const int wave_s = C.wave;
    XcdBarrier bar; bar.bar = (unsigned*)(ws + WS_CTL) + CW_BAR; bar.x = 0; bar.st = nullptr;
    if (MK_ONE_LAUNCH || hi - lo > 1) bar = xcd_barrier_post((unsigned*)(ws + WS_CTL) + CW_BAR, MISC + 8, C.tid == 0);
#if MK_ONE_LAUNCH
#define IN(k) true
#else
#define IN(k) (lo <= (k) && (k) < hi)
#endif
#define FRESH() do { unsigned z_ = 0u; asm volatile("" : "+v"(z_)); int t_ = wave_s * 64 + (int)__builtin_amdgcn_mbcnt_hi(~0u, __builtin_amdgcn_mbcnt_lo(~0u, z_)); asm volatile("" : "+v"(t_)); C.tid = t_; C.lane = t_ & 63; C.wave = wave_s; } while (0)
#if MK_ONE_LAUNCH
#define SEAM(k) xcd_barrier(bar, C.tid == 0)
#else
#define SEAM(k) do { if (IN(k) && IN((k) + 1)) xcd_barrier(bar, C.tid == 0); } while (0)
#endif
    bf16* XN = (bf16*)args.out; bf16* P = (bf16*)(ws + WS_P); bf16* XB = (bf16*)(ws + WS_XB);
    unsigned char* XN8 = (unsigned char*)args.out + (size_t)64 * MiB;

    if (IN(0)) { FRESH(); convert_layer_weights(C, args, 0); rope_table(C, ws); norm_rows<false, true>(C, args.in[0], args.in[1], XN, nullptr, ws, XN8); SEAM(0); }

#pragma unroll
    for (int l = 0; l < 2; ++l) {
        const int pb = 1 + 9 * l;
        if (IN(pb + 0)) { FRESH();
            {
                PlainSched S; S.T.init(M / 256, C_G / 256, C.G, C.bid); S.A = (const char*)XN; S.B = (const char*)(ws + WS_WIN); S.tA = (size_t)256 * D * 2; S.tB = (size_t)256 * D * 2;
                pg8::EpiBf16 E{P, NCOL, 1 << 30, 1.0f};
                pg8::gemm_phase<pg8::EpiBf16, PlainSched, true, true>(C.tid, C.lds, pg8::Gemm{D, D, D}, S, E); }
            FRESH();
            {
                PlainSched S; S.T.init(M / 256, (NCOL - C_G) / 256, C.G, C.bid); S.A = (const char*)XN8; S.B = (const char*)(ws + WS_WIN + (size_t)8 * MiB); S.tA = (size_t)256 * D; S.tB = (size_t)256 * D;
                pg8::EpiBf16 E{P + C_G, NCOL, 0, 1.0f / (SC_X8 * SC_W8)};
                pg8::gemm_phase<pg8::EpiBf16, PlainSched, true, true, true>(C.tid, C.lds, pg8::Gemm{D, D, D}, S, E); }
            SEAM(pb + 0);
        }
        if (IN(pb + 1)) { FRESH();
            lru_pass1_phase(C, args, l);
            __syncthreads(); FRESH();
            for (int it = C.bid; it < (M / 256) * NH; it += C.G) qk_item(C, args, l, it);
            FRESH();
            conva_tasks(C, args, l);
            SEAM(pb + 1);
        }
        if (IN(pb + 2)) { FRESH();
            {
                static_assert(moba::LDS_BYTES <= RING_BYTES, "attention scratch fits the ring region");
                const int v0 = (C.G % 8 == 0) ? (C.bid % 8) * (C.G / 8) + C.bid / 8 : C.bid;
                for (int v = v0; v < BATCH * NH * 4; v += C.G) { const int s = v & 3, bh = v >> 2;
#pragma unroll 1
                    for (int i = 0; i < 4; ++i) { const int qb = (i == 0) ? s : (i == 1) ? 7 - s : (i == 2) ? 8 + s : 15 - s;
                        moba::moba_unit(C.tid, bh >> 3, bh & 7, qb, (moba::bf16raw*)P, (const float*)(ws + WS_KMEAN), (char*)lds_raw); } }
            }
            FRESH();
            for (int it = C.bid; it < BATCH * NCH; it += C.G) lru_pass2_item(C, args, it);
            SEAM(pb + 2);
        }
        if (IN(pb + 3)) { FRESH();
            MergeSched S; S.T.init(M / 256, D / 256, C.G, C.bid); S.P = (const char*)P; S.W = (const char*)(ws + WS_WOABC);
            EpiMerge E{XN, P};
            pg8::gemm_phase<EpiMerge, MergeSched, true, true>(C.tid, C.lds, pg8::Gemm{512, NCOL, 512}, S, E);
            SEAM(pb + 3);
        }
        if (IN(pb + 4)) { FRESH();
            PlainSched S; S.T.init(M / 256, D / 256, C.G, C.bid); S.A = (const char*)XN; S.B = (const char*)(ws + WS_WO); S.tA = (size_t)256 * D * 2; S.tB = (size_t)256 * D * 2;
            if (l == 0) { EpiRes<true> E{args.in[0], XB}; pg8::gemm_phase<EpiRes<true>, PlainSched, true, true>(C.tid, C.lds, pg8::Gemm{D, D, D}, S, E); }
            else { EpiRes<false> E{XB, XB}; pg8::gemm_phase<EpiRes<false>, PlainSched, true, true>(C.tid, C.lds, pg8::Gemm{D, D, D}, S, E); }
            SEAM(pb + 4);
        }
        if (l == 0) {
            if (IN(pb + 5)) { FRESH(); norm_rows_b<false>(C, XB, args.in[17], XN, nullptr, ws); SEAM(pb + 5); }
            if (IN(pb + 6)) { FRESH();
                PlainSched S; S.T.init(M / 256, 2 * DFF / 256, C.G, C.bid); S.A = (const char*)XN; S.B = (const char*)(ws + WS_FGU); S.tA = (size_t)256 * D * 2; S.tB = (size_t)256 * D * 2;
                EpiSwiGLU E{(bf16*)(ws + WS_HID0), DFF};
                pg8::gemm_phase<EpiSwiGLU, PlainSched, true, true>(C.tid, C.lds, pg8::Gemm{D, D, D}, S, E);
                SEAM(pb + 6);
            }
            if (IN(pb + 7)) { FRESH();
                PlainSched S; S.T.init(M / 256, D / 256, C.G, C.bid); S.A = (const char*)(ws + WS_HID0); S.B = (const char*)(ws + WS_FDN); S.tA = (size_t)256 * DFF * 2; S.tB = (size_t)256 * DFF * 2;
                EpiRes<false> E{XB, XB};
                pg8::gemm_phase<EpiRes<false>, PlainSched, true, true>(C.tid, C.lds, pg8::Gemm{DFF, DFF, DFF}, S, E);
                SEAM(pb + 7);
            }
            if (IN(pb + 8)) { FRESH(); convert_layer_weights(C, args, 1); norm_rows_b<false, true>(C, XB, args.in[1] + D, XN, nullptr, ws, XN8); SEAM(pb + 8); }
        } else {
            if (IN(15)) { FRESH(); norm_rows_b<true>(C, XB, args.in[17] + D, XN, args.in[21], ws); convert_moe_weights(C, args); SEAM(15); }
            if (IN(16)) { FRESH(); moe_gather(C, ws, XN, 0); FRESH(); moe_gather(C, ws, XN, 1); SEAM(16); }
            const unsigned* cnt = (const unsigned*)(ws + WS_CTL) + CW_CNT;
            int nt0, nt1; { MoeTiles t; t.init(cnt); nt0 = t.ntiles; t.init(cnt + 8); nt1 = t.ntiles; }
            const int reg1 = ((nt1 * (D / 256)) / C.G) * C.G / (D / 256);
            constexpr float dsc = 1.0f / (SC_H8 * SC_W8);
            if (IN(17)) { FRESH();
                MoeSched S; S.init(cnt, 2 * EFF / 256, C.G, C.bid, 0, 0, nt0, 1, reg1, nt1 - reg1);
                S.A = (const char*)(ws + WS_XG); S.tA = (size_t)256 * D; S.W = (const char*)(ws + WS_MGU); S.eStride = (size_t)7168 * D; S.tB = (size_t)256 * D;
                EpiSwiGLU8 E{ws + WS_MH, EFF};
                pg8::gemm_phase<EpiSwiGLU8, MoeSched, true, true, true>(C.tid, C.lds, pg8::Gemm{D, D, D}, S, E);
                SEAM(17);
            }
            if (IN(18)) { FRESH();
                int extra;
                {   MoeSched S; S.init(cnt, D / 256, C.G, C.bid, 0, 0, nt0, 1, reg1, nt1 - reg1); extra = S.nunits() % C.G;
                    S.A = (const char*)(ws + WS_MH); S.tA = (size_t)256 * EFF; S.W = (const char*)(ws + WS_MDN); S.eStride = (size_t)D * EFF; S.tB = (size_t)256 * EFF;
                    EpiScatter<false, true> E{(const int*)(ws + WS_ROWTOK), (const float*)(ws + WS_ROWW), XB, XB, dsc, args.out};
                    pg8::gemm_phase<EpiScatter<false, true>, MoeSched, true, true, true>(C.tid, C.lds, pg8::Gemm{EFF, EFF, EFF}, S, E); }
                FRESH();
                {   MoeSched S; S.init(cnt, 2 * EFF / 256, C.G, C.bid, 1, 0, reg1, 1, 0, 0); S.skipE = extra; S.skipR = MOE_DOWN_COST;
                    S.A = (const char*)(ws + WS_XG); S.tA = (size_t)256 * D; S.W = (const char*)(ws + WS_MGU); S.eStride = (size_t)7168 * D; S.tB = (size_t)256 * D;
                    EpiSwiGLU8 E{ws + WS_MH, EFF};
                    pg8::gemm_phase<EpiSwiGLU8, MoeSched, true, true, true>(C.tid, C.lds, pg8::Gemm{D, D, D}, S, E); }
                SEAM(18);
            }
            if (IN(19)) { FRESH();
                moe_side_combine(C, ws, XB, args.out, (MOE_TILES + reg1) * 256, (MOE_TILES + nt1) * 256);
                FRESH();
                MoeSched S; S.init(cnt, D / 256, C.G, C.bid, 1, 0, reg1, 1, 0, 0);
                S.A = (const char*)(ws + WS_MH); S.tA = (size_t)256 * EFF; S.W = (const char*)(ws + WS_MDN); S.eStride = (size_t)D * EFF; S.tB = (size_t)256 * EFF;
                EpiScatter<true, false> E{(const int*)(ws + WS_ROWTOK), (const float*)(ws + WS_ROWW), XB, args.out, dsc, nullptr};
                pg8::gemm_phase<EpiScatter<true, false>, MoeSched, true, true, true>(C.tid, C.lds, pg8::Gemm{EFF, EFF, EFF}, S, E);
            }
        }
    }
#undef IN
#undef SEAM
}

extern "C" void kernel_launch(void* const* d_in, const int* in_sizes, int n_in, void* d_out, int out_size, void* d_ws, size_t ws_size, hipStream_t stream) {
    static int grid = 0;
    if (grid == 0) {
        if (n_in != 25 || in_sizes[0] != M * D || out_size != M * D || ws_size < WS_END) { fprintf(stderr, "kernel_launch: unexpected shapes (n_in %d, in0 %d, out %d, ws %zu); nothing launched\n", n_in, n_in > 0 ? in_sizes[0] : -1, out_size, ws_size); grid = -1; return; }
        int dev = 0, cus = 0, per_cu = 0;
        if (hipGetDevice(&dev) != hipSuccess || hipDeviceGetAttribute(&cus, hipDeviceAttributeMultiprocessorCount, dev) != hipSuccess) { grid = -1; return; }
        if (hipFuncSetAttribute((const void*)fwd, hipFuncAttributeMaxDynamicSharedMemorySize, LDS_BYTES) != hipSuccess) { fprintf(stderr, "kernel_launch: hipFuncSetAttribute failed\n"); grid = -1; return; }
        if (hipOccupancyMaxActiveBlocksPerMultiprocessor(&per_cu, (const void*)fwd, NTHR, LDS_BYTES) != hipSuccess || per_cu < 1) { fprintf(stderr, "kernel_launch: occupancy query reports %d workgroups per CU\n", per_cu); }
        (void)hipGetLastError();
        grid = cus;
    }
    if (grid < 0) return;
    if (hipMemsetAsync((char*)d_ws + WS_CTL, 0, CTL_ZERO_BYTES, stream) != hipSuccess) return;
    Args a{};
    for (int i = 0; i < 25; ++i) a.in[i] = (const float*)d_in[i];
    a.out = (float*)d_out; a.ws = (unsigned char*)d_ws;
#if MK_ONE_LAUNCH
    a.ph_lo = 0; a.ph_hi = N_PHASES;
    hipLaunchKernelGGL(fwd, dim3(grid), dim3(NTHR), LDS_BYTES, stream, a);
#else
    for (int p = 0; p < N_PHASES; ++p) { a.ph_lo = p; a.ph_hi = p + 1; hipLaunchKernelGGL(fwd, dim3(grid), dim3(NTHR), LDS_BYTES, stream, a); }
#endif
}
```
